# Optimizing an MI355X kernel written in HIP

```python
import jax, jax.numpy as jnp
from jax import lax
import numpy as np

D_MODEL = 2048
BATCH = 2
SEQ = 16384
DEPTH = 2

N_MIXERS = 2
N_RET_LAYERS = (DEPTH + 1) // 2
N_NSA_LAYERS = DEPTH // 2
EPS = 1e-6
NEG_INF = -1e30
FORCE_SCORE = 1e4

RET_HEADS = 8
RET_DK = D_MODEL // RET_HEADS
RET_DV = 2 * RET_DK
RET_QK_W = RET_HEADS * RET_DK
RET_V_W = RET_HEADS * RET_DV
RET_IN = 2 * RET_QK_W + 2 * RET_V_W
RET_CHUNK = 128

NSA_HEADS = 16
NSA_GROUPS = 4
NSA_REP = NSA_HEADS // NSA_GROUPS
NSA_DH = D_MODEL // NSA_HEADS
NSA_WIDTH = NSA_HEADS * NSA_DH
NSA_KV = NSA_GROUPS * NSA_DH
NSA_BRANCHES = 3
NSA_IN = NSA_WIDTH + 6 * NSA_KV + NSA_HEADS * NSA_BRANCHES + NSA_WIDTH
CMP_LEN = 32
CMP_STRIDE = 16
SLC_BLOCK = 64
TOP_N = 16
WINDOW = 512
Q_BLOCK = 128

kernel_name = "interleaved_retention_nsa_gated_hybrid"


def rmsnorm(x, g):
    xf = x.astype(jnp.float32)
    y = xf * lax.rsqrt(jnp.mean(xf * xf, axis=-1, keepdims=True) + EPS)
    return (y * g.astype(jnp.float32)).astype(x.dtype)


def masked_softmax(s, mask):
    p = jax.nn.softmax(jnp.where(mask, s, NEG_INF), axis=-1)
    return jnp.where(mask, p, 0.0)


def alibi_slopes(n_heads):
    return jnp.exp2(-8.0 * jnp.arange(1, n_heads + 1, dtype=jnp.float32) / n_heads)


def retention_mixer(h, w_in, w_out):
    B, S, _ = h.shape
    H, C = RET_HEADS, RET_CHUNK
    n = S // C
    proj = h @ w_in
    q, k, v, gate = jnp.split(proj, [RET_QK_W, 2 * RET_QK_W, 2 * RET_QK_W + RET_V_W], axis=-1)

    def heads(t, d):
        return t.reshape(B, n, C, H, d).transpose(1, 0, 3, 2, 4).astype(jnp.float32)

    q = heads(q, RET_DK)
    k = heads(k, RET_DK) * (RET_DK ** -0.5)
    v = heads(v, RET_DV)
    log_g = jnp.log1p(-jnp.exp2(-5.0 - jnp.arange(H, dtype=jnp.float32)))
    idx = jnp.arange(C, dtype=jnp.float32)
    diff = idx[:, None] - idx[None, :]
    decay_intra = jnp.where(diff >= 0, jnp.exp(diff[None] * log_g[:, None, None]), 0.0)
    q_decay = jnp.exp((idx[None, :] + 1.0) * log_g[:, None])[None, :, :, None]
    k_decay = jnp.exp((C - 1.0 - idx[None, :]) * log_g[:, None])[None, :, :, None]
    chunk_decay = jnp.exp(C * log_g)[None, :, None, None]

    def step(state, qkv):
        qc, kc, vc = qkv
        scores = jnp.einsum('bhnd,bhmd->bhnm', qc, kc) * decay_intra
        o = (jnp.einsum('bhnm,bhmv->bhnv', scores, vc)
             + jnp.einsum('bhnd,bhdv->bhnv', qc, state) * q_decay)
        state = state * chunk_decay + jnp.einsum('bhmd,bhmv->bhdv', kc * k_decay, vc)
        return state, o

    state0 = jnp.zeros((B, H, RET_DK, RET_DV), jnp.float32)
    _, o = lax.scan(step, state0, (q, k, v))
    mu = jnp.mean(o, axis=-1, keepdims=True)
    var = jnp.mean(jnp.square(o - mu), axis=-1, keepdims=True)
    o = (o - mu) * lax.rsqrt(var + EPS)
    o = o.transpose(1, 0, 3, 2, 4).reshape(B, S, RET_V_W)
    y = jax.nn.silu(gate.astype(jnp.float32)) * o
    return y.astype(h.dtype) @ w_out


def compress_blocks(raw, pos, w1, w2, blk_idx):
    B = raw.shape[0]
    n_cmp = blk_idx.shape[0]
    blocks = raw[:, blk_idx] + pos[None, None, :, None, :]
    flat = blocks.transpose(0, 1, 3, 2, 4).reshape(B, n_cmp, NSA_GROUPS, CMP_LEN * NSA_DH)
    return jax.nn.silu(flat @ w1) @ w2


def nsa_mixer(h, w_in, cmp_pos_k, cmp_w1_k, cmp_w2_k, cmp_pos_v, cmp_w1_v, cmp_w2_v, w_out):
    B, S, _ = h.shape
    G, R, dh, QB = NSA_GROUPS, NSA_REP, NSA_DH, Q_BLOCK
    nq = S // QB
    sizes = [NSA_WIDTH] + [NSA_KV] * 6 + [NSA_HEADS * NSA_BRANCHES]
    offs = [int(o) for o in np.cumsum(sizes)]
    proj = h @ w_in
    q, kc_raw, vc_raw, ks, vs, kw, vw, g, z = jnp.split(proj, offs, axis=-1)
    q = q.reshape(B, S, G, R, dh) * (dh ** -0.5)
    kv = lambda t: t.reshape(B, S, G, dh)
    kc_raw, vc_raw, ks, vs, kw, vw = map(kv, (kc_raw, vc_raw, ks, vs, kw, vw))
    gates = jax.nn.sigmoid(g.astype(jnp.float32)).reshape(B, S, G, R, NSA_BRANCHES)
    slopes = alibi_slopes(NSA_HEADS).reshape(G, R)

    n_cmp = (S - CMP_LEN) // CMP_STRIDE + 1
    blk_idx = jnp.arange(n_cmp)[:, None] * CMP_STRIDE + jnp.arange(CMP_LEN)[None, :]
    k_cmp = compress_blocks(kc_raw, cmp_pos_k, cmp_w1_k, cmp_w2_k, blk_idx)
    v_cmp = compress_blocks(vc_raw, cmp_pos_v, cmp_w1_v, cmp_w2_v, blk_idx)
    cmp_end = blk_idx[:, -1]

    n_slc = S // SLC_BLOCK
    n_sel = min(TOP_N, n_slc)
    cstart = jnp.arange(n_cmp) * CMP_STRIDE
    sstart = jnp.arange(n_slc) * SLC_BLOCK
    overlap = ((cstart[:, None] < sstart[None, :] + SLC_BLOCK)
               & (cstart[:, None] + CMP_LEN > sstart[None, :])).astype(jnp.float32)
    k_blk = ks.reshape(B, n_slc, SLC_BLOCK, G, dh).transpose(0, 3, 1, 2, 4)
    v_blk = vs.reshape(B, n_slc, SLC_BLOCK, G, dh).transpose(0, 3, 1, 2, 4)
    b_i = jnp.arange(B)[:, None, None, None]
    g_i = jnp.arange(G)[None, None, :, None]
    jj = jnp.arange(n_slc)

    kw_p = jnp.pad(kw, ((0, 0), (WINDOW, 0), (0, 0), (0, 0)))
    vw_p = jnp.pad(vw, ((0, 0), (WINDOW, 0), (0, 0), (0, 0)))

    q_blocks = q.reshape(B, nq, QB, G, R, dh).transpose(1, 0, 2, 3, 4, 5)
    g_blocks = gates.reshape(B, nq, QB, G, R, NSA_BRANCHES).transpose(1, 0, 2, 3, 4, 5)

    def block_fn(args):
        qi, qb, gb = args
        q0 = qi * QB
        t = q0 + jnp.arange(QB)
        dc = t[:, None] - cmp_end[None, :]
        sc = (jnp.einsum('bqgrd,bcgd->bqgrc', qb, k_cmp).astype(jnp.float32)
              - slopes[None, None, :, :, None] * dc.astype(jnp.float32)[None, :, None, None, :])
        pc = masked_softmax(sc, (dc >= 0)[None, :, None, None, :])
        o_cmp = jnp.einsum('bqgrc,bcgd->bqgrd', pc, v_cmp)
        imp = jnp.einsum('bqgrc,cj->bqgj', pc, overlap)
        cur = (t // SLC_BLOCK)[:, None]
        forced = (jj[None, :] == 0) | (jj[None, :] == cur) | (jj[None, :] == cur - 1)
        blk_ok = sstart[None, :] <= t[:, None]
        score = jnp.where(forced[None, :, None, :], FORCE_SCORE,
                          jnp.where(blk_ok[None, :, None, :], imp, -1.0))
        _, sel = lax.top_k(score, n_sel)
        kb = k_blk[b_i, g_i, sel]
        vb = v_blk[b_i, g_i, sel]
        tok = sel[..., None] * SLC_BLOCK + jnp.arange(SLC_BLOCK)
        ds = (t[None, :, None, None, None] - tok)[:, :, :, None]
        ss = (jnp.einsum('bqgrd,bqgnkd->bqgrnk', qb, kb).astype(jnp.float32)
              - slopes[None, None, :, :, None, None] * ds.astype(jnp.float32))
        flat_shape = ss.shape[:4] + (n_sel * SLC_BLOCK,)
        ps = masked_softmax(ss.reshape(flat_shape),
                            jnp.broadcast_to(ds >= 0, ss.shape).reshape(flat_shape)).reshape(ss.shape)
        o_slc = jnp.einsum('bqgrnk,bqgnkd->bqgrd', ps, vb)
        kwb = lax.dynamic_slice_in_dim(kw_p, q0, QB + WINDOW, axis=1)
        vwb = lax.dynamic_slice_in_dim(vw_p, q0, QB + WINDOW, axis=1)
        kpos = q0 - WINDOW + jnp.arange(QB + WINDOW)
        dw = t[:, None] - kpos[None, :]
        mw = (dw >= 0) & (dw < WINDOW) & (kpos[None, :] >= 0)
        sw = (jnp.einsum('bqgrd,bkgd->bqgrk', qb, kwb).astype(jnp.float32)
              - slopes[None, None, :, :, None] * dw.astype(jnp.float32)[None, :, None, None, :])
        pw = masked_softmax(sw, mw[None, :, None, None, :])
        o_win = jnp.einsum('bqgrk,bkgd->bqgrd', pw, vwb)
        return gb[..., 0:1] * o_cmp + gb[..., 1:2] * o_slc + gb[..., 2:3] * o_win

    o = lax.map(block_fn, (jnp.arange(nq), q_blocks, g_blocks))
    o = o.transpose(1, 0, 2, 3, 4, 5).reshape(B, S, NSA_WIDTH)
    y = jax.nn.silu(z.astype(jnp.float32)) * o.astype(jnp.float32)
    return y.astype(h.dtype) @ w_out


def setup_inputs(seed: int = 0) -> dict:
    key = jax.random.key(seed)
    ks = jax.random.split(key, 14)
    nrm = lambda k, shape, scale: jax.random.normal(k, shape, jnp.float32) * scale
    return {
        "x": nrm(ks[0], (BATCH, SEQ, D_MODEL), 1.0),
        "norm_g": 1.0 + nrm(ks[1], (DEPTH, D_MODEL), 0.01),
        "ret_w_in": nrm(ks[2], (N_RET_LAYERS, D_MODEL, RET_IN), D_MODEL ** -0.5),
        "ret_w_out": nrm(ks[3], (N_RET_LAYERS, RET_V_W, D_MODEL), RET_V_W ** -0.5),
        "nsa_w_in": nrm(ks[4], (N_NSA_LAYERS, D_MODEL, NSA_IN), D_MODEL ** -0.5),
        "nsa_cmp_pos_k": nrm(ks[5], (N_NSA_LAYERS, CMP_LEN, NSA_DH), 0.1),
        "nsa_cmp_w1_k": nrm(ks[6], (N_NSA_LAYERS, CMP_LEN * NSA_DH, NSA_DH), (CMP_LEN * NSA_DH) ** -0.5),
        "nsa_cmp_w2_k": nrm(ks[7], (N_NSA_LAYERS, NSA_DH, NSA_DH), NSA_DH ** -0.5),
        "nsa_cmp_pos_v": nrm(ks[8], (N_NSA_LAYERS, CMP_LEN, NSA_DH), 0.1),
        "nsa_cmp_w1_v": nrm(ks[9], (N_NSA_LAYERS, CMP_LEN * NSA_DH, NSA_DH), (CMP_LEN * NSA_DH) ** -0.5),
        "nsa_cmp_w2_v": nrm(ks[10], (N_NSA_LAYERS, NSA_DH, NSA_DH), NSA_DH ** -0.5),
        "nsa_w_out": nrm(ks[11], (N_NSA_LAYERS, NSA_WIDTH, D_MODEL), NSA_WIDTH ** -0.5),
        "final_g": 1.0 + nrm(ks[12], (D_MODEL,), 0.01),
    }


def reference(x, norm_g, ret_w_in, ret_w_out, nsa_w_in, nsa_cmp_pos_k, nsa_cmp_w1_k, nsa_cmp_w2_k,
              nsa_cmp_pos_v, nsa_cmp_w1_v, nsa_cmp_w2_v, nsa_w_out, final_g):
    h = x
    for i in range(DEPTH):
        hn = rmsnorm(h, norm_g[i])
        j = i // N_MIXERS
        if i % N_MIXERS == 0:
            h = h + retention_mixer(hn, ret_w_in[j], ret_w_out[j])
        else:
            h = h + nsa_mixer(hn, nsa_w_in[j], nsa_cmp_pos_k[j], nsa_cmp_w1_k[j], nsa_cmp_w2_k[j],
                              nsa_cmp_pos_v[j], nsa_cmp_w1_v[j], nsa_cmp_w2_v[j], nsa_w_out[j])
    return rmsnorm(h, final_g)
```

```cpp
#include <hip/hip_runtime.h>
#include <hip/hip_cooperative_groups.h>
#include <cstdio>
namespace cg = cooperative_groups;

#ifndef SINGLE_LAUNCH
#define SINGLE_LAUNCH 0
#endif

#define DI __device__ __forceinline__
#define LAS __attribute__((address_space(3)))
typedef unsigned short bf16_t;
typedef short bf16x8 __attribute__((ext_vector_type(8)));
typedef short s16x4 __attribute__((ext_vector_type(4)));
typedef float f32x4 __attribute__((ext_vector_type(4)));
typedef float f32x16 __attribute__((ext_vector_type(16)));
typedef unsigned u32x4 __attribute__((ext_vector_type(4)));
typedef unsigned u32x2 __attribute__((ext_vector_type(2)));
typedef __bf16 bf2_t __attribute__((ext_vector_type(2)));

constexpr int T_ = 32768, S_ = 16384, DM = 2048;
constexpr int LD0 = 12288;
constexpr int LD1 = 7424;
constexpr int C_KC = 2048, C_VC = 2560, C_KS = 3072, C_VS = 3584, C_KW = 4096, C_VW = 4608, C_Z = 5120, C_G = 7168;
constexpr int NTHREADS = 512;
constexpr int LDS_BYTES = 144 * 1024;

constexpr size_t OFF_W1T = 0;
constexpr size_t OFF_W2T = OFF_W1T + (size_t)12288 * 2048 * 2;
constexpr size_t OFF_W3T = OFF_W2T + (size_t)2048 * 4096 * 2;
constexpr size_t OFF_W4T = OFF_W3T + (size_t)LD1 * 2048 * 2;
constexpr size_t OFF_CW1K = OFF_W4T + (size_t)2048 * 2048 * 2;
constexpr size_t OFF_CW1V = OFF_CW1K + (size_t)128 * 4096 * 2;
constexpr size_t OFF_CW2K = OFF_CW1V + (size_t)128 * 4096 * 2;
constexpr size_t OFF_CW2V = OFF_CW2K + (size_t)128 * 128 * 2;
constexpr size_t OFF_CB = OFF_CW2V + (size_t)128 * 128 * 2;
constexpr size_t OFF_RSTD0 = OFF_CB + 1024;
constexpr size_t OFF_SS1 = OFF_RSTD0 + (size_t)T_ * 4;
constexpr size_t OFF_KC = OFF_SS1 + (size_t)T_ * 4;
constexpr size_t OFF_VCT = OFF_KC + (size_t)8 * 1024 * 128 * 2;
constexpr size_t OFF_XB = OFF_VCT + (size_t)8 * 1024 * 128 * 2;
constexpr size_t OFF_PROJ = OFF_XB + (size_t)T_ * 2048 * 2;
constexpr size_t OFF_VST = OFF_PROJ + (size_t)T_ * LD1 * 2;
constexpr size_t OFF_VWT = OFF_VST + (size_t)8 * 128 * S_ * 2;
constexpr size_t WS_END = OFF_PROJ + (size_t)T_ * LD0 * 2;
static_assert(OFF_VWT + (size_t)8 * 128 * S_ * 2 <= WS_END, "ws map");

struct Params {
    const float* x; const float* norm_g; const float* ret_w_in; const float* ret_w_out; const float* nsa_w_in;
    const float* pos_k; const float* w1_k; const float* w2_k; const float* pos_v; const float* w1_v; const float* w2_v;
    const float* nsa_w_out; const float* final_g; float* out; unsigned char* ws; int ph_lo, ph_hi;
};

DI unsigned pk2(float lo, float hi) { bf2_t v; v.x = (__bf16)lo; v.y = (__bf16)hi; return __builtin_bit_cast(unsigned, v); }
DI float bflo(unsigned u) { return __uint_as_float(u << 16); }
DI float bfhi(unsigned u) { return __uint_as_float(u & 0xffff0000u); }
DI float wave_sum(float v) {
#pragma unroll
    for (int o = 32; o >= 1; o >>= 1) v += __shfl_xor(v, o);
    return v;
}
DI float silu_f(float x) { return x / (1.f + __expf(-x)); }
DI float sigm_f(float x) { return 1.f / (1.f + __expf(-x)); }
DI int crow(int i, int hh) { return (i & 3) + 8 * (i >> 2) + 4 * hh; }
#define MFMA32(a, b, c) __builtin_amdgcn_mfma_f32_32x32x16_bf16((a), (b), (c), 0, 0, 0)
DI f32x16 zero16() { f32x16 z; for (int i = 0; i < 16; ++i) z[i] = 0.f; return z; }
DI bf16x8 ldsfrag(const LAS bf16_t* p) { return *(const LAS bf16x8*)p; }
DI void tr4x8(const u32x4 (&R)[4], u32x2 (&o)[8]) {
#pragma unroll
    for (int d = 0; d < 4; ++d) {
        const unsigned a0 = R[0][d], a1 = R[1][d], a2 = R[2][d], a3 = R[3][d];
        o[2 * d][0] = (a0 & 0xffffu) | (a1 << 16); o[2 * d][1] = (a2 & 0xffffu) | (a3 << 16);
        o[2 * d + 1][0] = (a0 >> 16) | (a1 & 0xffff0000u); o[2 * d + 1][1] = (a2 >> 16) | (a3 & 0xffff0000u);
    }
}

namespace pg8 {
constexpr int BM = 256, BK = 64, HALF = 128, HTB = HALF * BK * 2, STAGE_BYTES = 8 * HTB, NXCD = 8, WGM = 8;
DI int lds_byte(int r, int c) { const int st = (r >> 4) * 2 + (c >> 5), rr = r & 15, cc = c & 31, ob = rr * 64 + cc * 2; return st * 1024 + (ob ^ (((ob >> 9) & 1) << 5)); }
DI void stage_rc(int b, int& R, int& C) { const int st = b / 1024, sb = b % 1024, swz = sb ^ (((sb >> 9) & 1) << 5); R = (st >> 1) * 16 + swz / 64; C = (st & 1) * 32 + (swz % 64) / 2; }
DI int perm32(int rho) { const int n = rho >> 4, i = rho & 15; return 8 * (i >> 2) + 4 * n + (i & 3); }
struct Unit { int pm, pn; };
struct Gemm { const bf16_t* A; const bf16_t* Bt; int lda, ldb, M, N, K; };
struct StaticOrder {
    int nM, nN, nwg, G, c;
    DI void init(int M, int N, int G_, int c_) { nM = M / BM; nN = N / BM; nwg = nM * nN; G = G_; c = c_; }
    DI bool next(int i, Unit& u) const {
        const long L = (long)i * G + c; if (L >= nwg) return false;
        int wgid = (int)L; { const int q = nwg / NXCD, r = nwg % NXCD, xcd = wgid % NXCD, off = wgid / NXCD; wgid = (xcd < r ? xcd * (q + 1) : r * (q + 1) + (xcd - r) * q) + off; }
        const int nig = WGM * nN, gid = wgid / nig, fm = gid * WGM, gsz = (nM - fm) < WGM ? (nM - fm) : WGM;
        u.pm = fm + ((wgid % nig) % gsz); u.pn = (wgid % nig) / gsz; return true;
    }
};

template <class Epi>
DI void gemm_phase(LAS unsigned char* lds, const Gemm g, const StaticOrder& S, const Epi& E) {
    const int tid = threadIdx.x, wid = __builtin_amdgcn_readfirstlane(tid >> 6), lane = tid & 63, wr = wid >> 2, wc = wid & 3, fr = lane & 15, fq = lane >> 4;
    const int K = g.K, nt = K / BK;
    unsigned voffA[2], voffB[2];
#pragma unroll
    for (int i = 0; i < 2; ++i) { int R, C; stage_rc(tid * 16 + i * 8192, R, C); const int Rb = Epi::PERM ? ((R & ~31) + perm32(R & 31)) : R;
        voffA[i] = (unsigned)(R * g.lda + C) * 2u; voffB[i] = (unsigned)(Rb * g.ldb + C) * 2u; }
    const size_t kstep = (size_t)(BK * 2);
    const size_t hstepA = (size_t)HALF * g.lda * 2, hstepB = (size_t)HALF * g.ldb * 2;
    const size_t tstepA = 2 * hstepA, tstepB = 2 * hstepB;
    const unsigned ldsw = (unsigned)wid * 1024u;
    const int aoff = lds_byte(wr * 64 + fr, fq * 8), boff = lds_byte(wc * 32 + fr, fq * 8);
#define PG8_SA(b, h) (((b) * 2 + (h)) * HTB)
#define PG8_SB(b, h) ((4 + (b) * 2 + (h)) * HTB)
#define PG8_STAGE(bufoff, gbase, voff) do { _Pragma("unroll") for (int _i = 0; _i < 2; ++_i) \
        __builtin_amdgcn_global_load_lds((const unsigned*)((const char*)(gbase) + (voff)[_i]), (LAS unsigned*)(lds + (bufoff) + ldsw + _i * 8192), 16, 0, 0); } while (0)
#define PG8_LDA(dst, b, h) do { _Pragma("unroll") for (int m = 0; m < 4; ++m) _Pragma("unroll") for (int k = 0; k < 2; ++k) dst[m][k] = *(const LAS bf16x8*)(lds + PG8_SA(b, h) + aoff + m * 2048 + k * 1024); } while (0)
#define PG8_LDB(dst, b, h) do { _Pragma("unroll") for (int n = 0; n < 2; ++n) _Pragma("unroll") for (int k = 0; k < 2; ++k) dst[n][k] = *(const LAS bf16x8*)(lds + PG8_SB(b, h) + boff + n * 2048 + k * 1024); } while (0)
#define PG8_MMA(ai, bj, At, Bt) do { __builtin_amdgcn_s_setprio(1); _Pragma("unroll") for (int m = 0; m < 4; ++m) _Pragma("unroll") for (int n = 0; n < 2; ++n) _Pragma("unroll") for (int k = 0; k < 2; ++k) \
        acc[ai][bj][m][n] = __builtin_amdgcn_mfma_f32_16x16x32_bf16(Bt[n][k], At[m][k], acc[ai][bj][m][n], 0, 0, 0); __builtin_amdgcn_s_setprio(0); } while (0)
#define PG8_WAIT_V(n) asm volatile("s_waitcnt vmcnt(" #n ")" ::: "memory")
#define PG8_WAIT_L(n) asm volatile("s_waitcnt lgkmcnt(" #n ")" ::: "memory")
#define PG8_BAR __builtin_amdgcn_s_barrier()
#define PG8_SCHED __builtin_amdgcn_sched_barrier(0)
    Unit cur, nxt; int ui = 0;
    if (!S.next(0, cur)) return;
    f32x4 acc[2][2][4][2];
#pragma unroll
    for (int a = 0; a < 2; ++a)
#pragma unroll
        for (int b = 0; b < 2; ++b)
#pragma unroll
            for (int m = 0; m < 4; ++m)
#pragma unroll
                for (int n = 0; n < 2; ++n) acc[a][b][m][n] = (f32x4){0.f, 0.f, 0.f, 0.f};
    bf16x8 At[4][2], B0[2][2], B1[2][2];
    const char* cA = (const char*)g.A + (size_t)cur.pm * tstepA; const char* cB = (const char*)g.Bt + (size_t)cur.pn * tstepB;
    PG8_STAGE(PG8_SB(0, 0), cB, voffB); PG8_STAGE(PG8_SA(0, 0), cA, voffA); PG8_STAGE(PG8_SB(0, 1), cB + hstepB, voffB); PG8_STAGE(PG8_SA(0, 1), cA + hstepA, voffA);
    if (wr == 1) PG8_BAR;
    PG8_WAIT_V(4); PG8_BAR;
    PG8_STAGE(PG8_SB(1, 0), cB + kstep, voffB); PG8_STAGE(PG8_SA(1, 0), cA + kstep, voffA); PG8_STAGE(PG8_SB(1, 1), cB + hstepB + kstep, voffB);
    PG8_WAIT_V(6); PG8_BAR;
    for (;;) {
        const bool has_next = S.next(ui + 1, nxt);
        const char* nA = has_next ? (const char*)g.A + (size_t)nxt.pm * tstepA : cA; const char* nB = has_next ? (const char*)g.Bt + (size_t)nxt.pn * tstepB : cB;
        for (int t = 0; t < nt; t += 2) {
            const bool last = (t == nt - 2);
            const char* a1 = cA + (size_t)(t + 1) * kstep;
            const char* a2 = last ? nA : cA + (size_t)(t + 2) * kstep; const char* b2 = last ? nB : cB + (size_t)(t + 2) * kstep;
            const char* a3 = a2 + kstep; const char* b3 = b2 + kstep;
            PG8_LDB(B0, 0, 0); PG8_SCHED; PG8_LDA(At, 0, 0); PG8_STAGE(PG8_SA(1, 1), a1 + hstepA, voffA);
            PG8_WAIT_L(8); PG8_BAR; PG8_WAIT_L(0); PG8_MMA(0, 0, At, B0); PG8_BAR; PG8_SCHED;
            PG8_LDB(B1, 0, 1); PG8_STAGE(PG8_SB(0, 0), b2, voffB);
            PG8_BAR; PG8_WAIT_L(0); PG8_MMA(0, 1, At, B1); PG8_BAR;
            PG8_LDA(At, 0, 1); PG8_STAGE(PG8_SA(0, 0), a2, voffA);
            PG8_BAR; PG8_WAIT_L(0); PG8_MMA(1, 0, At, B0); PG8_BAR; PG8_SCHED;
            PG8_STAGE(PG8_SB(0, 1), b2 + hstepB, voffB);
            PG8_WAIT_V(6); PG8_BAR; PG8_MMA(1, 1, At, B1); PG8_BAR;
            PG8_LDB(B0, 1, 0); PG8_SCHED; PG8_LDA(At, 1, 0); PG8_STAGE(PG8_SA(0, 1), a2 + hstepA, voffA);
            PG8_WAIT_L(8); PG8_BAR; PG8_WAIT_L(0); PG8_MMA(0, 0, At, B0); PG8_BAR; PG8_SCHED;
            PG8_LDB(B1, 1, 1); PG8_STAGE(PG8_SB(1, 0), b3, voffB);
            PG8_BAR; PG8_WAIT_L(0); PG8_MMA(0, 1, At, B1); PG8_BAR;
            PG8_LDA(At, 1, 1); PG8_STAGE(PG8_SA(1, 0), a3, voffA);
            PG8_BAR; PG8_WAIT_L(0); PG8_MMA(1, 0, At, B0); PG8_BAR; PG8_SCHED;
            PG8_STAGE(PG8_SB(1, 1), b3 + hstepB, voffB);
            PG8_WAIT_V(6); PG8_BAR; PG8_MMA(1, 1, At, B1); PG8_BAR;
        }
        E(acc, cur, wr, wc, fr, fq);
        if (!has_next) break;
#pragma unroll
        for (int a = 0; a < 2; ++a)
#pragma unroll
            for (int b = 0; b < 2; ++b)
#pragma unroll
                for (int m = 0; m < 4; ++m)
#pragma unroll
                    for (int n = 0; n < 2; ++n) acc[a][b][m][n] = (f32x4){0.f, 0.f, 0.f, 0.f};
        cur = nxt; cA = nA; cB = nB; ++ui;
    }
    PG8_WAIT_V(0);
    if (wr == 0) PG8_BAR;
    PG8_BAR;
#undef PG8_SA
#undef PG8_SB
#undef PG8_STAGE
#undef PG8_LDA
#undef PG8_LDB
#undef PG8_MMA
#undef PG8_WAIT_V
#undef PG8_WAIT_L
#undef PG8_BAR
#undef PG8_SCHED
}

template <int MODE> struct EpiScaleBf16 {
    static constexpr bool PERM = true;
    bf16_t* O; int ldc; const float* rs;
    DI void operator()(const f32x4 (&acc)[2][2][4][2], const Unit& u, int wr, int wc, int fr, int fq) const {
        const int row0 = u.pm * BM + wr * 64 + fr, col0 = u.pn * BM + wc * 32 + 8 * fq;
#pragma unroll
        for (int ai = 0; ai < 2; ++ai)
#pragma unroll
            for (int m = 0; m < 4; ++m) {
                const int row = row0 + ai * HALF + m * 16;
                float sc = rs[row]; if (MODE == 1) sc = rsqrtf(sc * (1.f / 2048.f) + 1e-6f);
                bf16_t* rowp = O + (size_t)row * ldc + col0;
#pragma unroll
                for (int bj = 0; bj < 2; ++bj) {
                    const f32x4 v0 = acc[ai][bj][m][0] * sc, v1 = acc[ai][bj][m][1] * sc;
                    u32x4 w; w.x = pk2(v0[0], v0[1]); w.y = pk2(v0[2], v0[3]); w.z = pk2(v1[0], v1[1]); w.w = pk2(v1[2], v1[3]);
                    *(u32x4*)(rowp + bj * HALF) = w;
                }
            }
    }
};
struct EpiResid {
    static constexpr bool PERM = false;
    const float* R; float* H; bf16_t* HB; float* SS;
    DI void operator()(const f32x4 (&acc)[2][2][4][2], const Unit& u, int wr, int wc, int fr, int fq) const {
        const int row0 = u.pm * BM + wr * 64 + fr, col0 = u.pn * BM + wc * 32 + 4 * fq;
#pragma unroll
        for (int ai = 0; ai < 2; ++ai)
#pragma unroll
            for (int m = 0; m < 4; ++m) {
                const int row = row0 + ai * HALF + m * 16;
                const size_t ro = (size_t)row * DM + col0;
                float ss = 0.f;
#pragma unroll
                for (int bj = 0; bj < 2; ++bj)
#pragma unroll
                    for (int n = 0; n < 2; ++n) {
                        const size_t o = ro + bj * HALF + n * 16;
                        const f32x4 r = *(const f32x4*)(R + o);
                        const f32x4 v = acc[ai][bj][m][n] + r;
                        *(f32x4*)(H + o) = v;
                        ss += v[0] * v[0] + v[1] * v[1] + v[2] * v[2] + v[3] * v[3];
                        if (HB) { u32x2 w; w.x = pk2(v[0], v[1]); w.y = pk2(v[2], v[3]); *(u32x2*)(HB + o) = w; }
                    }
                if (SS) { ss += __shfl_xor(ss, 16); ss += __shfl_xor(ss, 32); if (fq == 0) atomicAdd(SS + row, ss); }
            }
    }
};
}

DI void tconv(const float* src, int K, int N, bf16_t* dst, int Npad, const float* rs, int mode, LAS float* tile) {
    const int tid = threadIdx.x, nkt = K / 64, ntiles = nkt * (Npad / 64);
    for (int tl = blockIdx.x; tl < ntiles; tl += gridDim.x) {
        const int kt = tl % nkt, ntb = tl / nkt, k0 = kt * 64, n0 = ntb * 64;
#pragma unroll
        for (int i = 0; i < 8; ++i) {
            const int idx = tid + i * 512, kk = idx >> 6, nn = idx & 63, n = n0 + nn;
            int sc = n < N ? n : -1; float scale = 1.f;
            if (mode == 1) { scale = (n >= 2048 && n < 4096) ? 0.0625f : 1.f; }
            if (mode == 2) {
                if (n < 5120) { sc = n; scale = n < 2048 ? 0.08838834764831845f : 1.f; }
                else if (n < 7168) sc = n + 48;
                else if (n < 7216) sc = n - 2048;
                else sc = -1;
            }
            float v = 0.f;
            if (sc >= 0) { v = src[(size_t)(k0 + kk) * N + sc] * scale; if (rs) v *= rs[k0 + kk]; }
            tile[kk * 65 + nn] = v;
        }
        __syncthreads();
#pragma unroll
        for (int i = 0; i < 8; ++i) {
            const int idx = tid + i * 512, nn = idx >> 6, kk = idx & 63;
            bf2_t t; t.x = (__bf16)tile[kk * 65 + nn]; t.y = t.x;
            dst[(size_t)(n0 + nn) * K + k0 + kk] = (bf16_t)(__builtin_bit_cast(unsigned, t) & 0xffffu);
        }
        __syncthreads();
    }
}

DI void phase0(const Params& p, LAS unsigned char* lds) {
    unsigned char* ws = p.ws;
    LAS float* tile = (LAS float*)lds;
    const int tid = threadIdx.x, lane = tid & 63, wave = tid >> 6;
    tconv(p.ret_w_in, 2048, 12288, (bf16_t*)(ws + OFF_W1T), 12288, p.norm_g, 1, tile);
    tconv(p.ret_w_out, 4096, 2048, (bf16_t*)(ws + OFF_W2T), 2048, nullptr, 0, tile);
    tconv(p.nsa_w_in, 2048, 7216, (bf16_t*)(ws + OFF_W3T), LD1, p.norm_g + 2048, 2, tile);
    tconv(p.nsa_w_out, 2048, 2048, (bf16_t*)(ws + OFF_W4T), 2048, nullptr, 0, tile);
    tconv(p.w1_k, 4096, 128, (bf16_t*)(ws + OFF_CW1K), 128, nullptr, 0, tile);
    tconv(p.w1_v, 4096, 128, (bf16_t*)(ws + OFF_CW1V), 128, nullptr, 0, tile);
    tconv(p.w2_k, 128, 128, (bf16_t*)(ws + OFF_CW2K), 128, nullptr, 0, tile);
    tconv(p.w2_v, 128, 128, (bf16_t*)(ws + OFF_CW2V), 128, nullptr, 0, tile);
    bf16_t* xb = (bf16_t*)(ws + OFF_XB); float* rstd0 = (float*)(ws + OFF_RSTD0); float* ss1 = (float*)(ws + OFF_SS1);
    for (int row = blockIdx.x * 8 + wave; row < T_; row += gridDim.x * 8) {
        const f32x4* xr = (const f32x4*)(p.x + (size_t)row * DM);
        f32x4 v[8]; float ss = 0.f;
#pragma unroll
        for (int i = 0; i < 8; ++i) { v[i] = xr[lane + 64 * i]; ss += v[i][0] * v[i][0] + v[i][1] * v[i][1] + v[i][2] * v[i][2] + v[i][3] * v[i][3]; }
        ss = wave_sum(ss);
        if (lane == 0) rstd0[row] = rsqrtf(ss * (1.f / 2048.f) + 1e-6f);
#pragma unroll
        for (int i = 0; i < 8; ++i) { u32x2 w; w.x = pk2(v[i][0], v[i][1]); w.y = pk2(v[i][2], v[i][3]); *(u32x2*)(xb + (size_t)row * DM + (lane + 64 * i) * 4) = w; }
    }
    for (int i = blockIdx.x * NTHREADS + tid; i < T_; i += gridDim.x * NTHREADS) ss1[i] = 0.f;
    float* cb = (float*)(ws + OFF_CB);
    for (int o = blockIdx.x * 8 + wave; o < 256; o += gridDim.x * 8) {
        const int kv = o >> 7, j = o & 127; const float* pos = kv ? p.pos_v : p.pos_k; const float* w1 = kv ? p.w1_v : p.w1_k;
        float s = 0.f;
        for (int i = lane; i < 4096; i += 64) s += pos[i] * w1[(size_t)i * 128 + j];
        s = wave_sum(s);
        if (lane == 0) cb[o] = s;
    }
}

DI void ret_intra(const bf16_t* PROJ, bf16_t* OI, LAS unsigned char* lds) {
    const int tid = threadIdx.x, lane = tid & 63, wave = tid >> 6, r32 = lane & 31, hh = lane >> 5;
    LAS bf16_t* Qs = (LAS bf16_t*)lds;
    LAS bf16_t* Ks = (LAS bf16_t*)(lds + 67584);
    LAS bf16_t* Ss = Qs;
    LAS bf16_t* VT0 = (LAS bf16_t*)(lds + 67584);
    for (int u = blockIdx.x; u < 2048; u += gridDim.x) {
        const int b = u >> 10, h = (u >> 7) & 7, ch = u & 127;
        const size_t t0 = (size_t)b * S_ + ch * 128;
        const float logg = log1pf(-exp2f(-5.f - (float)h));
#pragma unroll
        for (int i = 0; i < 8; ++i) {
            const int pc = tid + i * 512, row = pc >> 5, cs = pc & 31;
            const bf16_t* src = PROJ + (t0 + row) * LD0 + h * 256 + cs * 8;
            *(LAS u32x4*)(Qs + row * 264 + cs * 8) = *(const u32x4*)src;
            *(LAS u32x4*)(Ks + row * 264 + cs * 8) = *(const u32x4*)(src + 2048);
        }
        __syncthreads();
        const int nt = wave & 3, mtb = (wave >> 2) * 2;
        f32x16 sacc[2];
#pragma unroll
        for (int mi = 0; mi < 2; ++mi) {
            const int mt = mtb + mi; sacc[mi] = zero16();
            if (mt <= nt) {
#pragma unroll
                for (int s = 0; s < 16; ++s)
                    sacc[mi] = MFMA32(ldsfrag(Ks + (mt * 32 + r32) * 264 + 16 * s + 8 * hh), ldsfrag(Qs + (nt * 32 + r32) * 264 + 16 * s + 8 * hh), sacc[mi]);
            }
        }
        __syncthreads();
        const int n = nt * 32 + r32;
#pragma unroll
        for (int mi = 0; mi < 2; ++mi) {
            const int mt = mtb + mi;
#pragma unroll
            for (int G = 0; G < 4; ++G) {
                const int m0 = mt * 32 + 8 * G + 4 * hh;
                float v[4];
#pragma unroll
                for (int j = 0; j < 4; ++j) { const int df = n - (m0 + j); v[j] = df >= 0 ? sacc[mi][4 * G + j] * __expf((float)df * logg) : 0.f; }
                u32x2 w; w.x = pk2(v[0], v[1]); w.y = pk2(v[2], v[3]);
                *(LAS u32x2*)(Ss + n * 136 + m0) = w;
            }
        }
        const int vg = (tid & 3) + 4 * (tid >> 7), mg = (tid >> 2) & 31;
        auto stageVT = [&](int pz) {
            LAS bf16_t* VT = VT0 + (pz & 1) * (128 * 136);
            u32x4 R[4]; u32x2 o[8];
#pragma unroll
            for (int rr = 0; rr < 4; ++rr) R[rr] = *(const u32x4*)(PROJ + (t0 + 4 * mg + rr) * LD0 + 4096 + h * 512 + pz * 128 + 8 * vg);
            tr4x8(R, o);
#pragma unroll
            for (int jj = 0; jj < 8; ++jj) *(LAS u32x2*)(VT + (8 * vg + jj) * 136 + 4 * mg) = o[jj];
        };
        stageVT(0);
        const int vtb = (wave >> 2) * 2;
        for (int pz = 0; pz < 4; ++pz) {
            __syncthreads();
            if (pz < 3) stageVT(pz + 1);
            LAS bf16_t* VT = VT0 + (pz & 1) * (128 * 136);
#pragma unroll
            for (int vi = 0; vi < 2; ++vi) {
                const int vt = vtb + vi; f32x16 acc = zero16();
                for (int s = 0; s < 2 * (nt + 1); ++s)
                    acc = MFMA32(ldsfrag(VT + (vt * 32 + r32) * 136 + 16 * s + 8 * hh), ldsfrag(Ss + (nt * 32 + r32) * 136 + 16 * s + 8 * hh), acc);
#pragma unroll
                for (int G = 0; G < 4; ++G) {
                    const int v0 = pz * 128 + vt * 32 + 8 * G + 4 * hh;
                    u32x2 w; w.x = pk2(acc[4 * G], acc[4 * G + 1]); w.y = pk2(acc[4 * G + 2], acc[4 * G + 3]);
                    *(u32x2*)(OI + (t0 + n) * 4096 + h * 512 + v0) = w;
                }
            }
        }
        __syncthreads();
    }
}

DI void ret_inter(bf16_t* PROJ, const bf16_t* OI, LAS unsigned char* lds) {
    const int tid = threadIdx.x, lane = tid & 63, wave = tid >> 6, r32 = lane & 31, hh = lane >> 5;
    LAS bf16_t* KT = (LAS bf16_t*)lds;
    LAS bf16_t* VT = (LAS bf16_t*)(lds + 69632);
    LAS bf16_t* ST = (LAS bf16_t*)(lds + 69632 + 8704);
    for (int u = blockIdx.x; u < 256; u += gridDim.x) {
        const int b = u >> 7, h = (u >> 4) & 7, vs = u & 15, v0 = vs * 32;
        const float logg = log1pf(-exp2f(-5.f - (float)h));
        const float cd = __expf(128.f * logg);
        for (int i = tid; i < 32 * 264 / 2; i += NTHREADS) ((LAS unsigned*)ST)[i] = 0u;
        f32x16 sacc[2]; sacc[0] = zero16(); sacc[1] = zero16();
        u32x4 kreg[2][4]; u32x4 vreg;
        const int vm = tid >> 2, vgq = tid & 3;
        auto load_chunk = [&](int c) {
            const size_t t0 = (size_t)b * S_ + c * 128;
#pragma unroll
            for (int i = 0; i < 2; ++i) {
                const int bi = tid + 512 * i, dg = (bi & 3) + 4 * (bi >> 7), mg = (bi >> 2) & 31;
#pragma unroll
                for (int rr = 0; rr < 4; ++rr) kreg[i][rr] = *(const u32x4*)(PROJ + (t0 + 4 * mg + rr) * LD0 + 2048 + h * 256 + 8 * dg);
            }
            vreg = *(const u32x4*)(PROJ + (t0 + vm) * LD0 + 4096 + h * 512 + v0 + 8 * vgq);
        };
        load_chunk(0);
        for (int c = 0; c < 128; ++c) {
            const size_t t0 = (size_t)b * S_ + c * 128;
#pragma unroll
            for (int i = 0; i < 2; ++i) {
                const int bi = tid + 512 * i, dg = (bi & 3) + 4 * (bi >> 7), mg = (bi >> 2) & 31;
                u32x2 o[8]; tr4x8(kreg[i], o);
#pragma unroll
                for (int jj = 0; jj < 8; ++jj) *(LAS u32x2*)(KT + (8 * dg + jj) * 136 + 4 * mg) = o[jj];
            }
            {
                const float kd = __expf((float)(127 - vm) * logg);
#pragma unroll
                for (int d = 0; d < 4; ++d) {
                    const unsigned wv = vreg[d];
                    const unsigned a = pk2(bflo(wv) * kd, bfhi(wv) * kd);
                    VT[(8 * vgq + 2 * d) * 136 + vm] = (bf16_t)(a & 0xffffu);
                    VT[(8 * vgq + 2 * d + 1) * 136 + vm] = (bf16_t)(a >> 16);
                }
            }
            if (c + 1 < 128) load_chunk(c + 1);
            __syncthreads();
            if (wave < 4) {
                const int n = 32 * wave + r32; const size_t token = t0 + n;
                const bf16_t* qrow = PROJ + token * LD0 + h * 256 + 32 * hh;
                f32x16 acc = zero16();
#pragma unroll
                for (int kk = 0; kk < 4; ++kk) {
                    bf16x8 qf[4];
#pragma unroll
                    for (int j = 0; j < 4; ++j) qf[j] = *(const bf16x8*)(qrow + 64 * kk + 8 * j);
#pragma unroll
                    for (int j = 0; j < 4; ++j) acc = MFMA32(ldsfrag(ST + r32 * 264 + 64 * kk + 32 * hh + 8 * j), qf[j], acc);
                }
                const float qd = __expf((float)(n + 1) * logg);
#pragma unroll
                for (int G = 0; G < 4; ++G) {
                    const int vv = h * 512 + v0 + 8 * G + 4 * hh;
                    const u32x2 oi = *(const u32x2*)(OI + token * 4096 + vv);
                    u32x2 w;
                    w.x = pk2(bflo(oi.x) + acc[4 * G] * qd, bfhi(oi.x) + acc[4 * G + 1] * qd);
                    w.y = pk2(bflo(oi.y) + acc[4 * G + 2] * qd, bfhi(oi.y) + acc[4 * G + 3] * qd);
                    *(u32x2*)(PROJ + token * LD0 + 4096 + vv) = w;
                }
            } else {
#pragma unroll
                for (int ti = 0; ti < 2; ++ti) {
                    const int dt = 2 * (wave - 4) + ti;
                    sacc[ti] = sacc[ti] * cd;
#pragma unroll
                    for (int s = 0; s < 8; ++s)
                        sacc[ti] = MFMA32(ldsfrag(KT + (dt * 32 + r32) * 136 + 16 * s + 8 * hh), ldsfrag(VT + r32 * 136 + 16 * s + 8 * hh), sacc[ti]);
                }
            }
            __syncthreads();
            if (wave >= 4) {
#pragma unroll
                for (int ti = 0; ti < 2; ++ti) {
                    const int dt = 2 * (wave - 4) + ti;
#pragma unroll
                    for (int G = 0; G < 4; ++G) {
                        u32x2 w; w.x = pk2(sacc[ti][4 * G], sacc[ti][4 * G + 1]); w.y = pk2(sacc[ti][4 * G + 2], sacc[ti][4 * G + 3]);
                        *(LAS u32x2*)(ST + r32 * 264 + dt * 32 + 8 * G + 4 * hh) = w;
                    }
                }
            }
        }
        __syncthreads();
    }
}

DI void ret_gate(bf16_t* PROJ) {
    const int lane = threadIdx.x & 63, wave = threadIdx.x >> 6;
    const int nw = gridDim.x * 8, gw = blockIdx.x * 8 + wave;
    for (int task0 = gw * 4; task0 < T_ * 8; task0 += nw * 4) {
        u32x4 o8[4], g8[4];
#pragma unroll
        for (int q = 0; q < 4; ++q) {
            const int task = task0 + q; const size_t t = task >> 3; const int h = task & 7;
            o8[q] = *(const u32x4*)(PROJ + t * LD0 + 4096 + h * 512 + lane * 8);
            g8[q] = *(const u32x4*)(PROJ + t * LD0 + 8192 + h * 512 + lane * 8);
        }
#pragma unroll
        for (int q = 0; q < 4; ++q) {
            const int task = task0 + q; const size_t t = task >> 3; const int h = task & 7;
            float f[8], gt[8];
#pragma unroll
            for (int d = 0; d < 4; ++d) { f[2 * d] = bflo(o8[q][d]); f[2 * d + 1] = bfhi(o8[q][d]); gt[2 * d] = bflo(g8[q][d]); gt[2 * d + 1] = bfhi(g8[q][d]); }
            float s = 0.f;
#pragma unroll
            for (int d = 0; d < 8; ++d) s += f[d];
            const float mu = wave_sum(s) * (1.f / 512.f);
            float s2 = 0.f;
#pragma unroll
            for (int d = 0; d < 8; ++d) { f[d] -= mu; s2 += f[d] * f[d]; }
            const float rs = rsqrtf(wave_sum(s2) * (1.f / 512.f) + 1e-6f);
            u32x4 w;
#pragma unroll
            for (int d = 0; d < 4; ++d) w[d] = pk2(silu_f(gt[2 * d]) * f[2 * d] * rs, silu_f(gt[2 * d + 1]) * f[2 * d + 1] * rs);
            *(u32x4*)(PROJ + t * LD0 + 8192 + h * 512 + lane * 8) = w;
        }
    }
}

DI void nsa_compress(const bf16_t* P1, const unsigned char* ws, bf16_t* KC, bf16_t* VCT, bf16_t* VST, bf16_t* VWT, LAS unsigned char* lds) {
    const int tid = threadIdx.x, lane = tid & 63, wave = tid >> 6, r32 = lane & 31, hh = lane >> 5;
    LAS bf16_t* As = (LAS bf16_t*)lds;
    LAS bf16_t* Ws = (LAS bf16_t*)(lds + 17408);
    LAS bf16_t* Hs = (LAS bf16_t*)(lds + 17408 + 34816);
    const float* cb = (const float*)(ws + OFF_CB);
    for (int u = blockIdx.x; u < 256; u += gridDim.x) {
        const int kv = u >> 7, bg = (u >> 4) & 7, ct = u & 15, b = bg >> 2, g = bg & 3;
        const bf16_t* W1T = (const bf16_t*)(ws + (kv ? OFF_CW1V : OFF_CW1K));
        const bf16_t* W2T = (const bf16_t*)(ws + (kv ? OFF_CW2V : OFF_CW2K));
        const int colA = (kv ? C_VC : C_KC) + g * 128;
        const int ch = wave & 1, jt = wave >> 1;
        f32x16 acc = zero16();
        for (int l = 0; l < 32; ++l) {
            __syncthreads();
#pragma unroll
            for (int i = 0; i < 2; ++i) {
                const int pc = tid + 512 * i, row = pc >> 4, cs = pc & 15;
                int tok = 16 * (ct * 64 + row) + l; tok = tok < S_ ? tok : S_ - 1;
                *(LAS u32x4*)(As + row * 136 + cs * 8) = *(const u32x4*)(P1 + ((size_t)b * S_ + tok) * LD1 + colA + cs * 8);
            }
#pragma unroll
            for (int i = 0; i < 4; ++i) {
                const int pc = tid + 512 * i, row = pc >> 4, cs = pc & 15;
                *(LAS u32x4*)(Ws + row * 136 + cs * 8) = *(const u32x4*)(W1T + (size_t)row * 4096 + l * 128 + cs * 8);
            }
            __syncthreads();
#pragma unroll
            for (int s = 0; s < 8; ++s)
                acc = MFMA32(ldsfrag(Ws + (jt * 32 + r32) * 136 + 16 * s + 8 * hh), ldsfrag(As + (ch * 32 + r32) * 136 + 16 * s + 8 * hh), acc);
        }
#pragma unroll
        for (int G = 0; G < 4; ++G) {
            const int j0 = jt * 32 + 8 * G + 4 * hh;
            float v[4];
#pragma unroll
            for (int j = 0; j < 4; ++j) v[j] = silu_f(acc[4 * G + j] + cb[kv * 128 + j0 + j]);
            u32x2 w; w.x = pk2(v[0], v[1]); w.y = pk2(v[2], v[3]);
            *(LAS u32x2*)(Hs + (ch * 32 + r32) * 136 + j0) = w;
        }
        __syncthreads();
#pragma unroll
        for (int i = 0; i < 4; ++i) {
            const int pc = tid + 512 * i, row = pc >> 4, cs = pc & 15;
            *(LAS u32x4*)(Ws + row * 136 + cs * 8) = *(const u32x4*)(W2T + (size_t)row * 128 + cs * 8);
        }
        __syncthreads();
        f32x16 a2 = zero16();
        if (kv == 0) {
#pragma unroll
            for (int s = 0; s < 8; ++s)
                a2 = MFMA32(ldsfrag(Ws + (jt * 32 + r32) * 136 + 16 * s + 8 * hh), ldsfrag(Hs + (ch * 32 + r32) * 136 + 16 * s + 8 * hh), a2);
            const int c = ct * 64 + ch * 32 + r32;
#pragma unroll
            for (int G = 0; G < 4; ++G) {
                u32x2 w; w.x = pk2(a2[4 * G], a2[4 * G + 1]); w.y = pk2(a2[4 * G + 2], a2[4 * G + 3]);
                *(u32x2*)(KC + ((size_t)bg * 1024 + c) * 128 + jt * 32 + 8 * G + 4 * hh) = w;
            }
        } else {
#pragma unroll
            for (int s = 0; s < 8; ++s)
                a2 = MFMA32(ldsfrag(Hs + (ch * 32 + r32) * 136 + 16 * s + 8 * hh), ldsfrag(Ws + (jt * 32 + r32) * 136 + 16 * s + 8 * hh), a2);
            const int j2 = jt * 32 + r32;
#pragma unroll
            for (int G = 0; G < 4; ++G) {
                u32x2 w; w.x = pk2(a2[4 * G], a2[4 * G + 1]); w.y = pk2(a2[4 * G + 2], a2[4 * G + 3]);
                *(u32x2*)(VCT + ((size_t)bg * 128 + j2) * 1024 + ct * 64 + ch * 32 + 8 * G + 4 * hh) = w;
            }
        }
        __syncthreads();
    }
    {
        const int half = tid >> 8, t8 = tid & 255, dgq = (t8 & 3) + 4 * (t8 >> 6), mg = (t8 >> 2) & 15;
        for (int u2 = blockIdx.x * 2 + half; u2 < 4096; u2 += gridDim.x * 2) {
            const int which = u2 >> 11, bg = (u2 >> 8) & 7, jb = u2 & 255, b = bg >> 2, g = bg & 3;
            const int col = (which ? C_VW : C_VS) + g * 128;
            bf16_t* dst = which ? VWT : VST;
            u32x4 R[4]; u32x2 o[8];
#pragma unroll
            for (int rr = 0; rr < 4; ++rr) R[rr] = *(const u32x4*)(P1 + ((size_t)b * S_ + jb * 64 + 4 * mg + rr) * LD1 + col + 8 * dgq);
            tr4x8(R, o);
#pragma unroll
            for (int jj = 0; jj < 8; ++jj) *(u32x2*)(dst + ((size_t)bg * 128 + 8 * dgq + jj) * S_ + jb * 64 + 4 * mg) = o[jj];
        }
    }
}

DI float dpp_x1(float v) { return __int_as_float(__builtin_amdgcn_mov_dpp(__float_as_int(v), 0xB1, 0xF, 0xF, true)); }
DI float dpp_x2(float v) { return __int_as_float(__builtin_amdgcn_mov_dpp(__float_as_int(v), 0x4E, 0xF, 0xF, true)); }

DI void nsa_attn(const bf16_t* P1, const bf16_t* KC, const bf16_t* VCT, const bf16_t* VST, const bf16_t* VWT, bf16_t* Y1, LAS unsigned char* lds) {
    const int tid = threadIdx.x, lane = tid & 63, wave = tid >> 6, r32 = lane & 31, hh = lane >> 5;
    constexpr int KB_E = 64 * 136, VB_E = 128 * 72;
    LAS bf16_t* Kb = (LAS bf16_t*)lds;
    LAS bf16_t* Vb = (LAS bf16_t*)(lds + 2 * KB_E * 2);
    LAS unsigned char* r1base = lds + 2 * KB_E * 2 + 2 * VB_E * 2;
    LAS float* imp = (LAS float*)r1base;
    LAS bf16_t* R1 = (LAS bf16_t*)r1base;
    LAS unsigned* selm = (LAS unsigned*)(r1base + 67584);
    LAS unsigned* uni = selm + 512;
    LAS int* jcount = (LAS int*)(uni + 8);
    LAS unsigned char* jlist = (LAS unsigned char*)(uni + 16);
    const int G_ = gridDim.x;
    for (int U = blockIdx.x; U < 2048; U += G_) {
        const int bg = U >> 8, qidx = U & 255, qb = (bg & 1) ? 255 - qidx : qidx, b = bg >> 2, g = bg & 3;
        const int q0 = qb * 64, tkl = r32 >> 2, r = r32 & 3, head = g * 4 + r, tl = 8 * wave + tkl, t = q0 + tl;
        const unsigned token = (unsigned)b * S_ + t;
        const float slope = exp2f(-0.5f * (float)(head + 1));
        bf16x8 qf[8];
#pragma unroll
        for (int s = 0; s < 8; ++s) qf[s] = *(const bf16x8*)(P1 + token * LD1 + head * 128 + 16 * s + 8 * hh);
        float gsig[3];
#pragma unroll
        for (int br = 0; br < 3; ++br) gsig[br] = sigm_f(__uint_as_float((unsigned)P1[token * LD1 + C_G + head * 3 + br] << 16));
        if (tid < 8) uni[tid] = 0u;

        u32x4 pk[2], pv[2];
        auto issue = [&](const bf16_t* ksrc, unsigned kld, const bf16_t* vsrc, unsigned vld, bool withv) {
            unsigned tq = tid; asm volatile("" : "+v"(tq));
#pragma unroll
            for (int i = 0; i < 2; ++i) { const unsigned pc = tq + 512 * i; pk[i] = *(const u32x4*)(ksrc + ((pc >> 4) * kld + (pc & 15) * 8u)); }
            if (withv) {
#pragma unroll
                for (int i = 0; i < 2; ++i) { const unsigned pc = tq + 512 * i; pv[i] = *(const u32x4*)(vsrc + ((pc >> 3) * vld + (pc & 7) * 8u)); }
            }
        };
        auto commit = [&](int buf, bool withv) {
            int tq = tid; asm volatile("" : "+v"(tq));
#pragma unroll
            for (int i = 0; i < 2; ++i) { const int pc = tq + 512 * i; *(LAS u32x4*)(Kb + buf * KB_E + (pc >> 4) * 136 + (pc & 15) * 8) = pk[i]; }
            if (withv) {
#pragma unroll
                for (int i = 0; i < 2; ++i) { const int pc = tq + 512 * i; *(LAS u32x4*)(Vb + buf * VB_E + (pc >> 3) * 72 + (pc & 7) * 8) = pv[i]; }
            }
        };
        auto compS = [&](int buf, f32x16 (&S)[2]) {
            int ro = r32 * 136 + 8 * hh; asm volatile("" : "+v"(ro));
#pragma unroll
            for (int ct = 0; ct < 2; ++ct) {
                S[ct] = zero16();
#pragma unroll
                for (int s = 0; s < 8; ++s) S[ct] = MFMA32(ldsfrag(Kb + buf * KB_E + ct * 32 * 136 + ro + 16 * s), qf[s], S[ct]);
                __builtin_amdgcn_sched_barrier(0);
            }
        };
        auto compPV = [&](int buf, const f32x16 (&P)[2], f32x16 (&O)[4]) {
            int vo = r32 * 72 + 4 * hh; asm volatile("" : "+v"(vo));
#pragma unroll
            for (int s2 = 0; s2 < 4; ++s2) {
                const int ct = s2 >> 1, sh = s2 & 1;
                u32x4 pw;
#pragma unroll
                for (int d = 0; d < 4; ++d) pw[d] = pk2(P[ct][8 * sh + 2 * d], P[ct][8 * sh + 2 * d + 1]);
                const bf16x8 pf = __builtin_bit_cast(bf16x8, pw);
#pragma unroll
                for (int dt = 0; dt < 4; ++dt) {
                    const LAS bf16_t* vp = Vb + buf * VB_E + dt * 32 * 72 + vo + 16 * s2;
                    const s16x4 lo = *(const LAS s16x4*)vp, hi = *(const LAS s16x4*)(vp + 8);
                    const bf16x8 xf = __builtin_shufflevector(lo, hi, 0, 1, 2, 3, 4, 5, 6, 7);
                    O[dt] = MFMA32(xf, pf, O[dt]);
                }
                __builtin_amdgcn_sched_barrier(0);
            }
        };

        const int nkt = (4 * qb + 66) >> 6;
        const bf16_t* kcb = KC + (size_t)bg * 1024 * 128;
        const bf16_t* vcb = VCT + (size_t)bg * 128 * 1024;
        float m1 = -1e30f, l1 = 0.f;
        __syncthreads();
        issue(kcb, 128, vcb, 1024, false);
        for (int kt = 0; kt < nkt; ++kt) {
            const int buf = kt & 1;
            commit(buf, false);
            if (kt + 1 < nkt) issue(kcb + (size_t)(kt + 1) * 64 * 128, 128, vcb, 1024, false);
            __syncthreads();
            f32x16 S[2]; compS(buf, S);
            float mt = -1e30f;
            int d0 = t - 31 - 1024 * kt - 64 * hh; asm volatile("" : "+v"(d0));
#pragma unroll
            for (int ct = 0; ct < 2; ++ct)
#pragma unroll
                for (int i = 0; i < 16; ++i) {
                    const int dist = d0 - 16 * (32 * ct + (i & 3) + 8 * (i >> 2));
                    const float sv = dist >= 0 ? S[ct][i] - slope * (float)dist : -1e30f;
                    S[ct][i] = sv; mt = fmaxf(mt, sv);
                }
            const float mn = fmaxf(m1, mt);
            float ls = 0.f;
#pragma unroll
            for (int ct = 0; ct < 2; ++ct)
#pragma unroll
                for (int i = 0; i < 16; ++i) ls += S[ct][i] > -1e29f ? __expf(S[ct][i] - mn) : 0.f;
            l1 = l1 * __expf(m1 - mn) + ls; m1 = mn;
        }
        float Mx, invL;
        {
            const float mo = __shfl_xor(m1, 32), lo = __shfl_xor(l1, 32);
            Mx = fmaxf(m1, mo);
            const float L = l1 * __expf(m1 - Mx) + lo * __expf(mo - Mx);
            invL = L > 0.f ? 1.f / L : 0.f;
        }
        f32x16 O[4];
#pragma unroll
        for (int dt = 0; dt < 4; ++dt) O[dt] = zero16();
        float carry = 0.f;
        LAS float* impw = imp + (wave * 8 + tkl) * 257;
        __syncthreads();
        issue(kcb, 128, vcb, 1024, true);
        for (int kt = 0; kt < nkt; ++kt) {
            const int buf = kt & 1;
            commit(buf, true);
            if (kt + 1 < nkt) issue(kcb + (size_t)(kt + 1) * 64 * 128, 128, vcb + (kt + 1) * 64, 1024, true);
            __syncthreads();
            f32x16 S[2]; compS(buf, S);
            int d0 = t - 31 - 1024 * kt - 64 * hh; asm volatile("" : "+v"(d0));
#pragma unroll
            for (int ct = 0; ct < 2; ++ct)
#pragma unroll
                for (int i = 0; i < 16; ++i) {
                    const int dist = d0 - 16 * (32 * ct + (i & 3) + 8 * (i >> 2));
                    S[ct][i] = dist >= 0 ? __expf(S[ct][i] - slope * (float)dist - Mx) * invL : 0.f;
                }
            float X[2][4];
#pragma unroll
            for (int ct = 0; ct < 2; ++ct)
#pragma unroll
                for (int G = 0; G < 4; ++G) X[ct][G] = __shfl_xor(S[ct][4 * G + 3], 32);
#pragma unroll
            for (int ct = 0; ct < 2; ++ct)
#pragma unroll
                for (int G = 0; G < 4; ++G) {
                    const float prev0 = G > 0 ? X[ct][G - 1] : (ct > 0 ? X[0][3] : carry);
                    const float prev = hh ? X[ct][G] : prev0;
                    float tot = S[ct][4 * G] + S[ct][4 * G + 1] + S[ct][4 * G + 2] + S[ct][4 * G + 3] + prev;
                    tot += dpp_x1(tot); tot += dpp_x2(tot);
                    const int cq = 16 * kt + 8 * ct + 2 * G + hh;
                    if (r == 0) impw[cq] = tot;
                }
            carry = X[1][3];
            compPV(buf, S, O);
        }
        {
            const int cur = qb, nr = cur + 1 < 16 ? cur + 1 : 16;
            for (int tk = 0; tk < 8; ++tk) {
                const LAS float* iw = imp + (wave * 8 + tk) * 257;
                float v[4];
#pragma unroll
                for (int uu = 0; uu < 4; ++uu) {
                    const int j = lane + 64 * uu;
                    v[uu] = j > cur ? -3e38f : ((j == 0 || j == cur || j == cur - 1) ? 1e4f : iw[j]);
                }
                unsigned word = 0u;
                for (int rnd = 0; rnd < nr; ++rnd) {
                    float bv = v[0]; int bi = lane;
#pragma unroll
                    for (int uu = 1; uu < 4; ++uu) if (v[uu] > bv) { bv = v[uu]; bi = lane + 64 * uu; }
#pragma unroll
                    for (int o = 32; o >= 1; o >>= 1) {
                        const float ov = __shfl_xor(bv, o); const int oi = __shfl_xor(bi, o);
                        if (ov > bv || (ov == bv && oi < bi)) { bv = ov; bi = oi; }
                    }
#pragma unroll
                    for (int uu = 0; uu < 4; ++uu) if (bi == lane + 64 * uu) v[uu] = -3e38f;
                    if ((bi >> 5) == lane) word |= 1u << (bi & 31);
                }
                if (lane < 8) { selm[(wave * 8 + tk) * 8 + lane] = word; if (word) atomicOr((unsigned*)(uni + lane), word); }
            }
        }
        __syncthreads();
        {
            LAS bf16_t* rp = R1 + (wave * 32 + r32) * 132;
#pragma unroll
            for (int dt = 0; dt < 4; ++dt)
#pragma unroll
                for (int G = 0; G < 4; ++G) {
                    u32x2 w; w.x = pk2(O[dt][4 * G] * gsig[0], O[dt][4 * G + 1] * gsig[0]); w.y = pk2(O[dt][4 * G + 2] * gsig[0], O[dt][4 * G + 3] * gsig[0]);
                    *(LAS u32x2*)(rp + dt * 32 + 8 * G + 4 * hh) = w;
                }
            if (tid == 0) {
                int n = 0;
                for (int w = 0; w < 8; ++w) { unsigned m = uni[w]; while (m) { const int bit = __builtin_ctz(m); m &= m - 1; jlist[n++] = (unsigned char)(32 * w + bit); } }
                *jcount = n;
            }
        }
        __syncthreads();
        float mr, lr;
        auto flash_tile = [&](int buf, int kbase, bool rowsel, int wlim) {
            f32x16 S[2]; compS(buf, S);
            float mt = -1e30f;
            int d0 = t - kbase - 4 * hh; asm volatile("" : "+v"(d0));
#pragma unroll
            for (int ct = 0; ct < 2; ++ct)
#pragma unroll
                for (int i = 0; i < 16; ++i) {
                    const int dist = d0 - (32 * ct + (i & 3) + 8 * (i >> 2));
                    const float sv = (rowsel && dist >= 0 && dist < wlim) ? S[ct][i] - slope * (float)dist : -1e30f;
                    S[ct][i] = sv; mt = fmaxf(mt, sv);
                }
            mt = fmaxf(mt, __shfl_xor(mt, 32));
            const float mn = fmaxf(mr, mt), alpha = __expf(mr - mn);
            float ls = 0.f;
#pragma unroll
            for (int ct = 0; ct < 2; ++ct)
#pragma unroll
                for (int i = 0; i < 16; ++i) { const float pe = S[ct][i] > -1e29f ? __expf(S[ct][i] - mn) : 0.f; S[ct][i] = pe; ls += pe; }
            lr = lr * alpha + ls; mr = mn;
#pragma unroll
            for (int dt = 0; dt < 4; ++dt) O[dt] = O[dt] * alpha;
            compPV(buf, S, O);
        };
        {
            const int nj = __builtin_amdgcn_readfirstlane(*jcount);
            mr = -1e30f; lr = 0.f;
#pragma unroll
            for (int dt = 0; dt < 4; ++dt) O[dt] = zero16();
            const bf16_t* ksb = P1 + (size_t)b * S_ * LD1 + C_KS + g * 128;
            const bf16_t* vsb = VST + (size_t)bg * 128 * S_;
            { const int j = __builtin_amdgcn_readfirstlane((int)jlist[0]); issue(ksb + (size_t)j * 64 * LD1, LD1, vsb + j * 64, S_, true); }
            for (int i = 0; i < nj; ++i) {
                const int buf = i & 1, j = __builtin_amdgcn_readfirstlane((int)jlist[i]);
                commit(buf, true);
                if (i + 1 < nj) { const int jn = __builtin_amdgcn_readfirstlane((int)jlist[i + 1]); issue(ksb + (size_t)jn * 64 * LD1, LD1, vsb + jn * 64, S_, true); }
                __syncthreads();
                const bool rowsel = (selm[tl * 8 + (j >> 5)] >> (j & 31)) & 1u;
                if (__any(rowsel)) flash_tile(buf, 64 * j, rowsel, 1 << 30);
            }
            const float lt = lr + __shfl_xor(lr, 32), inv = gsig[1] / lt;
            LAS bf16_t* rp = R1 + (wave * 32 + r32) * 132;
#pragma unroll
            for (int dt = 0; dt < 4; ++dt)
#pragma unroll
                for (int G = 0; G < 4; ++G) {
                    LAS u32x2* q = (LAS u32x2*)(rp + dt * 32 + 8 * G + 4 * hh);
                    const u32x2 old = *q; u32x2 w;
                    w.x = pk2(bflo(old.x) + O[dt][4 * G] * inv, bfhi(old.x) + O[dt][4 * G + 1] * inv);
                    w.y = pk2(bflo(old.y) + O[dt][4 * G + 2] * inv, bfhi(old.y) + O[dt][4 * G + 3] * inv);
                    *q = w;
                }
        }
        {
            mr = -1e30f; lr = 0.f;
#pragma unroll
            for (int dt = 0; dt < 4; ++dt) O[dt] = zero16();
            const bf16_t* kwb = P1 + (size_t)b * S_ * LD1 + C_KW + g * 128;
            const bf16_t* vwb = VWT + (size_t)bg * 128 * S_;
            const int j0 = qb - 8 > 0 ? qb - 8 : 0, nj = qb - j0 + 1;
            __syncthreads();
            issue(kwb + (size_t)j0 * 64 * LD1, LD1, vwb + j0 * 64, S_, true);
            for (int i = 0; i < nj; ++i) {
                const int buf = i & 1, j = j0 + i;
                commit(buf, true);
                if (i + 1 < nj) issue(kwb + (size_t)(j + 1) * 64 * LD1, LD1, vwb + (j + 1) * 64, S_, true);
                __syncthreads();
                flash_tile(buf, 64 * j, true, 512);
            }
            const float lt = lr + __shfl_xor(lr, 32), inv = gsig[2] / lt;
            const LAS bf16_t* rp = R1 + (wave * 32 + r32) * 132;
#pragma unroll
            for (int dt = 0; dt < 4; ++dt)
#pragma unroll
                for (int G = 0; G < 4; ++G) {
                    const int d0 = dt * 32 + 8 * G + 4 * hh;
                    const u32x2 old = *(const LAS u32x2*)(rp + d0);
                    const u32x2 zz = *(const u32x2*)(P1 + token * LD1 + C_Z + head * 128 + d0);
                    u32x2 w;
                    w.x = pk2(silu_f(bflo(zz.x)) * (bflo(old.x) + O[dt][4 * G] * inv), silu_f(bfhi(zz.x)) * (bfhi(old.x) + O[dt][4 * G + 1] * inv));
                    w.y = pk2(silu_f(bflo(zz.y)) * (bflo(old.y) + O[dt][4 * G + 2] * inv), silu_f(bfhi(zz.y)) * (bfhi(old.y) + O[dt][4 * G + 3] * inv));
                    *(u32x2*)(Y1 + token * DM + head * 128 + d0) = w;
                }
        }
        __syncthreads();
    }
}

DI void final_norm(float* out, const float* fg) {
    const int lane = threadIdx.x & 63, wave = threadIdx.x >> 6;
    for (int row = blockIdx.x * 8 + wave; row < T_; row += gridDim.x * 8) {
        f32x4* xr = (f32x4*)(out + (size_t)row * DM);
        f32x4 v[8]; float ss = 0.f;
#pragma unroll
        for (int i = 0; i < 8; ++i) { v[i] = xr[lane + 64 * i]; ss += v[i][0] * v[i][0] + v[i][1] * v[i][1] + v[i][2] * v[i][2] + v[i][3] * v[i][3]; }
        ss = wave_sum(ss);
        const float rs = rsqrtf(ss * (1.f / 2048.f) + 1e-6f);
#pragma unroll
        for (int i = 0; i < 8; ++i) { const f32x4 gq = ((const f32x4*)fg)[lane + 64 * i]; xr[lane + 64 * i] = v[i] * rs * gq; }
    }
}

constexpr int NPHASE = 11;
__global__ void __launch_bounds__(NTHREADS, 2) fwd_kernel(Params p) {
    extern __shared__ __attribute__((aligned(16))) unsigned char lds_raw[];
    LAS unsigned char* lds = (LAS unsigned char*)lds_raw;
    unsigned char* ws = p.ws;
    bf16_t* PROJ = (bf16_t*)(ws + OFF_PROJ);
    bf16_t* XB = (bf16_t*)(ws + OFF_XB);
    const int lo = p.ph_lo, hi = p.ph_hi;
#ifndef PHMASK
#define PHMASK 0x7ff
#endif
#define IN(k) (((PHMASK >> (k)) & 1) && lo <= (k) && (k) < hi)
#define SEAM(k) do { if ((k) + 1 < hi) { cg::this_grid().sync(); } } while (0)
    if (IN(0)) { phase0(p, lds); SEAM(0); }
    if (IN(1)) {
        pg8::Gemm g{XB, (const bf16_t*)(ws + OFF_W1T), 2048, 2048, T_, 12288, 2048}; pg8::StaticOrder S; S.init(T_, 12288, gridDim.x, blockIdx.x);
        pg8::EpiScaleBf16<0> E{PROJ, LD0, (const float*)(ws + OFF_RSTD0)};
        pg8::gemm_phase(lds, g, S, E); SEAM(1);
    }
    if (IN(2)) { ret_intra(PROJ, (bf16_t*)p.out, lds); SEAM(2); }
    if (IN(3)) { ret_inter(PROJ, (const bf16_t*)p.out, lds); SEAM(3); }
    if (IN(4)) { ret_gate(PROJ); SEAM(4); }
    if (IN(5)) {
        pg8::Gemm g{PROJ + 8192, (const bf16_t*)(ws + OFF_W2T), LD0, 4096, T_, 2048, 4096}; pg8::StaticOrder S; S.init(T_, 2048, gridDim.x, blockIdx.x);
        pg8::EpiResid E{p.x, p.out, XB, (float*)(ws + OFF_SS1)};
        pg8::gemm_phase(lds, g, S, E); SEAM(5);
    }
    if (IN(6)) {
        pg8::Gemm g{XB, (const bf16_t*)(ws + OFF_W3T), 2048, 2048, T_, LD1, 2048}; pg8::StaticOrder S; S.init(T_, LD1, gridDim.x, blockIdx.x);
        pg8::EpiScaleBf16<1> E{PROJ, LD1, (const float*)(ws + OFF_SS1)};
        pg8::gemm_phase(lds, g, S, E); SEAM(6);
    }
    if (IN(7)) { nsa_compress(PROJ, ws, (bf16_t*)(ws + OFF_KC), (bf16_t*)(ws + OFF_VCT), (bf16_t*)(ws + OFF_VST), (bf16_t*)(ws + OFF_VWT), lds); SEAM(7); }
    if (IN(8)) { nsa_attn(PROJ, (const bf16_t*)(ws + OFF_KC), (const bf16_t*)(ws + OFF_VCT), (const bf16_t*)(ws + OFF_VST), (const bf16_t*)(ws + OFF_VWT), XB, lds); SEAM(8); }
    if (IN(9)) {
        pg8::Gemm g{XB, (const bf16_t*)(ws + OFF_W4T), 2048, 2048, T_, 2048, 2048}; pg8::StaticOrder S; S.init(T_, 2048, gridDim.x, blockIdx.x);
        pg8::EpiResid E{p.out, p.out, nullptr, nullptr};
        pg8::gemm_phase(lds, g, S, E); SEAM(9);
    }
    if (IN(10)) { final_norm(p.out, p.final_g); }
#undef IN
#undef SEAM
}

extern "C" void kernel_launch(void* const* d_in, const int* in_sizes, int n_in, void* d_out, int out_size, void* d_ws, size_t ws_size, hipStream_t stream) {
    static int grid = 0;
    if (grid == 0) {
        if (n_in != 13 || out_size != T_ * DM || ws_size < WS_END) { fprintf(stderr, "kernel_launch: unexpected shapes (n_in %d out %d ws %zu need %zu)\n", n_in, out_size, ws_size, (size_t)WS_END); grid = -1; return; }
        int dev = 0, cus = 0, per_cu = 0;
        hipGetDevice(&dev); hipDeviceGetAttribute(&cus, hipDeviceAttributeMultiprocessorCount, dev);
        if (hipFuncSetAttribute((const void*)fwd_kernel, hipFuncAttributeMaxDynamicSharedMemorySize, LDS_BYTES) != hipSuccess) { fprintf(stderr, "kernel_launch: hipFuncSetAttribute failed\n"); grid = -1; return; }
        hipOccupancyMaxActiveBlocksPerMultiprocessor(&per_cu, (const void*)fwd_kernel, NTHREADS, LDS_BYTES);
        (void)hipGetLastError();
        if (per_cu < 1) per_cu = 1;
        grid = cus * 1;
    }
    if (grid < 0) return;
    Params p{};
    p.x = (const float*)d_in[0]; p.norm_g = (const float*)d_in[1]; p.ret_w_in = (const float*)d_in[2]; p.ret_w_out = (const float*)d_in[3];
    p.nsa_w_in = (const float*)d_in[4]; p.pos_k = (const float*)d_in[5]; p.w1_k = (const float*)d_in[6]; p.w2_k = (const float*)d_in[7];
    p.pos_v = (const float*)d_in[8]; p.w1_v = (const float*)d_in[9]; p.w2_v = (const float*)d_in[10]; p.nsa_w_out = (const float*)d_in[11];
    p.final_g = (const float*)d_in[12]; p.out = (float*)d_out; p.ws = (unsigned char*)d_ws;
#if SINGLE_LAUNCH
    p.ph_lo = 0; p.ph_hi = NPHASE;
    void* args[] = {&p};
    hipError_t e = hipLaunchCooperativeKernel((const void*)fwd_kernel, dim3(grid), dim3(NTHREADS), args, LDS_BYTES, stream);
    if (e != hipSuccess) fprintf(stderr, "cooperative launch failed: %s (grid %d)\n", hipGetErrorString(e), grid);
#else
    for (int k = 0; k < NPHASE; ++k) {
        p.ph_lo = k; p.ph_hi = k + 1;
        hipLaunchKernelGGL(fwd_kernel, dim3(grid), dim3(NTHREADS), LDS_BYTES, stream, p);
    }
#endif
}
```

```cpp
#include <hip/hip_runtime.h>
#include <hip/hip_cooperative_groups.h>
#include <cstdio>
namespace cg = cooperative_groups;

#ifndef SINGLE_LAUNCH
#define SINGLE_LAUNCH 1
#endif

#define DI __device__ __forceinline__
#define LAS __attribute__((address_space(3)))
typedef unsigned short bf16_t;
typedef short bf16x8 __attribute__((ext_vector_type(8)));
typedef short s16x4 __attribute__((ext_vector_type(4)));
typedef float f32x4 __attribute__((ext_vector_type(4)));
typedef float f32x16 __attribute__((ext_vector_type(16)));
typedef unsigned u32x4 __attribute__((ext_vector_type(4)));
typedef unsigned u32x2 __attribute__((ext_vector_type(2)));
typedef __bf16 bf2_t __attribute__((ext_vector_type(2)));

constexpr int T_ = 32768, S_ = 16384, DM = 2048;
constexpr int LD0 = 12288;
constexpr int LD1 = 7424;
constexpr int C_KC = 2048, C_VC = 2560, C_KS = 3072, C_VS = 3584, C_KW = 4096, C_VW = 4608, C_Z = 5120, C_G = 7168;
constexpr int NTHREADS = 512;
constexpr int LDS_BYTES = 160 * 1024;

constexpr size_t OFF_W1T = 0;
constexpr size_t OFF_W2T = OFF_W1T + (size_t)12288 * 2048 * 2;
constexpr size_t OFF_W3T = OFF_W2T + (size_t)2048 * 4096 * 2;
constexpr size_t OFF_W4T = OFF_W3T + (size_t)LD1 * 2048 * 2;
constexpr size_t OFF_CW1K = OFF_W4T + (size_t)2048 * 2048 * 2;
constexpr size_t OFF_CW1V = OFF_CW1K + (size_t)128 * 4096 * 2;
constexpr size_t OFF_CW2K = OFF_CW1V + (size_t)128 * 4096 * 2;
constexpr size_t OFF_CW2V = OFF_CW2K + (size_t)128 * 128 * 2;
constexpr size_t OFF_CB = OFF_CW2V + (size_t)128 * 128 * 2;
constexpr size_t OFF_RSTD0 = OFF_CB + 1024;
constexpr size_t OFF_SS1 = OFF_RSTD0 + (size_t)T_ * 4;
constexpr size_t OFF_KC = OFF_SS1 + (size_t)T_ * 4;
constexpr size_t OFF_VCT = OFF_KC + (size_t)8 * 1024 * 128 * 2;
constexpr size_t OFF_XB = OFF_VCT + (size_t)8 * 1024 * 128 * 2;
constexpr size_t OFF_PROJ = OFF_XB + (size_t)T_ * 2048 * 2;
constexpr size_t OFF_VST = OFF_PROJ + (size_t)T_ * LD1 * 2;
constexpr size_t OFF_VWT = OFF_VST + (size_t)8 * 128 * S_ * 2;
constexpr size_t OFF_KS2 = OFF_VWT + (size_t)8 * 128 * S_ * 2;
constexpr size_t OFF_KW2 = OFF_KS2 + (size_t)8 * 128 * S_ * 2;
constexpr size_t OFF_BAR = OFF_PROJ + (size_t)T_ * LD0 * 2;
constexpr size_t OFF_KINF = OFF_BAR + 15360;
constexpr size_t WS_END = OFF_BAR + 16384;
static_assert(OFF_KW2 + (size_t)8 * 128 * S_ * 2 <= WS_END, "ws map");

struct Params {
    const float* x; const float* norm_g; const float* ret_w_in; const float* ret_w_out; const float* nsa_w_in;
    const float* pos_k; const float* w1_k; const float* w2_k; const float* pos_v; const float* w1_v; const float* w2_v;
    const float* nsa_w_out; const float* final_g; float* out; unsigned char* ws; int ph_lo, ph_hi;
};

DI unsigned pk2(float lo, float hi) { bf2_t v; v.x = (__bf16)lo; v.y = (__bf16)hi; return __builtin_bit_cast(unsigned, v); }
DI float bflo(unsigned u) { return __uint_as_float(u << 16); }
DI float bfhi(unsigned u) { return __uint_as_float(u & 0xffff0000u); }
#define DPPF(v, ctrl) __int_as_float(__builtin_amdgcn_mov_dpp(__float_as_int(v), (ctrl), 0xF, 0xF, true))
DI float wave_sum(float v) {
    v += DPPF(v, 0xB1);
    v += DPPF(v, 0x4E);
    v += DPPF(v, 0x141);
    v += DPPF(v, 0x140);
    return (__int_as_float(__builtin_amdgcn_readlane(__float_as_int(v), 0)) + __int_as_float(__builtin_amdgcn_readlane(__float_as_int(v), 16))) +
           (__int_as_float(__builtin_amdgcn_readlane(__float_as_int(v), 32)) + __int_as_float(__builtin_amdgcn_readlane(__float_as_int(v), 48)));
}
DI void lds_barrier() { asm volatile("s_waitcnt lgkmcnt(0)\n\ts_barrier" ::: "memory"); }
DI float silu_f(float x) { return x / (1.f + __expf(-x)); }
DI float sigm_f(float x) { return 1.f / (1.f + __expf(-x)); }
DI int crow(int i, int hh) { return (i & 3) + 8 * (i >> 2) + 4 * hh; }
#define MFMA32(a, b, c) __builtin_amdgcn_mfma_f32_32x32x16_bf16((a), (b), (c), 0, 0, 0)
DI f32x16 zero16() { f32x16 z; for (int i = 0; i < 16; ++i) z[i] = 0.f; return z; }
DI bf16x8 ldsfrag(const LAS bf16_t* p) { return *(const LAS bf16x8*)p; }
DI void tr4x8(const u32x4 (&R)[4], u32x2 (&o)[8]) {
#pragma unroll
    for (int d = 0; d < 4; ++d) {
        const unsigned a0 = R[0][d], a1 = R[1][d], a2 = R[2][d], a3 = R[3][d];
        o[2 * d][0] = (a0 & 0xffffu) | (a1 << 16); o[2 * d][1] = (a2 & 0xffffu) | (a3 << 16);
        o[2 * d + 1][0] = (a0 >> 16) | (a1 & 0xffff0000u); o[2 * d + 1][1] = (a2 >> 16) | (a3 & 0xffff0000u);
    }
}

namespace pg8 {
constexpr int BM = 256, BK = 64, HALF = 128, HTB = HALF * BK * 2, STAGE_BYTES = 8 * HTB, NXCD = 8, WGM = 8;
DI int lds_byte(int r, int c) { const int st = (r >> 4) * 2 + (c >> 5), rr = r & 15, cc = c & 31, ob = rr * 64 + cc * 2; return st * 1024 + (ob ^ (((ob >> 9) & 1) << 5)); }
DI void stage_rc(int b, int& R, int& C) { const int st = b / 1024, sb = b % 1024, swz = sb ^ (((sb >> 9) & 1) << 5); R = (st >> 1) * 16 + swz / 64; C = (st & 1) * 32 + (swz % 64) / 2; }
DI int perm32(int rho) { const int n = rho >> 4, i = rho & 15; return 8 * (i >> 2) + 4 * n + (i & 3); }
struct Unit { int pm, pn; };
struct Gemm { const bf16_t* A; const bf16_t* Bt; int lda, ldb, M, N, K; };
struct StaticOrder {
    int nM, nN, nwg, G, c;
    DI void init(int M, int N, int G_, int c_) { nM = M / BM; nN = N / BM; nwg = nM * nN; G = G_; c = c_; }
    DI bool next(int i, Unit& u) const {
        const long L = (long)i * G + c; if (L >= nwg) return false;
        int wgid = (int)L; { const int q = nwg / NXCD, r = nwg % NXCD, xcd = wgid % NXCD, off = wgid / NXCD; wgid = (xcd < r ? xcd * (q + 1) : r * (q + 1) + (xcd - r) * q) + off; }
        const int nig = WGM * nN, gid = wgid / nig, fm = gid * WGM, gsz = (nM - fm) < WGM ? (nM - fm) : WGM;
        u.pm = fm + ((wgid % nig) % gsz); u.pn = (wgid % nig) / gsz; return true;
    }
};

template <class Epi>
DI void gemm_phase(LAS unsigned char* lds, const Gemm g, const StaticOrder& S, const Epi& E) {
    const int tid = threadIdx.x, wid = __builtin_amdgcn_readfirstlane(tid >> 6), lane = tid & 63, wr = wid >> 2, wc = wid & 3, fr = lane & 15, fq = lane >> 4;
    const int K = g.K, nt = K / BK;
    unsigned voffA[2], voffB[2];
#pragma unroll
    for (int i = 0; i < 2; ++i) { int R, C; stage_rc(tid * 16 + i * 8192, R, C); const int Rb = Epi::PERM ? ((R & ~31) + perm32(R & 31)) : R;
        voffA[i] = (unsigned)(R * g.lda + C) * 2u; voffB[i] = (unsigned)(Rb * g.ldb + C) * 2u; }
    const size_t kstep = (size_t)(BK * 2);
    const size_t hstepA = (size_t)HALF * g.lda * 2, hstepB = (size_t)HALF * g.ldb * 2;
    const size_t tstepA = 2 * hstepA, tstepB = 2 * hstepB;
    const unsigned ldsw = (unsigned)wid * 1024u;
    const int aoff = lds_byte(wr * 64 + fr, fq * 8), boff = lds_byte(wc * 32 + fr, fq * 8);
#define PG8_SA(b, h) (((b) * 2 + (h)) * HTB)
#define PG8_SB(b, h) ((4 + (b) * 2 + (h)) * HTB)
#define PG8_STAGE(bufoff, gbase, voff) do { _Pragma("unroll") for (int _i = 0; _i < 2; ++_i) \
        __builtin_amdgcn_global_load_lds((const unsigned*)((const char*)(gbase) + (voff)[_i]), (LAS unsigned*)(lds + (bufoff) + ldsw + _i * 8192), 16, 0, 0); } while (0)
#define PG8_LDA(dst, b, h) do { _Pragma("unroll") for (int m = 0; m < 4; ++m) _Pragma("unroll") for (int k = 0; k < 2; ++k) dst[m][k] = *(const LAS bf16x8*)(lds + PG8_SA(b, h) + aoff + m * 2048 + k * 1024); } while (0)
#define PG8_LDB(dst, b, h) do { _Pragma("unroll") for (int n = 0; n < 2; ++n) _Pragma("unroll") for (int k = 0; k < 2; ++k) dst[n][k] = *(const LAS bf16x8*)(lds + PG8_SB(b, h) + boff + n * 2048 + k * 1024); } while (0)
#define PG8_MMA(ai, bj, At, Bt) do { __builtin_amdgcn_s_setprio(1); _Pragma("unroll") for (int m = 0; m < 4; ++m) _Pragma("unroll") for (int n = 0; n < 2; ++n) _Pragma("unroll") for (int k = 0; k < 2; ++k) \
        acc[ai][bj][m][n] = __builtin_amdgcn_mfma_f32_16x16x32_bf16(Bt[n][k], At[m][k], acc[ai][bj][m][n], 0, 0, 0); __builtin_amdgcn_s_setprio(0); } while (0)
#define PG8_WAIT_V(n) asm volatile("s_waitcnt vmcnt(" #n ")" ::: "memory")
#define PG8_WAIT_L(n) asm volatile("s_waitcnt lgkmcnt(" #n ")" ::: "memory")
#define PG8_BAR __builtin_amdgcn_s_barrier()
#define PG8_SCHED __builtin_amdgcn_sched_barrier(0)
    Unit cur, nxt; int ui = 0;
    if (!S.next(0, cur)) return;
    f32x4 acc[2][2][4][2];
#pragma unroll
    for (int a = 0; a < 2; ++a)
#pragma unroll
        for (int b = 0; b < 2; ++b)
#pragma unroll
            for (int m = 0; m < 4; ++m)
#pragma unroll
                for (int n = 0; n < 2; ++n) acc[a][b][m][n] = (f32x4){0.f, 0.f, 0.f, 0.f};
    bf16x8 At[4][2], B0[2][2], B1[2][2];
    const char* cA = (const char*)g.A + (size_t)cur.pm * tstepA; const char* cB = (const char*)g.Bt + (size_t)cur.pn * tstepB;
    PG8_STAGE(PG8_SB(0, 0), cB, voffB); PG8_STAGE(PG8_SA(0, 0), cA, voffA); PG8_STAGE(PG8_SB(0, 1), cB + hstepB, voffB); PG8_STAGE(PG8_SA(0, 1), cA + hstepA, voffA);
    if (wr == 1) PG8_BAR;
    PG8_WAIT_V(4); PG8_BAR;
    PG8_STAGE(PG8_SB(1, 0), cB + kstep, voffB); PG8_STAGE(PG8_SA(1, 0), cA + kstep, voffA); PG8_STAGE(PG8_SB(1, 1), cB + hstepB + kstep, voffB);
    PG8_WAIT_V(6); PG8_BAR;
    for (;;) {
        const bool has_next = S.next(ui + 1, nxt);
        const char* nA = has_next ? (const char*)g.A + (size_t)nxt.pm * tstepA : cA; const char* nB = has_next ? (const char*)g.Bt + (size_t)nxt.pn * tstepB : cB;
        for (int t = 0; t < nt; t += 2) {
            const bool last = (t == nt - 2);
            const char* a1 = cA + (size_t)(t + 1) * kstep;
            const char* a2 = last ? nA : cA + (size_t)(t + 2) * kstep; const char* b2 = last ? nB : cB + (size_t)(t + 2) * kstep;
            const char* a3 = a2 + kstep; const char* b3 = b2 + kstep;
            PG8_LDB(B0, 0, 0); PG8_SCHED; PG8_LDA(At, 0, 0); PG8_STAGE(PG8_SA(1, 1), a1 + hstepA, voffA);
            PG8_WAIT_L(8); PG8_BAR; PG8_WAIT_L(0); PG8_MMA(0, 0, At, B0); PG8_BAR; PG8_SCHED;
            PG8_LDB(B1, 0, 1); PG8_STAGE(PG8_SB(0, 0), b2, voffB);
            PG8_BAR; PG8_WAIT_L(0); PG8_MMA(0, 1, At, B1); PG8_BAR;
            PG8_LDA(At, 0, 1); PG8_STAGE(PG8_SA(0, 0), a2, voffA);
            PG8_BAR; PG8_WAIT_L(0); PG8_MMA(1, 0, At, B0); PG8_BAR; PG8_SCHED;
            PG8_STAGE(PG8_SB(0, 1), b2 + hstepB, voffB);
            PG8_WAIT_V(6); PG8_BAR; PG8_MMA(1, 1, At, B1); PG8_BAR;
            PG8_LDB(B0, 1, 0); PG8_SCHED; PG8_LDA(At, 1, 0); PG8_STAGE(PG8_SA(0, 1), a2 + hstepA, voffA);
            PG8_WAIT_L(8); PG8_BAR; PG8_WAIT_L(0); PG8_MMA(0, 0, At, B0); PG8_BAR; PG8_SCHED;
            PG8_LDB(B1, 1, 1); PG8_STAGE(PG8_SB(1, 0), b3, voffB);
            PG8_BAR; PG8_WAIT_L(0); PG8_MMA(0, 1, At, B1); PG8_BAR;
            PG8_LDA(At, 1, 1); PG8_STAGE(PG8_SA(1, 0), a3, voffA);
            PG8_BAR; PG8_WAIT_L(0); PG8_MMA(1, 0, At, B0); PG8_BAR; PG8_SCHED;
            PG8_STAGE(PG8_SB(1, 1), b3 + hstepB, voffB);
            PG8_WAIT_V(6); PG8_BAR; PG8_MMA(1, 1, At, B1); PG8_BAR;
        }
        E(acc, cur, wr, wc, fr, fq);
        if (!has_next) break;
#pragma unroll
        for (int a = 0; a < 2; ++a)
#pragma unroll
            for (int b = 0; b < 2; ++b)
#pragma unroll
                for (int m = 0; m < 4; ++m)
#pragma unroll
                    for (int n = 0; n < 2; ++n) acc[a][b][m][n] = (f32x4){0.f, 0.f, 0.f, 0.f};
        cur = nxt; cA = nA; cB = nB; ++ui;
    }
    PG8_WAIT_V(0);
    if (wr == 0) PG8_BAR;
    PG8_BAR;
#undef PG8_SA
#undef PG8_SB
#undef PG8_STAGE
#undef PG8_LDA
#undef PG8_LDB
#undef PG8_MMA
#undef PG8_WAIT_V
#undef PG8_WAIT_L
#undef PG8_BAR
#undef PG8_SCHED
}

template <int MODE> struct EpiScaleBf16 {
    static constexpr bool PERM = true;
    bf16_t* O; int ldc; const float* rs;
    DI void operator()(const f32x4 (&acc)[2][2][4][2], const Unit& u, int wr, int wc, int fr, int fq) const {
        const int row0 = u.pm * BM + wr * 64 + fr, col0 = u.pn * BM + wc * 32 + 8 * fq;
#pragma unroll
        for (int ai = 0; ai < 2; ++ai)
#pragma unroll
            for (int m = 0; m < 4; ++m) {
                const int row = row0 + ai * HALF + m * 16;
                float sc = 1.f;
                if (MODE != 2) { sc = rs[row]; if (MODE == 1) sc = rsqrtf(sc * (1.f / 2048.f) + 1e-6f); }
                bf16_t* rowp = O + (size_t)row * ldc + col0;
#pragma unroll
                for (int bj = 0; bj < 2; ++bj) {
                    const f32x4 v0 = acc[ai][bj][m][0] * sc, v1 = acc[ai][bj][m][1] * sc;
                    u32x4 w; w.x = pk2(v0[0], v0[1]); w.y = pk2(v0[2], v0[3]); w.z = pk2(v1[0], v1[1]); w.w = pk2(v1[2], v1[3]);
                    *(u32x4*)(rowp + bj * HALF) = w;
                }
            }
    }
};
struct EpiResid {
    static constexpr bool PERM = false;
    const float* R; float* H; bf16_t* HB; float* SS;
    DI void operator()(const f32x4 (&acc)[2][2][4][2], const Unit& u, int wr, int wc, int fr, int fq) const {
        const int row0 = u.pm * BM + wr * 64 + fr, col0 = u.pn * BM + wc * 32 + 4 * fq;
#pragma unroll
        for (int ai = 0; ai < 2; ++ai)
#pragma unroll
            for (int m = 0; m < 4; ++m) {
                const int row = row0 + ai * HALF + m * 16;
                const size_t ro = (size_t)row * DM + col0;
                float ss = 0.f;
#pragma unroll
                for (int bj = 0; bj < 2; ++bj)
#pragma unroll
                    for (int n = 0; n < 2; ++n) {
                        const size_t o = ro + bj * HALF + n * 16;
                        const f32x4 r = *(const f32x4*)(R + o);
                        const f32x4 v = acc[ai][bj][m][n] + r;
                        *(f32x4*)(H + o) = v;
                        ss += v[0] * v[0] + v[1] * v[1] + v[2] * v[2] + v[3] * v[3];
                        if (HB) { u32x2 w; w.x = pk2(v[0], v[1]); w.y = pk2(v[2], v[3]); *(u32x2*)(HB + o) = w; }
                    }
                if (SS) { ss += __shfl_xor(ss, 16); ss += __shfl_xor(ss, 32); if (fq == 0) atomicAdd(SS + row, ss); }
            }
    }
};
}

DI void tconv(const float* src, int K, int N, bf16_t* dst, int Npad, const float* rs, int mode, LAS float* tile) {
    const int tid = threadIdx.x, nkt = K / 64, ntiles = nkt * (Npad / 128);
    float vv[16];
    auto ldt = [&](int tl) {
        const int kt = tl % nkt, ntb = tl / nkt, k0 = kt * 64, n0 = ntb * 128;
#pragma unroll
        for (int i = 0; i < 4; ++i) {
            const int idx = tid + i * 512, kk = idx >> 5, n = n0 + (idx & 31) * 4;
            int sc = n < N ? n : -1; float scale = 1.f;
            if (mode == 1) { scale = (n >= 2048 && n < 4096) ? 0.0625f : 1.f; }
            if (mode == 2) {
                if (n < 5120) { sc = n; scale = n < 2048 ? 0.12751743074602467f : 1.f; }
                else if (n < 7168) sc = n + 48;
                else if (n < 7216) sc = n - 2048;
                else sc = -1;
            }
            f32x4 v = (f32x4){0.f, 0.f, 0.f, 0.f};
            if (sc >= 0) { v = *(const f32x4*)(src + (size_t)(k0 + kk) * N + sc); if (rs) scale *= rs[k0 + kk]; v = v * scale; }
            vv[4 * i] = v[0]; vv[4 * i + 1] = v[1]; vv[4 * i + 2] = v[2]; vv[4 * i + 3] = v[3];
        }
    };
    if ((int)blockIdx.x < ntiles) ldt(blockIdx.x);
    for (int tl = blockIdx.x; tl < ntiles; tl += gridDim.x) {
        const int kt = tl % nkt, ntb = tl / nkt, k0 = kt * 64, n0 = ntb * 128;
#pragma unroll
        for (int i = 0; i < 4; ++i) { const int idx = tid + i * 512, kk = idx >> 5, nn = (idx & 31) * 4;
#pragma unroll
            for (int e = 0; e < 4; ++e) tile[kk * 129 + nn + e] = vv[4 * i + e]; }
        if (tl + (int)gridDim.x < ntiles) ldt(tl + gridDim.x);
        lds_barrier();
#pragma unroll
        for (int i = 0; i < 2; ++i) {
            const int id = tid + 512 * i, k8 = id & 7, nn = id >> 3;
            u32x4 w;
#pragma unroll
            for (int d = 0; d < 4; ++d) w[d] = pk2(tile[(k8 * 8 + 2 * d) * 129 + nn], tile[(k8 * 8 + 2 * d + 1) * 129 + nn]);
            *(u32x4*)(dst + (size_t)(n0 + nn) * K + k0 + k8 * 8) = w;
        }
        lds_barrier();
    }
}

DI void phase0(const Params& p, LAS unsigned char* lds) {
    unsigned char* ws = p.ws;
    LAS float* tile = (LAS float*)lds;
    const int tid = threadIdx.x, lane = tid & 63, wave = tid >> 6;
    tconv(p.ret_w_in, 2048, 12288, (bf16_t*)(ws + OFF_W1T), 12288, p.norm_g, 1, tile);
    tconv(p.ret_w_out, 4096, 2048, (bf16_t*)(ws + OFF_W2T), 2048, nullptr, 0, tile);
    tconv(p.nsa_w_in, 2048, 7216, (bf16_t*)(ws + OFF_W3T), LD1, p.norm_g + 2048, 2, tile);
    tconv(p.nsa_w_out, 2048, 2048, (bf16_t*)(ws + OFF_W4T), 2048, nullptr, 0, tile);
    tconv(p.w1_k, 4096, 128, (bf16_t*)(ws + OFF_CW1K), 128, nullptr, 0, tile);
    tconv(p.w1_v, 4096, 128, (bf16_t*)(ws + OFF_CW1V), 128, nullptr, 0, tile);
    tconv(p.w2_k, 128, 128, (bf16_t*)(ws + OFF_CW2K), 128, nullptr, 0, tile);
    tconv(p.w2_v, 128, 128, (bf16_t*)(ws + OFF_CW2V), 128, nullptr, 0, tile);
    bf16_t* xb = (bf16_t*)(ws + OFF_XB); float* rstd0 = (float*)(ws + OFF_RSTD0); float* ss1 = (float*)(ws + OFF_SS1);
    for (int row0 = (blockIdx.x * 8 + wave) * 2; row0 < T_; row0 += gridDim.x * 16) {
        f32x4 v[2][8]; float ss[2] = {0.f, 0.f};
#pragma unroll
        for (int q = 0; q < 2; ++q) {
            const f32x4* xr = (const f32x4*)(p.x + (size_t)(row0 + q) * DM);
#pragma unroll
            for (int i = 0; i < 8; ++i) v[q][i] = xr[lane + 64 * i];
        }
#pragma unroll
        for (int q = 0; q < 2; ++q)
#pragma unroll
            for (int i = 0; i < 8; ++i) ss[q] += v[q][i][0] * v[q][i][0] + v[q][i][1] * v[q][i][1] + v[q][i][2] * v[q][i][2] + v[q][i][3] * v[q][i][3];
        ss[0] = wave_sum(ss[0]); ss[1] = wave_sum(ss[1]);
#pragma unroll
        for (int q = 0; q < 2; ++q) {
            const float rs0 = rsqrtf(ss[q] * (1.f / 2048.f) + 1e-6f);
#pragma unroll
            for (int i = 0; i < 8; ++i) { u32x2 w; w.x = pk2(v[q][i][0] * rs0, v[q][i][1] * rs0); w.y = pk2(v[q][i][2] * rs0, v[q][i][3] * rs0); *(u32x2*)(xb + (size_t)(row0 + q) * DM + (lane + 64 * i) * 4) = w; }
        }
    }
    for (int i = blockIdx.x * NTHREADS + tid; i < T_; i += gridDim.x * NTHREADS) ss1[i] = 0.f;
    float* cb = (float*)(ws + OFF_CB);
    for (int o = blockIdx.x * 8 + wave; o < 256; o += gridDim.x * 8) {
        const int kv = o >> 7, j = o & 127; const float* pos = kv ? p.pos_v : p.pos_k; const float* w1 = kv ? p.w1_v : p.w1_k;
        float s = 0.f;
        for (int i = lane; i < 4096; i += 64) s += pos[i] * w1[(size_t)i * 128 + j];
        s = wave_sum(s);
        if (lane == 0) cb[o] = s;
    }
}

DI void ret_intra(const bf16_t* PROJ, bf16_t* OI, bf16_t* KTG, LAS unsigned char* lds) {
    const int tid = threadIdx.x, lane = tid & 63, wave = tid >> 6, r32 = lane & 31, hh = lane >> 5;
    LAS bf16_t* Qs = (LAS bf16_t*)lds;
    LAS bf16_t* Ks = (LAS bf16_t*)(lds + 67584);
    LAS bf16_t* Ss = Qs;
    LAS bf16_t* OUTs = (LAS bf16_t*)(lds + 34816);
    LAS bf16_t* VT0 = (LAS bf16_t*)(lds + 69632);
    u32x4 qk[16];
    auto loadQK = [&](int u) {
        const int b = u >> 10, h = (u >> 7) & 7, ch = u & 127;
        unsigned tq = tid; asm volatile("" : "+v"(tq));
        const bf16_t* base = PROJ + ((size_t)b * S_ + ch * 128) * LD0 + h * 256;
#pragma unroll
        for (int i = 0; i < 8; ++i) {
            const unsigned pc = tq + i * 512, off = (pc >> 5) * LD0 + (pc & 31) * 8;
            qk[2 * i] = *(const u32x4*)(base + off);
            qk[2 * i + 1] = *(const u32x4*)(base + (off + 2048));
        }
    };
    if ((int)blockIdx.x < 2048) loadQK(blockIdx.x);
    for (int u = blockIdx.x; u < 2048; u += gridDim.x) {
        const int b = u >> 10, h = (u >> 7) & 7, ch = u & 127;
        const size_t t0 = (size_t)b * S_ + ch * 128;
        const float logg = log1pf(-exp2f(-5.f - (float)h));
        {
            int tq = tid; asm volatile("" : "+v"(tq));
#pragma unroll
            for (int i = 0; i < 8; ++i) {
                const int pc = tq + i * 512, row = pc >> 5, cs = pc & 31;
                *(LAS u32x4*)(Qs + row * 264 + cs * 8) = qk[2 * i];
                *(LAS u32x4*)(Ks + row * 264 + cs * 8) = qk[2 * i + 1];
            }
        }
        const int vg = (tid & 3) + 4 * (tid >> 7), mg = (tid >> 2) & 31;
        u32x4 VA[4], VB[4];
        const bf16_t* vbase = PROJ + t0 * LD0 + 4096 + h * 512;
        auto loadV = [&](u32x4 (&R)[4], int pz) {
            unsigned mq = mg, vq = vg; asm volatile("" : "+v"(mq)); asm volatile("" : "+v"(vq));
#pragma unroll
            for (int rr = 0; rr < 4; ++rr) R[rr] = *(const u32x4*)(vbase + ((4 * mq + rr) * LD0 + pz * 128 + 8 * vq));
        };
        auto writeV = [&](const u32x4 (&R)[4], int pz) {
            LAS bf16_t* VT = VT0 + (pz & 1) * (128 * 136);
            u32x2 o[8]; tr4x8(R, o);
#pragma unroll
            for (int jj = 0; jj < 8; ++jj) *(LAS u32x2*)(VT + (8 * vg + jj) * 136 + 4 * mg) = o[jj];
        };
        loadV(VA, 0); loadV(VB, 1);
        lds_barrier();
        const int nt = wave & 3, mtb = (wave >> 2) * 2;
        f32x16 sacc[2];
#pragma unroll
        for (int mi = 0; mi < 2; ++mi) {
            const int mt = mtb + mi; sacc[mi] = zero16();
            if (mt <= nt) {
#pragma unroll
                for (int s = 0; s < 16; ++s)
                    sacc[mi] = MFMA32(ldsfrag(Ks + (mt * 32 + r32) * 264 + 16 * s + 8 * hh), ldsfrag(Qs + (nt * 32 + r32) * 264 + 16 * s + 8 * hh), sacc[mi]);
            }
        }
        {
            bf16_t* kt = KTG + (size_t)u * 32768;
#pragma unroll
            for (int i = 0; i < 2; ++i) {
                const int bi = tid + 512 * i, mgk = bi & 31, dg = bi >> 5;
                u32x4 R[4]; u32x2 o[8];
#pragma unroll
                for (int rr = 0; rr < 4; ++rr) R[rr] = *(const LAS u32x4*)(Ks + (4 * mgk + rr) * 264 + 8 * dg);
                tr4x8(R, o);
#pragma unroll
                for (int jj = 0; jj < 8; ++jj) *(u32x2*)(kt + (8 * dg + jj) * 128 + 4 * mgk) = o[jj];
            }
        }
        lds_barrier();
        const int n = nt * 32 + r32;
#pragma unroll
        for (int mi = 0; mi < 2; ++mi) {
            const int mt = mtb + mi;
#pragma unroll
            for (int G = 0; G < 4; ++G) {
                const int m0 = mt * 32 + 8 * G + 4 * hh;
                float v[4];
#pragma unroll
                for (int j = 0; j < 4; ++j) { const int df = n - (m0 + j); v[j] = df >= 0 ? sacc[mi][4 * G + j] * __expf((float)df * logg) : 0.f; }
                u32x2 w; w.x = pk2(v[0], v[1]); w.y = pk2(v[2], v[3]);
                *(LAS u32x2*)(Ss + n * 136 + m0) = w;
            }
        }
        writeV(VA, 0); loadV(VA, 2);
        if (u + (int)gridDim.x < 2048) loadQK(u + gridDim.x);
        const int vtb = (wave >> 2) * 2;
        auto piece = [&](int pz) {
            LAS bf16_t* VT = VT0 + (pz & 1) * (128 * 136);
#pragma unroll
            for (int vi = 0; vi < 2; ++vi) {
                const int vt = vtb + vi; f32x16 acc = zero16();
                for (int s = 0; s < 2 * (nt + 1); ++s)
                    acc = MFMA32(ldsfrag(VT + (vt * 32 + r32) * 136 + 16 * s + 8 * hh), ldsfrag(Ss + (nt * 32 + r32) * 136 + 16 * s + 8 * hh), acc);
#pragma unroll
                for (int G = 0; G < 4; ++G) {
                    u32x2 w; w.x = pk2(acc[4 * G], acc[4 * G + 1]); w.y = pk2(acc[4 * G + 2], acc[4 * G + 3]);
                    *(LAS u32x2*)(OUTs + n * 136 + vt * 32 + 8 * G + 4 * hh) = w;
                }
            }
        };
        auto flush = [&](int pz) {
            int tq = tid; asm volatile("" : "+v"(tq));
#pragma unroll
            for (int i = 0; i < 4; ++i) {
                const int pc = tq + 512 * i, row = pc >> 4, c16 = pc & 15;
                *(u32x4*)(OI + (t0 + row) * 4096 + h * 512 + pz * 128 + c16 * 8) = *(const LAS u32x4*)(OUTs + row * 136 + c16 * 8);
            }
        };
        lds_barrier(); writeV(VB, 1); loadV(VB, 3); piece(0); lds_barrier(); flush(0);
        lds_barrier(); writeV(VA, 2); piece(1); lds_barrier(); flush(1);
        lds_barrier(); writeV(VB, 3); piece(2); lds_barrier(); flush(2);
        lds_barrier(); piece(3); lds_barrier(); flush(3);
        lds_barrier();
    }
}

DI void ret_inter(bf16_t* PROJ, const bf16_t* OI, const bf16_t* KTG, LAS unsigned char* lds, bool dummy = false) {
    const int tid = threadIdx.x, lane = tid & 63, wave = tid >> 6, r32 = lane & 31, hh = lane >> 5;
    LAS bf16_t* KT = (LAS bf16_t*)lds;
    LAS bf16_t* VT = (LAS bf16_t*)(lds + 69632);
    LAS bf16_t* ST = (LAS bf16_t*)(lds + 69632 + 8704);
    LAS bf16_t* Qs = (LAS bf16_t*)(lds + 69632 + 8704 + 16896);
    for (int u = blockIdx.x; u < 256; u += gridDim.x) {
        const int uu = (gridDim.x == 256) ? ((((u & 7) * 2 + (u >> 7)) << 4) + ((u >> 3) & 15)) : u;
        const int b = uu >> 7, h = (uu >> 4) & 7, vs = uu & 15, v0 = vs * 32;
        const float logg = log1pf(-exp2f(-5.f - (float)h));
        const float cd = __expf(128.f * logg);
        for (int i = tid; i < 32 * 264 / 2; i += NTHREADS) ((LAS unsigned*)ST)[i] = 0u;
        const size_t tb = (size_t)b * S_;
        if (wave < 4) {
            struct QSet { u32x4 q[16]; u32x4 o[2]; };
            QSet QA, QB;
            const int n = 32 * wave + r32;
            auto loadq = [&](QSet& Q, int c) {
                unsigned tq = tid; asm volatile("" : "+v"(tq));
                const bf16_t* qb_ = PROJ + (tb + c * 128) * LD0 + h * 256;
                const bf16_t* ob_ = OI + (tb + c * 128) * 4096 + h * 512 + v0;
#pragma unroll
                for (int i = 0; i < 16; ++i) { const unsigned pc = tq + 256 * i; Q.q[i] = *(const u32x4*)(qb_ + ((pc >> 5) * LD0 + (pc & 31) * 8)); }
                const unsigned nq = 32 * (tq >> 6) + (tq & 31), hq = (tq >> 5) & 1;
#pragma unroll
                for (int e = 0; e < 2; ++e) Q.o[e] = *(const u32x4*)(ob_ + (nq * 4096 + 16 * e + 8 * hq));
            };
            const float qd = __expf((float)(n + 1) * logg);
            auto stepq = [&](int c, QSet& Q) {
                {
                    int tq = tid; asm volatile("" : "+v"(tq));
#pragma unroll
                    for (int i = 0; i < 16; ++i) { const int pc = tq + 256 * i; *(LAS u32x4*)(Qs + (pc >> 5) * 264 + (pc & 31) * 8) = Q.q[i]; }
                }
                const u32x4 o0 = Q.o[0], o1 = Q.o[1];
                if (c + 2 < 128) loadq(Q, c + 2);
                lds_barrier();
                f32x16 acc = zero16(), acc1 = zero16();
#pragma unroll
                for (int s = 0; s < 16; s += 2) {
                    acc = MFMA32(ldsfrag(ST + r32 * 264 + 16 * s + 8 * hh), ldsfrag(Qs + n * 264 + 16 * s + 8 * hh), acc);
                    acc1 = MFMA32(ldsfrag(ST + r32 * 264 + 16 * (s + 1) + 8 * hh), ldsfrag(Qs + n * 264 + 16 * (s + 1) + 8 * hh), acc1);
                }
                acc = acc + acc1;
                u32x4 w0, w1;
#pragma unroll
                for (int d = 0; d < 4; ++d) {
                    w0[d] = pk2(bflo(o0[d]) + acc[2 * d] * qd, bfhi(o0[d]) + acc[2 * d + 1] * qd);
                    w1[d] = pk2(bflo(o1[d]) + acc[8 + 2 * d] * qd, bfhi(o1[d]) + acc[8 + 2 * d + 1] * qd);
                }
                {
                    unsigned nq = n; asm volatile("" : "+v"(nq));
                    bf16_t* wb_ = PROJ + (tb + c * 128) * LD0 + 4096 + h * 512 + v0;
                    const unsigned wo = nq * LD0 + 8 * hh;
                    if (!dummy) { *(u32x4*)(wb_ + wo) = w0; *(u32x4*)(wb_ + (wo + 16)) = w1; }
                }
                lds_barrier();
            };
            loadq(QA, 0); loadq(QB, 1);
            for (int c = 0; c < 128; c += 2) { stepq(c, QA); stepq(c + 1, QB); }
        } else {
            struct KSet { u32x4 k[4][4]; u32x4 v[2]; };
            KSet KA, KB;
            const int t4 = tid - 256;
            auto loadk = [&](KSet& K, int c) {
                unsigned tq = t4; asm volatile("" : "+v"(tq));
                const bf16_t* kb_ = KTG + ((size_t)((b * 8 + h) * 128 + c)) * 32768;
                const bf16_t* vb_ = PROJ + (tb + c * 128) * LD0 + 4096 + h * 512 + v0;
#pragma unroll
                for (int i = 0; i < 16; ++i) K.k[i >> 2][i & 3] = *(const u32x4*)(kb_ + (tq + 256 * i) * 8u);
#pragma unroll
                for (int i = 0; i < 2; ++i) { const unsigned pi = tq + 256 * i; K.v[i] = *(const u32x4*)(vb_ + ((pi >> 2) * LD0 + 8 * (pi & 3))); }
            };
            f32x16 sacc[2]; sacc[0] = zero16(); sacc[1] = zero16();
            auto stepk = [&](int c, KSet& K) {
                int tw = t4; asm volatile("" : "+v"(tw));
#pragma unroll
                for (int i = 0; i < 16; ++i) { const int pc = tw + 256 * i; *(LAS u32x4*)(KT + (pc >> 4) * 136 + (pc & 15) * 8) = K.k[i >> 2][i & 3]; }
#pragma unroll
                for (int i = 0; i < 2; ++i) {
                    const int pi = tw + 256 * i, vm = pi >> 2, vgq = pi & 3;
                    const float kd = __expf((float)(127 - vm) * logg);
#pragma unroll
                    for (int d = 0; d < 4; ++d) {
                        const unsigned wv = K.v[i][d];
                        const unsigned a = pk2(bflo(wv) * kd, bfhi(wv) * kd);
                        const int vl = 8 * vgq + 2 * d, q4 = vl >> 2, pq = ((q4 & 3) == 1 || (q4 & 3) == 2) ? (q4 ^ 3) : q4, rho = (pq << 2) | (vl & 3);
                        VT[rho * 136 + vm] = (bf16_t)(a & 0xffffu);
                        VT[(rho + 1) * 136 + vm] = (bf16_t)(a >> 16);
                    }
                }
                if (c + 2 < 128) loadk(K, c + 2);
                lds_barrier();
#pragma unroll
                for (int ti = 0; ti < 2; ++ti) sacc[ti] = sacc[ti] * cd;
#pragma unroll
                for (int s = 0; s < 8; ++s)
#pragma unroll
                    for (int ti = 0; ti < 2; ++ti) {
                        const int d = (2 * (wave - 4) + ti) * 32 + r32;
                        sacc[ti] = MFMA32(ldsfrag(KT + d * 136 + 16 * s + 8 * hh), ldsfrag(VT + r32 * 136 + 16 * s + 8 * hh), sacc[ti]);
                    }
                lds_barrier();
#pragma unroll
                for (int ti = 0; ti < 2; ++ti) {
                    const int dt = 2 * (wave - 4) + ti;
#pragma unroll
                    for (int G = 0; G < 4; ++G) {
                        u32x2 w; w.x = pk2(sacc[ti][4 * G], sacc[ti][4 * G + 1]); w.y = pk2(sacc[ti][4 * G + 2], sacc[ti][4 * G + 3]);
                        *(LAS u32x2*)(ST + r32 * 264 + dt * 32 + 8 * G + 4 * hh) = w;
                    }
                }
            };
            loadk(KA, 0); loadk(KB, 1);
            for (int c = 0; c < 128; c += 2) { stepk(c, KA); stepk(c + 1, KB); }
        }
        lds_barrier();
    }
}

DI void ret_gate(bf16_t* PROJ, bf16_t* dummy = nullptr) {
    const int lane = threadIdx.x & 63, wave = threadIdx.x >> 6;
    const int nw = gridDim.x * 8, gw = blockIdx.x * 8 + wave;
    for (int task0 = gw * 8; task0 < T_ * 8; task0 += nw * 8) {
        u32x4 o8[8], g8[8];
#pragma unroll
        for (int q = 0; q < 8; ++q) {
            const int task = task0 + q; const size_t t = task >> 3; const int h = task & 7;
            o8[q] = *(const u32x4*)(PROJ + t * LD0 + 4096 + h * 512 + lane * 8);
            g8[q] = *(const u32x4*)(PROJ + t * LD0 + 8192 + h * 512 + lane * 8);
        }
#pragma unroll
        for (int q = 0; q < 8; ++q) {
            const int task = task0 + q; const size_t t = task >> 3; const int h = task & 7;
            float f[8], gt[8];
#pragma unroll
            for (int d = 0; d < 4; ++d) { f[2 * d] = bflo(o8[q][d]); f[2 * d + 1] = bfhi(o8[q][d]); gt[2 * d] = bflo(g8[q][d]); gt[2 * d + 1] = bfhi(g8[q][d]); }
            float s = 0.f;
#pragma unroll
            for (int d = 0; d < 8; ++d) s += f[d];
            const float mu = wave_sum(s) * (1.f / 512.f);
            float s2 = 0.f;
#pragma unroll
            for (int d = 0; d < 8; ++d) { f[d] -= mu; s2 += f[d] * f[d]; }
            const float rs = rsqrtf(wave_sum(s2) * (1.f / 512.f) + 1e-6f);
            u32x4 w;
#pragma unroll
            for (int d = 0; d < 4; ++d) w[d] = pk2(silu_f(gt[2 * d]) * f[2 * d] * rs, silu_f(gt[2 * d + 1]) * f[2 * d + 1] * rs);
            if (dummy) *(u32x4*)(dummy + (t & 4095) * LD0 + 8192 + h * 512 + lane * 8) = w; else *(u32x4*)(PROJ + t * LD0 + 8192 + h * 512 + lane * 8) = w;
        }
    }
}

DI void nsa_compress(const bf16_t* P1, unsigned char* ws, bf16_t* KC, bf16_t* VCT, bf16_t* VST, bf16_t* VWT, bf16_t* KS2, bf16_t* KW2, LAS unsigned char* lds) {
    const int tid = threadIdx.x, lane = tid & 63, wave = tid >> 6, r32 = lane & 31, hh = lane >> 5;
    LAS bf16_t* As = (LAS bf16_t*)lds;
    LAS bf16_t* Ws = (LAS bf16_t*)(lds + 17408);
    LAS bf16_t* Hs = (LAS bf16_t*)(lds + 17408 + 34816);
    const float* cb = (const float*)(ws + OFF_CB);
    for (int u = blockIdx.x; u < 256; u += gridDim.x) {
        const int kv = u >> 7, bg = (u >> 4) & 7, ct = u & 15, b = bg >> 2, g = bg & 3;
        const bf16_t* W1T = (const bf16_t*)(ws + (kv ? OFF_CW1V : OFF_CW1K));
        const bf16_t* W2T = (const bf16_t*)(ws + (kv ? OFF_CW2V : OFF_CW2K));
        const int colA = (kv ? C_VC : C_KC) + g * 128;
        const int ch = wave & 1, jt = wave >> 1;
        f32x16 acc = zero16();
        u32x4 pa[2], pw[4];
        auto ldl = [&](int l) {
            unsigned tq = tid; asm volatile("" : "+v"(tq));
#pragma unroll
            for (int i = 0; i < 2; ++i) {
                const unsigned pc = tq + 512 * i, row = pc >> 4, cs = pc & 15;
                unsigned tok = 16 * (ct * 64 + row) + l; tok = tok < (unsigned)S_ ? tok : S_ - 1;
                pa[i] = *(const u32x4*)(P1 + ((size_t)b * S_ + tok) * LD1 + colA + cs * 8);
            }
#pragma unroll
            for (int i = 0; i < 4; ++i) {
                const unsigned pc = tq + 512 * i, row = pc >> 4, cs = pc & 15;
                pw[i] = *(const u32x4*)(W1T + (row * 4096 + l * 128 + cs * 8));
            }
        };
        ldl(0);
        for (int l = 0; l < 32; ++l) {
            lds_barrier();
            {
                int tq = tid; asm volatile("" : "+v"(tq));
#pragma unroll
                for (int i = 0; i < 2; ++i) { const int pc = tq + 512 * i; *(LAS u32x4*)(As + (pc >> 4) * 136 + (pc & 15) * 8) = pa[i]; }
#pragma unroll
                for (int i = 0; i < 4; ++i) { const int pc = tq + 512 * i; *(LAS u32x4*)(Ws + (pc >> 4) * 136 + (pc & 15) * 8) = pw[i]; }
            }
            if (l + 1 < 32) ldl(l + 1);
            lds_barrier();
#pragma unroll
            for (int s = 0; s < 8; ++s)
                acc = MFMA32(ldsfrag(Ws + (jt * 32 + r32) * 136 + 16 * s + 8 * hh), ldsfrag(As + (ch * 32 + r32) * 136 + 16 * s + 8 * hh), acc);
        }
#pragma unroll
        for (int G = 0; G < 4; ++G) {
            const int j0 = jt * 32 + 8 * G + 4 * hh;
            float v[4];
#pragma unroll
            for (int j = 0; j < 4; ++j) v[j] = silu_f(acc[4 * G + j] + cb[kv * 128 + j0 + j]);
            u32x2 w; w.x = pk2(v[0], v[1]); w.y = pk2(v[2], v[3]);
            *(LAS u32x2*)(Hs + (ch * 32 + r32) * 136 + j0) = w;
        }
        lds_barrier();
#pragma unroll
        for (int i = 0; i < 4; ++i) {
            const int pc = tid + 512 * i, row = pc >> 4, cs = pc & 15;
            *(LAS u32x4*)(Ws + row * 136 + cs * 8) = *(const u32x4*)(W2T + (size_t)row * 128 + cs * 8);
        }
        lds_barrier();
        f32x16 a2 = zero16();
        if (kv == 0) {
#pragma unroll
            for (int s = 0; s < 8; ++s)
                a2 = MFMA32(ldsfrag(Ws + (jt * 32 + r32) * 136 + 16 * s + 8 * hh), ldsfrag(Hs + (ch * 32 + r32) * 136 + 16 * s + 8 * hh), a2);
            const int c = ct * 64 + ch * 32 + r32;
#pragma unroll
            for (int G = 0; G < 4; ++G) {
                u32x2 w; w.x = pk2(a2[4 * G], a2[4 * G + 1]); w.y = pk2(a2[4 * G + 2], a2[4 * G + 3]);
                *(u32x2*)(KC + ((size_t)bg * 1024 + c) * 128 + jt * 32 + 8 * G + 4 * hh) = w;
            }
            {
                float am = 0.f;
#pragma unroll
                for (int i = 0; i < 16; ++i) am = fmaxf(am, fabsf(a2[i]));
#pragma unroll
                for (int o = 32; o >= 1; o >>= 1) am = fmaxf(am, __shfl_xor(am, o));
                if (lane == 0) atomicMax((unsigned*)(ws + OFF_KINF) + bg, __float_as_uint(am * 1.01f));
            }
        } else {
#pragma unroll
            for (int s = 0; s < 8; ++s)
                a2 = MFMA32(ldsfrag(Hs + (ch * 32 + r32) * 136 + 16 * s + 8 * hh), ldsfrag(Ws + (jt * 32 + r32) * 136 + 16 * s + 8 * hh), a2);
            const int j2 = jt * 32 + r32;
#pragma unroll
            for (int G = 0; G < 4; ++G) {
                u32x2 w; w.x = pk2(a2[4 * G], a2[4 * G + 1]); w.y = pk2(a2[4 * G + 2], a2[4 * G + 3]);
                *(u32x2*)(VCT + ((size_t)(bg * 16 + ct) * 128 + j2) * 64 + ch * 32 + 8 * G + 4 * hh) = w;
            }
        }
        lds_barrier();
    }
    {
        const int half = tid >> 8, t8 = tid & 255, dgq = (t8 & 3) + 4 * (t8 >> 6), mg = (t8 >> 2) & 15;
        for (int u2 = blockIdx.x * 2 + half; u2 < 4096; u2 += gridDim.x * 2) {
            const int which = u2 >> 11, bg = (u2 >> 8) & 7, jb = u2 & 255, b = bg >> 2, g = bg & 3;
            const int col = (which ? C_VW : C_VS) + g * 128, kcol = (which ? C_KW : C_KS) + g * 128;
            bf16_t* vdst = (which ? VWT : VST) + (size_t)(bg * 256 + jb) * 8192;
            bf16_t* kdst = (which ? KW2 : KS2) + (size_t)(bg * 256 + jb) * 8192;
            const bf16_t* srow = P1 + ((size_t)b * S_ + jb * 64) * LD1;
            u32x4 R[4]; u32x2 o[8]; u32x4 kk[4];
#pragma unroll
            for (int rr = 0; rr < 4; ++rr) R[rr] = *(const u32x4*)(srow + (size_t)(4 * mg + rr) * LD1 + col + 8 * dgq);
#pragma unroll
            for (int i = 0; i < 4; ++i) { const int pc = t8 + 256 * i; kk[i] = *(const u32x4*)(srow + (size_t)(pc >> 4) * LD1 + kcol + (pc & 15) * 8); }
            tr4x8(R, o);
#pragma unroll
            for (int jj = 0; jj < 8; ++jj) *(u32x2*)(vdst + (8 * dgq + jj) * 64 + 4 * mg) = o[jj];
#pragma unroll
            for (int i = 0; i < 4; ++i) { const int pc = t8 + 256 * i; *(u32x4*)(kdst + pc * 8) = kk[i]; }
            if (which == 0) {
                float am = 0.f;
#pragma unroll
                for (int i = 0; i < 4; ++i)
#pragma unroll
                    for (int d = 0; d < 4; ++d) am = fmaxf(am, fmaxf(fabsf(bflo(kk[i][d])), fabsf(bfhi(kk[i][d]))));
#pragma unroll
                for (int o = 32; o >= 1; o >>= 1) am = fmaxf(am, __shfl_xor(am, o));
                if (lane == 0) atomicMax((unsigned*)(ws + OFF_KINF) + 8 + bg, __float_as_uint(am));
            }
        }
    }
}

DI float dpp_x1(float v) { return __int_as_float(__builtin_amdgcn_mov_dpp(__float_as_int(v), 0xB1, 0xF, 0xF, true)); }
DI float dpp_x2(float v) { return __int_as_float(__builtin_amdgcn_mov_dpp(__float_as_int(v), 0x4E, 0xF, 0xF, true)); }

DI void nsa_attn(const bf16_t* P1, const bf16_t* KC, const bf16_t* VCT, const bf16_t* VST, const bf16_t* VWT, const bf16_t* KS2, const bf16_t* KW2, const float* KINF, bf16_t* Y1, LAS unsigned char* lds) {
    const int tid = threadIdx.x, lane = tid & 63, wave = tid >> 6, r32 = lane & 31, hh = lane >> 5;
    constexpr int KB_E = 64 * 136, VP = 68, VB_E = 128 * VP;
    LAS bf16_t* Kb = (LAS bf16_t*)lds;
    LAS bf16_t* Vb = (LAS bf16_t*)(lds + 2 * KB_E * 2);
    LAS unsigned char* r1base = lds + 2 * KB_E * 2 + 2 * VB_E * 2;
    LAS float* imp = (LAS float*)r1base;
    LAS bf16_t* R1 = (LAS bf16_t*)r1base;
    LAS unsigned* selm = (LAS unsigned*)(r1base + 67584);
    LAS unsigned* uni = selm + 512;
    LAS int* jcount = (LAS int*)(uni + 8);
    LAS unsigned char* jlist = (LAS unsigned char*)(uni + 16);
    LAS int* kt0w = (LAS int*)(uni + 12);
    LAS int* jf0w = (LAS int*)(uni + 13);
    const int G_ = gridDim.x;
    for (int U = blockIdx.x; U < 2048; U += G_) {
        const int bg = U >> 8, qidx = U & 255, qb = (bg & 1) ? 255 - qidx : qidx, b = bg >> 2, g = bg & 3;
        const int q0 = qb * 64, tkl = r32 >> 2, r = r32 & 3, head = g * 4 + r, tl = 8 * wave + tkl, t = q0 + tl;
        const unsigned token = (unsigned)b * S_ + t;
        const float slope = 1.4426950408889634f * exp2f(-0.5f * (float)(head + 1));
        bf16x8 qf[8];
#pragma unroll
        for (int s = 0; s < 8; ++s) qf[s] = *(const bf16x8*)(P1 + token * LD1 + head * 128 + 16 * s + 8 * hh);
        float gsig[3];
#pragma unroll
        for (int br = 0; br < 3; ++br) gsig[br] = sigm_f(__uint_as_float((unsigned)P1[token * LD1 + C_G + head * 3 + br] << 16));
        if (tid < 8) uni[tid] = 0u;
        if (tid == 8) *kt0w = 1 << 20;
        if (tid == 9) *jf0w = 1 << 20;

        struct TileRegs { u32x4 k[2], v[2]; };
        TileRegs RA, RB;
        auto issue = [&](TileRegs& R, const bf16_t* ktile, const bf16_t* vtile, bool withv) {
            unsigned tq = tid; asm volatile("" : "+v"(tq));
#pragma unroll
            for (int i = 0; i < 2; ++i) R.k[i] = *(const u32x4*)(ktile + (tq + 512 * i) * 8u);
            if (withv) {
#pragma unroll
                for (int i = 0; i < 2; ++i) R.v[i] = *(const u32x4*)(vtile + (tq + 512 * i) * 8u);
            }
        };
        auto commit = [&](const TileRegs& R, int buf, bool withv) {
            int tq = tid; asm volatile("" : "+v"(tq));
#pragma unroll
            for (int i = 0; i < 2; ++i) { const int pc = tq + 512 * i; *(LAS u32x4*)(Kb + buf * KB_E + (pc >> 4) * 136 + (pc & 15) * 8) = R.k[i]; }
            if (withv) {
#pragma unroll
                for (int i = 0; i < 2; ++i) { const int pc = tq + 512 * i; LAS bf16_t* vq = Vb + buf * VB_E + (pc >> 3) * VP + (pc & 7) * 8; u32x2 lo_, hi_; lo_.x = R.v[i].x; lo_.y = R.v[i].y; hi_.x = R.v[i].z; hi_.y = R.v[i].w; *(LAS u32x2*)vq = lo_; *(LAS u32x2*)(vq + 4) = hi_; }
            }
        };
        auto compS = [&](int buf, f32x16 (&S)[2]) {
            int ro = r32 * 136 + 8 * hh; asm volatile("" : "+v"(ro));
            S[0] = zero16(); S[1] = zero16();
#pragma unroll
            for (int s = 0; s < 8; ++s) {
                S[0] = MFMA32(ldsfrag(Kb + buf * KB_E + ro + 16 * s), qf[s], S[0]);
                S[1] = MFMA32(ldsfrag(Kb + buf * KB_E + 32 * 136 + ro + 16 * s), qf[s], S[1]);
            }
        };
        auto compPV = [&](int buf, const f32x16 (&P)[2], f32x16 (&O)[4]) {
            int vo = r32 * VP + 4 * hh; asm volatile("" : "+v"(vo));
#pragma unroll
            for (int s2 = 0; s2 < 4; ++s2) {
                const int ct = s2 >> 1, sh = s2 & 1;
                u32x4 pw;
#pragma unroll
                for (int d = 0; d < 4; ++d) pw[d] = pk2(P[ct][8 * sh + 2 * d], P[ct][8 * sh + 2 * d + 1]);
                const bf16x8 pf = __builtin_bit_cast(bf16x8, pw);
#pragma unroll
                for (int dt = 0; dt < 4; ++dt) {
                    const LAS bf16_t* vp = Vb + buf * VB_E + dt * 32 * VP + vo + 16 * s2;
                    const s16x4 lo = *(const LAS s16x4*)vp, hi = *(const LAS s16x4*)(vp + 8);
                    const bf16x8 xf = __builtin_shufflevector(lo, hi, 0, 1, 2, 3, 4, 5, 6, 7);
                    O[dt] = MFMA32(xf, pf, O[dt]);
                }
            }
        };

#define KCONST(ct, i) ((float)(32 * (ct) + ((i) & 3) + 8 * ((i) >> 2)))
#define EX2(x) __builtin_amdgcn_exp2f(x)
        const int nkt = (4 * qb + 66) >> 6;
        const bf16_t* kcb = KC + (size_t)bg * 1024 * 128;
        const bf16_t* vcb = VCT + (size_t)bg * 16 * 8192;
        const float skc = 16.f * slope;
        float m1 = -1e30f, l1 = 0.f;
        int kt0;
        {
            float q1 = 0.f;
#pragma unroll
            for (int s = 0; s < 8; ++s)
#pragma unroll
                for (int e = 0; e < 8; ++e) q1 += fabsf(__uint_as_float(((unsigned)(unsigned short)qf[s][e]) << 16));
            q1 += __shfl_xor(q1, 32);
            const float reach = 15.f + (160.f + 2.f * q1 * KINF[bg]) / slope;
            const float xk = ((float)(t - 1039) - reach) * (1.f / 1024.f);
            int kf = xk > 0.f ? (int)ceilf(xk) : 0;
#pragma unroll
            for (int o = 32; o >= 1; o >>= 1) { const int ov = __shfl_xor(kf, o); kf = ov < kf ? ov : kf; }
            const float reach_s = (160.f + 2.f * q1 * KINF[8 + bg]) / slope;
            const float xj = ((float)(t - 63) - reach_s) * (1.f / 64.f);
            int jf = xj > 0.f ? (int)ceilf(xj) : 0;
#pragma unroll
            for (int o = 32; o >= 1; o >>= 1) { const int ov = __shfl_xor(jf, o); jf = ov < jf ? ov : jf; }
            lds_barrier();
            if (lane == 0) { atomicMin((int*)kt0w, kf); atomicMin((int*)jf0w, jf); }
            lds_barrier();
            kt0 = __builtin_amdgcn_readfirstlane(*kt0w);
            kt0 = kt0 < nkt - 1 ? kt0 : nkt - 1;
            for (int tk = 0; tk < 8; ++tk)
                for (int cq = lane; cq < 16 * kt0; cq += 64) imp[(wave * 8 + tk) * 257 + cq] = 0.f;
        }
        lds_barrier();
        issue(RA, kcb + (size_t)kt0 * 8192, vcb, false);
        if (kt0 + 1 < nkt) issue(RB, kcb + (size_t)(kt0 + 1) * 8192, vcb, false);
        auto step1 = [&](int kt, TileRegs& R) {
            const int buf = kt & 1;
            commit(R, buf, false);
            if (kt + 2 < nkt) issue(R, kcb + (size_t)(kt + 2) * 8192, vcb, false);
            lds_barrier();
            f32x16 S[2]; compS(buf, S);
            const bool fast = (1024 * kt + 1039 <= q0);
            float rb = -slope * (float)(t - 31 - 1024 * kt) + skc * (float)(4 * hh); asm volatile("" : "+v"(rb));
            float mt = -1e30f;
#pragma unroll
            for (int ct = 0; ct < 2; ++ct)
#pragma unroll
                for (int i = 0; i < 16; ++i) S[ct][i] = fmaf(skc, KCONST(ct, i), S[ct][i]);
            if (!fast) {
                int d0 = t - 31 - 1024 * kt - 64 * hh; asm volatile("" : "+v"(d0));
#pragma unroll
                for (int ct = 0; ct < 2; ++ct)
#pragma unroll
                    for (int i = 0; i < 16; ++i) { const int dist = d0 - 16 * (32 * ct + (i & 3) + 8 * (i >> 2)); S[ct][i] = dist >= 0 ? S[ct][i] : -1e30f; }
            }
#pragma unroll
            for (int ct = 0; ct < 2; ++ct)
#pragma unroll
                for (int i = 0; i < 16; ++i) mt = fmaxf(mt, S[ct][i]);
            mt += rb;
            const float mn = fmaxf(m1, mt), off = mn - rb;
            float ls = 0.f;
            if (fast) {
#pragma unroll
                for (int ct = 0; ct < 2; ++ct)
#pragma unroll
                    for (int i = 0; i < 16; ++i) ls += EX2(S[ct][i] - off);
            } else {
#pragma unroll
                for (int ct = 0; ct < 2; ++ct)
#pragma unroll
                    for (int i = 0; i < 16; ++i) ls += S[ct][i] > -1e29f ? EX2(S[ct][i] - off) : 0.f;
            }
            l1 = l1 * EX2(m1 - mn) + ls; m1 = mn;
        };
        for (int kt = kt0; kt < nkt; kt += 2) { step1(kt, RA); if (kt + 1 < nkt) step1(kt + 1, RB); }
        float Mx, lgi;
        {
            const float mo = __shfl_xor(m1, 32), lo = __shfl_xor(l1, 32);
            Mx = fmaxf(m1, mo);
            const float L = l1 * EX2(m1 - Mx) + lo * EX2(mo - Mx);
            lgi = L > 0.f ? -__log2f(L) : -1e30f;
        }
        f32x16 O[4];
#pragma unroll
        for (int dt = 0; dt < 4; ++dt) O[dt] = zero16();
        float carry = 0.f;
        LAS float* impw = imp + (wave * 8 + tkl) * 257;
        lds_barrier();
        issue(RA, kcb + (size_t)kt0 * 8192, vcb + (size_t)kt0 * 8192, true);
        if (kt0 + 1 < nkt) issue(RB, kcb + (size_t)(kt0 + 1) * 8192, vcb + (size_t)(kt0 + 1) * 8192, true);
        auto step2 = [&](int kt, TileRegs& R) {
            const int buf = kt & 1;
            commit(R, buf, true);
            if (kt + 2 < nkt) issue(R, kcb + (size_t)(kt + 2) * 8192, vcb + (size_t)(kt + 2) * 8192, true);
            lds_barrier();
            f32x16 S[2]; compS(buf, S);
            const bool fast = (1024 * kt + 1039 <= q0);
            float rb = -slope * (float)(t - 31 - 1024 * kt) + skc * (float)(4 * hh); asm volatile("" : "+v"(rb));
            const float off = (Mx - rb) - lgi;
            if (fast) {
#pragma unroll
                for (int ct = 0; ct < 2; ++ct)
#pragma unroll
                    for (int i = 0; i < 16; ++i) S[ct][i] = EX2(fmaf(skc, KCONST(ct, i), S[ct][i]) - off);
            } else {
                int d0 = t - 31 - 1024 * kt - 64 * hh; asm volatile("" : "+v"(d0));
#pragma unroll
                for (int ct = 0; ct < 2; ++ct)
#pragma unroll
                    for (int i = 0; i < 16; ++i) {
                        const int dist = d0 - 16 * (32 * ct + (i & 3) + 8 * (i >> 2));
                        S[ct][i] = dist >= 0 ? EX2(fmaf(skc, KCONST(ct, i), S[ct][i]) - off) : 0.f;
                    }
            }
            float X[2][4];
#pragma unroll
            for (int ct = 0; ct < 2; ++ct)
#pragma unroll
                for (int G = 0; G < 4; ++G) X[ct][G] = __shfl_xor(S[ct][4 * G + 3], 32);
#pragma unroll
            for (int ct = 0; ct < 2; ++ct)
#pragma unroll
                for (int G = 0; G < 4; ++G) {
                    const float prev0 = G > 0 ? X[ct][G - 1] : (ct > 0 ? X[0][3] : carry);
                    const float prev = hh ? X[ct][G] : prev0;
                    float tot = S[ct][4 * G] + S[ct][4 * G + 1] + S[ct][4 * G + 2] + S[ct][4 * G + 3] + prev;
                    tot += dpp_x1(tot); tot += dpp_x2(tot);
                    const int cq = 16 * kt + 8 * ct + 2 * G + hh;
                    if (r == 0) impw[cq] = tot;
                }
            carry = X[1][3];
            compPV(buf, S, O);
        };
        for (int kt = kt0; kt < nkt; kt += 2) { step2(kt, RA); if (kt + 1 < nkt) step2(kt + 1, RB); }
        {
            const int cur = qb, nsel = cur + 1 < 16 ? cur + 1 : 16;
#pragma unroll 1
            for (int tk = 0; tk < 8; ++tk) {
                const LAS float* iw = imp + (wave * 8 + tk) * 257;
                unsigned key[4];
#pragma unroll
                for (int uu = 0; uu < 4; ++uu) {
                    const int j = lane + 64 * uu;
                    const bool forced = (j == 0 || j == cur || j == cur - 1);
                    const unsigned bits = forced ? 0x461C4000u   : __float_as_uint(iw[j < 256 ? j : 255]);
                    key[uu] = j <= cur ? ((bits & 0xFFFFFF00u) | (unsigned)(255 - j)) : 0u;
                }
                unsigned thr = 0u;
#pragma unroll 1
                for (int bit = 30; bit >= 0; --bit) {
                    const unsigned cand = thr | (1u << bit);
                    const int cnt = __popcll(__ballot(key[0] >= cand)) + __popcll(__ballot(key[1] >= cand)) + __popcll(__ballot(key[2] >= cand)) + __popcll(__ballot(key[3] >= cand));
                    thr = cnt >= nsel ? cand : thr;
                }
                unsigned word = 0u;
#pragma unroll
                for (int uu = 0; uu < 4; ++uu) {
                    const unsigned long long m = __ballot(key[uu] >= thr);
                    if (lane == 2 * uu) word = (unsigned)m;
                    if (lane == 2 * uu + 1) word = (unsigned)(m >> 32);
                }
                if (lane < 8) { selm[(wave * 8 + tk) * 8 + lane] = word; if (word) atomicOr((unsigned*)(uni + lane), word); }
            }
        }
        lds_barrier();
        {
            LAS bf16_t* rp = R1 + (wave * 32 + r32) * 132;
#pragma unroll
            for (int dt = 0; dt < 4; ++dt)
#pragma unroll
                for (int G = 0; G < 4; ++G) {
                    u32x2 w; w.x = pk2(O[dt][4 * G] * gsig[0], O[dt][4 * G + 1] * gsig[0]); w.y = pk2(O[dt][4 * G + 2] * gsig[0], O[dt][4 * G + 3] * gsig[0]);
                    *(LAS u32x2*)(rp + dt * 32 + 8 * G + 4 * hh) = w;
                }
            if (wave == 0) {
                const int jf0 = *jf0w;
                int n = 0;
#pragma unroll
                for (int u4 = 3; u4 >= 0; --u4) {
                    const int j = lane + 64 * u4;
                    const bool sel = ((uni[2 * u4 + (lane >> 5)] >> (lane & 31)) & 1u) && j >= jf0;
                    const unsigned long long m = __ballot(sel);
                    const unsigned long long above = lane == 63 ? 0ull : (m >> (lane + 1));
                    if (sel) jlist[n + __popcll(above)] = (unsigned char)j;
                    n += __popcll(m);
                }
                if (lane == 0) *jcount = n;
            }
        }
        lds_barrier();
        float mr, lr;
        auto flash_tile = [&](int buf, int kbase, bool rowsel, int wlim, bool fast) {
            f32x16 S[2]; compS(buf, S);
            float rb = -slope * (float)(t - kbase) + slope * (float)(4 * hh); asm volatile("" : "+v"(rb));
#pragma unroll
            for (int ct = 0; ct < 2; ++ct)
#pragma unroll
                for (int i = 0; i < 16; ++i) S[ct][i] = fmaf(slope, KCONST(ct, i), S[ct][i]);
            if (!fast) {
                int d0 = t - kbase - 4 * hh; asm volatile("" : "+v"(d0));
#pragma unroll
                for (int ct = 0; ct < 2; ++ct)
#pragma unroll
                    for (int i = 0; i < 16; ++i) {
                        const int dist = d0 - (32 * ct + (i & 3) + 8 * (i >> 2));
                        S[ct][i] = (rowsel && dist >= 0 && dist < wlim) ? S[ct][i] : -1e30f;
                    }
            }
            float mt = -1e30f;
#pragma unroll
            for (int ct = 0; ct < 2; ++ct)
#pragma unroll
                for (int i = 0; i < 16; ++i) mt = fmaxf(mt, S[ct][i]);
            mt += rb;
            mt = fmaxf(mt, __shfl_xor(mt, 32));
            const float mn = fmaxf(mr, mt);
            if (__any(mn > mr)) {
                const float alpha = EX2(mr - mn);
                lr *= alpha;
#pragma unroll
                for (int dt = 0; dt < 4; ++dt) O[dt] = O[dt] * alpha;
            }
            mr = mn;
            const float off = mn - rb;
            float ls = 0.f;
#pragma unroll
            for (int ct = 0; ct < 2; ++ct)
#pragma unroll
                for (int i = 0; i < 16; ++i) { const float pe = EX2(S[ct][i] - off); S[ct][i] = pe; ls += pe; }
            lr += ls;
            compPV(buf, S, O);
        };
        {
            const int nj = __builtin_amdgcn_readfirstlane(*jcount);
            mr = -1e30f; lr = 0.f;
#pragma unroll
            for (int dt = 0; dt < 4; ++dt) O[dt] = zero16();
            const bf16_t* ksb = KS2 + (size_t)bg * 256 * 8192;
            const bf16_t* vsb = VST + (size_t)bg * 256 * 8192;
            auto jat = [&](int i) { return __builtin_amdgcn_readfirstlane((int)jlist[i]); };
            { const int j = jat(0); issue(RA, ksb + (size_t)j * 8192, vsb + (size_t)j * 8192, true); }
            if (nj > 1) { const int j = jat(1); issue(RB, ksb + (size_t)j * 8192, vsb + (size_t)j * 8192, true); }
            auto step3 = [&](int i, TileRegs& R) {
                const int buf = i & 1, j = jat(i);
                commit(R, buf, true);
                if (i + 2 < nj) { const int jn = jat(i + 2); issue(R, ksb + (size_t)jn * 8192, vsb + (size_t)jn * 8192, true); }
                lds_barrier();
                const bool rowsel = (selm[tl * 8 + (j >> 5)] >> (j & 31)) & 1u;
                if (__any(rowsel)) flash_tile(buf, 64 * j, rowsel, 1 << 30, j < qb && __all(rowsel));
            };
            for (int i = 0; i < nj; i += 2) { step3(i, RA); if (i + 1 < nj) step3(i + 1, RB); }
            const float lt = lr + __shfl_xor(lr, 32), inv = gsig[1] / lt;
            LAS bf16_t* rp = R1 + (wave * 32 + r32) * 132;
#pragma unroll
            for (int dt = 0; dt < 4; ++dt)
#pragma unroll
                for (int G = 0; G < 4; ++G) {
                    LAS u32x2* q = (LAS u32x2*)(rp + dt * 32 + 8 * G + 4 * hh);
                    const u32x2 old = *q; u32x2 w;
                    w.x = pk2(bflo(old.x) + O[dt][4 * G] * inv, bfhi(old.x) + O[dt][4 * G + 1] * inv);
                    w.y = pk2(bflo(old.y) + O[dt][4 * G + 2] * inv, bfhi(old.y) + O[dt][4 * G + 3] * inv);
                    *q = w;
                }
        }
        {
            mr = -1e30f; lr = 0.f;
#pragma unroll
            for (int dt = 0; dt < 4; ++dt) O[dt] = zero16();
            const bf16_t* kwb = KW2 + (size_t)bg * 256 * 8192;
            const bf16_t* vwb = VWT + (size_t)bg * 256 * 8192;
            const int j0 = qb - 8 > 0 ? qb - 8 : 0, nj = qb - j0 + 1;
            lds_barrier();
            issue(RA, kwb + (size_t)qb * 8192, vwb + (size_t)qb * 8192, true);
            if (nj > 1) issue(RB, kwb + (size_t)(qb - 1) * 8192, vwb + (size_t)(qb - 1) * 8192, true);
            auto step4 = [&](int i, TileRegs& R) {
                const int buf = i & 1, j = qb - i;
                commit(R, buf, true);
                if (i + 2 < nj) issue(R, kwb + (size_t)(j - 2) * 8192, vwb + (size_t)(j - 2) * 8192, true);
                lds_barrier();
                flash_tile(buf, 64 * j, true, 512, j < qb && j > qb - 8);
            };
            for (int i = 0; i < nj; i += 2) { step4(i, RA); if (i + 1 < nj) step4(i + 1, RB); }
            const float lt = lr + __shfl_xor(lr, 32), inv = gsig[2] / lt;
            const LAS bf16_t* rp = R1 + (wave * 32 + r32) * 132;
#pragma unroll
            for (int dt = 0; dt < 4; ++dt)
#pragma unroll
                for (int G = 0; G < 4; ++G) {
                    const int d0 = dt * 32 + 8 * G + 4 * hh;
                    const u32x2 old = *(const LAS u32x2*)(rp + d0);
                    const u32x2 zz = *(const u32x2*)(P1 + token * LD1 + C_Z + head * 128 + d0);
                    u32x2 w;
                    w.x = pk2(silu_f(bflo(zz.x)) * (bflo(old.x) + O[dt][4 * G] * inv), silu_f(bfhi(zz.x)) * (bfhi(old.x) + O[dt][4 * G + 1] * inv));
                    w.y = pk2(silu_f(bflo(zz.y)) * (bflo(old.y) + O[dt][4 * G + 2] * inv), silu_f(bfhi(zz.y)) * (bfhi(old.y) + O[dt][4 * G + 3] * inv));
                    *(u32x2*)(Y1 + token * DM + head * 128 + d0) = w;
                }
        }
        lds_barrier();
    }
}

DI void final_norm(float* out, const float* fg) {
    const int lane = threadIdx.x & 63, wave = threadIdx.x >> 6;
    const int nw = gridDim.x * 8, gw = blockIdx.x * 8 + wave;
    for (int row0 = gw * 2; row0 < T_; row0 += nw * 2) {
        f32x4 v[2][8]; float ss[2] = {0.f, 0.f};
#pragma unroll
        for (int q = 0; q < 2; ++q) {
            const f32x4* xr = (const f32x4*)(out + (size_t)(row0 + q) * DM);
#pragma unroll
            for (int i = 0; i < 8; ++i) v[q][i] = xr[lane + 64 * i];
        }
#pragma unroll
        for (int q = 0; q < 2; ++q)
#pragma unroll
            for (int i = 0; i < 8; ++i) ss[q] += v[q][i][0] * v[q][i][0] + v[q][i][1] * v[q][i][1] + v[q][i][2] * v[q][i][2] + v[q][i][3] * v[q][i][3];
        ss[0] = wave_sum(ss[0]); ss[1] = wave_sum(ss[1]);
#pragma unroll
        for (int q = 0; q < 2; ++q) {
            const float rs = rsqrtf(ss[q] * (1.f / 2048.f) + 1e-6f);
            f32x4* xr = (f32x4*)(out + (size_t)(row0 + q) * DM);
#pragma unroll
            for (int i = 0; i < 8; ++i) { const f32x4 gq = ((const f32x4*)fg)[lane + 64 * i]; xr[lane + 64 * i] = v[q][i] * rs * gq; }
        }
    }
}

#define XB_TMO      128
#define XB_XCNT(j)  (256  + 64 * (j))
#define XB_XSUB(j)  (1280 + 64 * (j))
#define XB_XGEN(j)  (2304 + 64 * (j))
#define XB_TOP      3328
#define XB_TOPGEN   3392
#define XCD_BAR_WORDS 3456
#define XB_SPIN_CAP (1u << 20)
DI unsigned xb_ld(unsigned* p) { return __hip_atomic_load(p, __ATOMIC_RELAXED, __HIP_MEMORY_SCOPE_AGENT); }
DI unsigned xb_add(unsigned* p, unsigned v) { return __hip_atomic_fetch_add(p, v, __ATOMIC_RELAXED, __HIP_MEMORY_SCOPE_AGENT); }
DI unsigned xb_xcc_id() { return (unsigned)__builtin_amdgcn_s_getreg((3 << 11) | 20) & 0xFu; }
#define XB_SPIN(cond, bar) do { unsigned _sp = 0; while (cond) { __builtin_amdgcn_s_sleep(1); \
    if ((++_sp & 255u) == 0u) { if (xb_ld(&(bar)[XB_TMO])) break; if (_sp > XB_SPIN_CAP) { atomicAdd(&(bar)[XB_TMO], 1u); break; } } } } while (0)
struct XcdBarrier { unsigned* bar; unsigned x; volatile LAS unsigned* st; };
DI XcdBarrier xcd_barrier_post(unsigned* bar, volatile LAS unsigned* st) {
    XcdBarrier b; b.bar = bar; b.x = xb_xcc_id(); b.st = st;
    if (threadIdx.x == 0) (void)xb_add(&bar[XB_XCNT(b.x)], 1u);
    return b;
}
DI void xcd_barrier_complete(unsigned* bar, unsigned x, unsigned& nloc, unsigned& nx) {
    const unsigned G = gridDim.x * gridDim.y * gridDim.z;
    unsigned sum, cnt, mine, sp = 0u;
    for (;;) {
        sum = 0u; cnt = 0u; mine = 0u;
#pragma unroll
        for (unsigned j = 0; j < 16; ++j) { const unsigned c = xb_ld(&bar[XB_XCNT(j)]); sum += c; cnt += (c > 0u) ? 1u : 0u; mine = (j == x) ? c : mine; }
        if (sum == G) break;
        __builtin_amdgcn_s_sleep(1);
        if ((++sp & 255u) == 0u) { if (xb_ld(&bar[XB_TMO])) break; if (sp > XB_SPIN_CAP) { atomicAdd(&bar[XB_TMO], 1u); break; } }
    }
    nloc = mine > 0u ? mine : 1u; nx = cnt > 0u ? cnt : 1u;
}
DI void xcd_barrier(const XcdBarrier& b) {
    asm volatile("s_waitcnt vmcnt(0)" ::: "memory");
    __syncthreads();
    if (threadIdx.x == 0) {
        unsigned* bar = b.bar;
        __builtin_amdgcn_s_waitcnt(0);
        unsigned nloc = b.st[0], nx = b.st[1];
        if (nloc == 0u) { xcd_barrier_complete(bar, b.x, nloc, nx); b.st[0] = nloc; b.st[1] = nx; }
        const unsigned old = xb_add(&bar[XB_XSUB(b.x)], 1u);
        const unsigned gen = old / nloc;
        if (old + 1u == (gen + 1u) * nloc) {
            __builtin_amdgcn_fence(__ATOMIC_RELEASE, "agent");
            asm volatile("s_waitcnt vmcnt(0)" ::: "memory");
            const unsigned og = xb_add(&bar[XB_TOP], 1u);
            const unsigned tg = og / nx;
            if (og + 1u == (tg + 1u) * nx) xb_add(&bar[XB_TOPGEN], 1u);
            else XB_SPIN(xb_ld(&bar[XB_TOPGEN]) == tg, bar);
            __builtin_amdgcn_fence(__ATOMIC_ACQUIRE, "agent");
            xb_add(&bar[XB_XGEN(b.x)], 1u);
            asm volatile("s_waitcnt vmcnt(0)" ::: "memory");
        } else {
            XB_SPIN(xb_ld(&bar[XB_XGEN(b.x)]) == gen, bar);
            __builtin_amdgcn_fence(__ATOMIC_ACQUIRE, "agent");
            asm volatile("s_waitcnt vmcnt(0)" ::: "memory");
        }
    }
    __syncthreads();
}

constexpr int NPHASE = 11;
__global__ void __launch_bounds__(NTHREADS, 2) fwd_kernel(Params p) {
    extern __shared__ __attribute__((aligned(16))) unsigned char lds_raw[];
    LAS unsigned char* lds = (LAS unsigned char*)lds_raw;
    unsigned char* ws = p.ws;
    bf16_t* PROJ = (bf16_t*)(ws + OFF_PROJ);
    bf16_t* XB = (bf16_t*)(ws + OFF_XB);
    const int lo = p.ph_lo, hi = p.ph_hi;
#ifndef PHMASK
#define PHMASK 0x7ff
#endif
#define IN(k) (((PHMASK >> (k)) & 1) && lo <= (k) && (k) < hi)
    volatile LAS unsigned* xst = (volatile LAS unsigned*)(lds + LDS_BYTES - 16);
    XcdBarrier xbar; xbar.bar = (unsigned*)(ws + OFF_BAR); xbar.x = 0; xbar.st = xst;
    if (hi - lo > 1) {
        if (threadIdx.x < 2) xst[threadIdx.x] = 0u;
        __syncthreads();
        xbar = xcd_barrier_post((unsigned*)(ws + OFF_BAR), xst);
    }
#define SEAM(k) do { if ((k) + 1 < hi) { if ((k) == 0) cg::this_grid().sync(); else xcd_barrier(xbar); } } while (0)
#ifndef REPMASK
#define REPMASK 0
#endif
#define REP(k) ((REPMASK >> (k)) & 1)
#define GS() cg::this_grid().sync()
    if (IN(0)) { if (REP(0)) { phase0(p, lds); GS(); } phase0(p, lds); SEAM(0); }
    if (IN(1)) {
        pg8::Gemm g{XB, (const bf16_t*)(ws + OFF_W1T), 2048, 2048, T_, 12288, 2048}; pg8::StaticOrder S; S.init(T_, 12288, gridDim.x, blockIdx.x);
        pg8::EpiScaleBf16<2> E{PROJ, LD0, nullptr};
        if (REP(1)) { pg8::gemm_phase(lds, g, S, E); GS(); }
        pg8::gemm_phase(lds, g, S, E); SEAM(1);
    }
    if (IN(2)) { if (REP(2)) { ret_intra(PROJ, (bf16_t*)p.out, XB, lds); GS(); } ret_intra(PROJ, (bf16_t*)p.out, XB, lds); SEAM(2); }
    if (IN(3)) { for (int rep = REP(3) ? 0 : 1; rep < 2; ++rep) { ret_inter(PROJ, (const bf16_t*)p.out, XB, lds, rep == 0); if (rep == 0) GS(); } SEAM(3); }
    if (IN(4)) { if (REP(4)) { ret_gate(PROJ, XB); GS(); } ret_gate(PROJ); SEAM(4); }
    if (IN(5)) {
        pg8::Gemm g{PROJ + 8192, (const bf16_t*)(ws + OFF_W2T), LD0, 4096, T_, 2048, 4096}; pg8::StaticOrder S; S.init(T_, 2048, gridDim.x, blockIdx.x);
        if (REP(5)) { pg8::EpiResid E0{p.x, p.out, XB, nullptr}; pg8::gemm_phase(lds, g, S, E0); GS(); }
        pg8::EpiResid E{p.x, p.out, XB, (float*)(ws + OFF_SS1)};
        pg8::gemm_phase(lds, g, S, E); SEAM(5);
    }
    if (IN(6)) {
        pg8::Gemm g{XB, (const bf16_t*)(ws + OFF_W3T), 2048, 2048, T_, LD1, 2048}; pg8::StaticOrder S; S.init(T_, LD1, gridDim.x, blockIdx.x);
        pg8::EpiScaleBf16<1> E{PROJ, LD1, (const float*)(ws + OFF_SS1)};
        if (REP(6)) { pg8::gemm_phase(lds, g, S, E); GS(); }
        pg8::gemm_phase(lds, g, S, E); SEAM(6);
    }
    if (IN(7)) {
        if (REP(7)) { nsa_compress(PROJ, ws, (bf16_t*)(ws + OFF_KC), (bf16_t*)(ws + OFF_VCT), (bf16_t*)(ws + OFF_VST), (bf16_t*)(ws + OFF_VWT), (bf16_t*)(ws + OFF_KS2), (bf16_t*)(ws + OFF_KW2), lds); GS(); }
        nsa_compress(PROJ, ws, (bf16_t*)(ws + OFF_KC), (bf16_t*)(ws + OFF_VCT), (bf16_t*)(ws + OFF_VST), (bf16_t*)(ws + OFF_VWT), (bf16_t*)(ws + OFF_KS2), (bf16_t*)(ws + OFF_KW2), lds); SEAM(7); }
    if (IN(8)) {
        if (REP(8)) { nsa_attn(PROJ, (const bf16_t*)(ws + OFF_KC), (const bf16_t*)(ws + OFF_VCT), (const bf16_t*)(ws + OFF_VST), (const bf16_t*)(ws + OFF_VWT), (const bf16_t*)(ws + OFF_KS2), (const bf16_t*)(ws + OFF_KW2), (const float*)(ws + OFF_KINF), XB, lds); GS(); }
        nsa_attn(PROJ, (const bf16_t*)(ws + OFF_KC), (const bf16_t*)(ws + OFF_VCT), (const bf16_t*)(ws + OFF_VST), (const bf16_t*)(ws + OFF_VWT), (const bf16_t*)(ws + OFF_KS2), (const bf16_t*)(ws + OFF_KW2), (const float*)(ws + OFF_KINF), XB, lds); SEAM(8); }
    if (IN(9)) {
        pg8::Gemm g{XB, (const bf16_t*)(ws + OFF_W4T), 2048, 2048, T_, 2048, 2048}; pg8::StaticOrder S; S.init(T_, 2048, gridDim.x, blockIdx.x);
        if (REP(9)) { pg8::EpiResid E0{p.out, (float*)PROJ, nullptr, nullptr}; pg8::gemm_phase(lds, g, S, E0); GS(); }
        pg8::EpiResid E{p.out, p.out, nullptr, nullptr};
        pg8::gemm_phase(lds, g, S, E); SEAM(9);
    }
    if (IN(10)) { final_norm(p.out, p.final_g); }
#undef IN
#undef SEAM
}

extern "C" void kernel_launch(void* const* d_in, const int* in_sizes, int n_in, void* d_out, int out_size, void* d_ws, size_t ws_size, hipStream_t stream) {
    static int grid = 0;
    if (grid == 0) {
        if (n_in != 13 || out_size != T_ * DM || ws_size < WS_END) { fprintf(stderr, "kernel_launch: unexpected shapes (n_in %d out %d ws %zu need %zu)\n", n_in, out_size, ws_size, (size_t)WS_END); grid = -1; return; }
        int dev = 0, cus = 0, per_cu = 0;
        hipGetDevice(&dev); hipDeviceGetAttribute(&cus, hipDeviceAttributeMultiprocessorCount, dev);
        if (hipFuncSetAttribute((const void*)fwd_kernel, hipFuncAttributeMaxDynamicSharedMemorySize, LDS_BYTES) != hipSuccess) { fprintf(stderr, "kernel_launch: hipFuncSetAttribute failed\n"); grid = -1; return; }
        hipOccupancyMaxActiveBlocksPerMultiprocessor(&per_cu, (const void*)fwd_kernel, NTHREADS, LDS_BYTES);
        (void)hipGetLastError();
        if (per_cu < 1) per_cu = 1;
        grid = cus * 1;
    }
    if (grid < 0) return;
    Params p{};
    p.x = (const float*)d_in[0]; p.norm_g = (const float*)d_in[1]; p.ret_w_in = (const float*)d_in[2]; p.ret_w_out = (const float*)d_in[3];
    p.nsa_w_in = (const float*)d_in[4]; p.pos_k = (const float*)d_in[5]; p.w1_k = (const float*)d_in[6]; p.w2_k = (const float*)d_in[7];
    p.pos_v = (const float*)d_in[8]; p.w1_v = (const float*)d_in[9]; p.w2_v = (const float*)d_in[10]; p.nsa_w_out = (const float*)d_in[11];
    p.final_g = (const float*)d_in[12]; p.out = (float*)d_out; p.ws = (unsigned char*)d_ws;
#if SINGLE_LAUNCH
    hipMemsetAsync((char*)d_ws + OFF_BAR, 0, 16384, stream);
    p.ph_lo = 0; p.ph_hi = NPHASE;
    void* args[] = {&p};
    hipError_t e = hipLaunchCooperativeKernel((const void*)fwd_kernel, dim3(grid), dim3(NTHREADS), args, LDS_BYTES, stream);
    if (e != hipSuccess) fprintf(stderr, "cooperative launch failed: %s (grid %d)\n", hipGetErrorString(e), grid);
#else
    for (int k = 0; k < NPHASE; ++k) {
        p.ph_lo = k; p.ph_hi = k + 1;
        hipLaunchKernelGGL(fwd_kernel, dim3(grid), dim3(NTHREADS), LDS_BYTES, stream, p);
    }
#endif
}
```

```cpp
#include <hip/hip_runtime.h>
#include <hip/hip_cooperative_groups.h>
#include <cstdio>
namespace cg = cooperative_groups;

#ifndef SINGLE_LAUNCH
#define SINGLE_LAUNCH 1
#endif

#define DI __device__ __forceinline__
#define LAS __attribute__((address_space(3)))
typedef unsigned short bf16_t;
typedef short bf16x8 __attribute__((ext_vector_type(8)));
typedef short s16x4 __attribute__((ext_vector_type(4)));
typedef float f32x4 __attribute__((ext_vector_type(4)));
typedef float f32x16 __attribute__((ext_vector_type(16)));
typedef unsigned u32x4 __attribute__((ext_vector_type(4)));
typedef unsigned u32x2 __attribute__((ext_vector_type(2)));
typedef __bf16 bf2_t __attribute__((ext_vector_type(2)));

constexpr int T_ = 32768, S_ = 16384, DM = 2048;
constexpr int LD0 = 12288;
constexpr int LD1 = 7424;
constexpr int C_KC = 2048, C_VC = 2560, C_KS = 3072, C_VS = 3584, C_KW = 4096, C_VW = 4608, C_Z = 5120, C_G = 7168;
constexpr int NTHREADS = 512;
constexpr int LDS_BYTES = 160 * 1024;

constexpr size_t OFF_W1T = 0;
constexpr size_t OFF_W2T = OFF_W1T + (size_t)12288 * 2048 * 2;
constexpr size_t OFF_W3T = OFF_W2T + (size_t)2048 * 4096 * 2;
constexpr size_t OFF_W4T = OFF_W3T + (size_t)LD1 * 2048 * 2;
constexpr size_t OFF_CW1K = OFF_W4T + (size_t)2048 * 2048 * 2;
constexpr size_t OFF_CW1V = OFF_CW1K + (size_t)128 * 4096 * 2;
constexpr size_t OFF_CW2K = OFF_CW1V + (size_t)128 * 4096 * 2;
constexpr size_t OFF_CW2V = OFF_CW2K + (size_t)128 * 128 * 2;
constexpr size_t OFF_CB = OFF_CW2V + (size_t)128 * 128 * 2;
constexpr size_t OFF_RSTD0 = OFF_CB + 1024;
constexpr size_t OFF_SS1 = OFF_RSTD0 + (size_t)T_ * 4;
constexpr size_t OFF_KC = OFF_SS1 + (size_t)T_ * 4;
constexpr size_t OFF_VCT = OFF_KC + (size_t)8 * 1024 * 128 * 2;
constexpr size_t OFF_XB = OFF_VCT + (size_t)8 * 1024 * 128 * 2;
constexpr size_t OFF_PROJ = OFF_XB + (size_t)T_ * 2048 * 2;
constexpr size_t OFF_VST = OFF_PROJ + (size_t)T_ * LD1 * 2;
constexpr size_t OFF_VWT = OFF_VST + (size_t)8 * 128 * S_ * 2;
constexpr size_t OFF_KS2 = OFF_VWT + (size_t)8 * 128 * S_ * 2;
constexpr size_t OFF_KW2 = OFF_KS2 + (size_t)8 * 128 * S_ * 2;
constexpr size_t OFF_BAR = OFF_PROJ + (size_t)T_ * LD0 * 2;
constexpr size_t OFF_CBZ = OFF_BAR + 14336;
constexpr size_t OFF_KINF = OFF_BAR + 15360;
constexpr size_t WS_END = OFF_BAR + 16384;
static_assert(OFF_KW2 + (size_t)8 * 128 * S_ * 2 <= WS_END, "ws map");

struct Params {
    const float* x; const float* norm_g; const float* ret_w_in; const float* ret_w_out; const float* nsa_w_in;
    const float* pos_k; const float* w1_k; const float* w2_k; const float* pos_v; const float* w1_v; const float* w2_v;
    const float* nsa_w_out; const float* final_g; float* out; unsigned char* ws; int ph_lo, ph_hi;
};

DI unsigned pk2(float lo, float hi) { bf2_t v; v.x = (__bf16)lo; v.y = (__bf16)hi; return __builtin_bit_cast(unsigned, v); }
DI float bflo(unsigned u) { return __uint_as_float(u << 16); }
DI float bfhi(unsigned u) { return __uint_as_float(u & 0xffff0000u); }
#define DPPF(v, ctrl) __int_as_float(__builtin_amdgcn_mov_dpp(__float_as_int(v), (ctrl), 0xF, 0xF, true))
DI float wave_sum(float v) {
    v += DPPF(v, 0xB1);
    v += DPPF(v, 0x4E);
    v += DPPF(v, 0x141);
    v += DPPF(v, 0x140);
    return (__int_as_float(__builtin_amdgcn_readlane(__float_as_int(v), 0)) + __int_as_float(__builtin_amdgcn_readlane(__float_as_int(v), 16))) +
           (__int_as_float(__builtin_amdgcn_readlane(__float_as_int(v), 32)) + __int_as_float(__builtin_amdgcn_readlane(__float_as_int(v), 48)));
}
DI void lds_barrier() { asm volatile("s_waitcnt lgkmcnt(0)\n\ts_barrier" ::: "memory"); }
DI float silu_f(float x) { return x / (1.f + __expf(-x)); }
DI float sigm_f(float x) { return 1.f / (1.f + __expf(-x)); }
DI int crow(int i, int hh) { return (i & 3) + 8 * (i >> 2) + 4 * hh; }
#define MFMA32(a, b, c) __builtin_amdgcn_mfma_f32_32x32x16_bf16((a), (b), (c), 0, 0, 0)
DI f32x16 zero16() { f32x16 z; for (int i = 0; i < 16; ++i) z[i] = 0.f; return z; }
DI bf16x8 ldsfrag(const LAS bf16_t* p) { return *(const LAS bf16x8*)p; }
DI void tr4x8(const u32x4 (&R)[4], u32x2 (&o)[8]) {
#pragma unroll
    for (int d = 0; d < 4; ++d) {
        const unsigned a0 = R[0][d], a1 = R[1][d], a2 = R[2][d], a3 = R[3][d];
        o[2 * d][0] = (a0 & 0xffffu) | (a1 << 16); o[2 * d][1] = (a2 & 0xffffu) | (a3 << 16);
        o[2 * d + 1][0] = (a0 >> 16) | (a1 & 0xffff0000u); o[2 * d + 1][1] = (a2 >> 16) | (a3 & 0xffff0000u);
    }
}

namespace pg8 {
constexpr int BM = 256, BK = 64, HALF = 128, HTB = HALF * BK * 2, STAGE_BYTES = 8 * HTB, NXCD = 8, WGM = 8;
DI int lds_byte(int r, int c) { const int st = (r >> 4) * 2 + (c >> 5), rr = r & 15, cc = c & 31, ob = rr * 64 + cc * 2; return st * 1024 + (ob ^ (((ob >> 9) & 1) << 5)); }
DI void stage_rc(int b, int& R, int& C) { const int st = b / 1024, sb = b % 1024, swz = sb ^ (((sb >> 9) & 1) << 5); R = (st >> 1) * 16 + swz / 64; C = (st & 1) * 32 + (swz % 64) / 2; }
DI int perm32(int rho) { const int n = rho >> 4, i = rho & 15; return 8 * (i >> 2) + 4 * n + (i & 3); }
struct Unit { int pm, pn; };
struct Gemm { const bf16_t* A; const bf16_t* Bt; int lda, ldb, M, N, K; };
struct StaticOrder {
    int nM, nN, nwg, G, c;
    DI void init(int M, int N, int G_, int c_) { nM = M / BM; nN = N / BM; nwg = nM * nN; G = G_; c = c_; }
    DI bool next(int i, Unit& u) const {
        const long L = (long)i * G + c; if (L >= nwg) return false;
        int wgid = (int)L; { const int q = nwg / NXCD, r = nwg % NXCD, xcd = wgid % NXCD, off = wgid / NXCD; wgid = (xcd < r ? xcd * (q + 1) : r * (q + 1) + (xcd - r) * q) + off; }
        const int nig = WGM * nN, gid = wgid / nig, fm = gid * WGM, gsz = (nM - fm) < WGM ? (nM - fm) : WGM;
        u.pm = fm + ((wgid % nig) % gsz); u.pn = (wgid % nig) / gsz; return true;
    }
};

template <class Epi>
DI void gemm_phase(LAS unsigned char* lds, const Gemm g, const StaticOrder& S, const Epi& E) {
    const int tid = threadIdx.x, wid = __builtin_amdgcn_readfirstlane(tid >> 6), lane = tid & 63, wr = wid >> 2, wc = wid & 3, fr = lane & 15, fq = lane >> 4;
    const int K = g.K, nt = K / BK;
    unsigned voffA[2], voffB[2];
#pragma unroll
    for (int i = 0; i < 2; ++i) { int R, C; stage_rc(tid * 16 + i * 8192, R, C); const int Rb = Epi::PERM ? ((R & ~31) + perm32(R & 31)) : R;
        voffA[i] = (unsigned)(R * g.lda + C) * 2u; voffB[i] = (unsigned)(Rb * g.ldb + C) * 2u; }
    const size_t kstep = (size_t)(BK * 2);
    const size_t hstepA = (size_t)HALF * g.lda * 2, hstepB = (size_t)HALF * g.ldb * 2;
    const size_t tstepA = 2 * hstepA, tstepB = 2 * hstepB;
    const unsigned ldsw = (unsigned)wid * 1024u;
    const int aoff = lds_byte(wr * 64 + fr, fq * 8), boff = lds_byte(wc * 32 + fr, fq * 8);
#define PG8_SA(b, h) (((b) * 2 + (h)) * HTB)
#define PG8_SB(b, h) ((4 + (b) * 2 + (h)) * HTB)
#define PG8_STAGE(bufoff, gbase, voff) do { _Pragma("unroll") for (int _i = 0; _i < 2; ++_i) \
        __builtin_amdgcn_global_load_lds((const unsigned*)((const char*)(gbase) + (voff)[_i]), (LAS unsigned*)(lds + (bufoff) + ldsw + _i * 8192), 16, 0, 0); } while (0)
#define PG8_LDA(dst, b, h) do { _Pragma("unroll") for (int m = 0; m < 4; ++m) _Pragma("unroll") for (int k = 0; k < 2; ++k) dst[m][k] = *(const LAS bf16x8*)(lds + PG8_SA(b, h) + aoff + m * 2048 + k * 1024); } while (0)
#define PG8_LDB(dst, b, h) do { _Pragma("unroll") for (int n = 0; n < 2; ++n) _Pragma("unroll") for (int k = 0; k < 2; ++k) dst[n][k] = *(const LAS bf16x8*)(lds + PG8_SB(b, h) + boff + n * 2048 + k * 1024); } while (0)
#define PG8_MMA(ai, bj, At, Bt) do { __builtin_amdgcn_s_setprio(1); _Pragma("unroll") for (int m = 0; m < 4; ++m) _Pragma("unroll") for (int n = 0; n < 2; ++n) _Pragma("unroll") for (int k = 0; k < 2; ++k) \
        acc[ai][bj][m][n] = __builtin_amdgcn_mfma_f32_16x16x32_bf16(Bt[n][k], At[m][k], acc[ai][bj][m][n], 0, 0, 0); __builtin_amdgcn_s_setprio(0); } while (0)
#define PG8_WAIT_V(n) asm volatile("s_waitcnt vmcnt(" #n ")" ::: "memory")
#define PG8_WAIT_L(n) asm volatile("s_waitcnt lgkmcnt(" #n ")" ::: "memory")
#define PG8_BAR __builtin_amdgcn_s_barrier()
#define PG8_SCHED __builtin_amdgcn_sched_barrier(0)
    Unit cur, nxt; int ui = 0;
    if (!S.next(0, cur)) return;
    f32x4 acc[2][2][4][2];
#pragma unroll
    for (int a = 0; a < 2; ++a)
#pragma unroll
        for (int b = 0; b < 2; ++b)
#pragma unroll
            for (int m = 0; m < 4; ++m)
#pragma unroll
                for (int n = 0; n < 2; ++n) acc[a][b][m][n] = (f32x4){0.f, 0.f, 0.f, 0.f};
    bf16x8 At[4][2], B0[2][2], B1[2][2];
    const char* cA = (const char*)g.A + (size_t)cur.pm * tstepA; const char* cB = (const char*)g.Bt + (size_t)cur.pn * tstepB;
    PG8_STAGE(PG8_SB(0, 0), cB, voffB); PG8_STAGE(PG8_SA(0, 0), cA, voffA); PG8_STAGE(PG8_SB(0, 1), cB + hstepB, voffB); PG8_STAGE(PG8_SA(0, 1), cA + hstepA, voffA);
    if (wr == 1) PG8_BAR;
    PG8_WAIT_V(4); PG8_BAR;
    PG8_STAGE(PG8_SB(1, 0), cB + kstep, voffB); PG8_STAGE(PG8_SA(1, 0), cA + kstep, voffA); PG8_STAGE(PG8_SB(1, 1), cB + hstepB + kstep, voffB);
    PG8_WAIT_V(6); PG8_BAR;
    for (;;) {
        const bool has_next = S.next(ui + 1, nxt);
        const char* nA = has_next ? (const char*)g.A + (size_t)nxt.pm * tstepA : cA; const char* nB = has_next ? (const char*)g.Bt + (size_t)nxt.pn * tstepB : cB;
        for (int t = 0; t < nt; t += 2) {
            const bool last = (t == nt - 2);
            const char* a1 = cA + (size_t)(t + 1) * kstep;
            const char* a2 = last ? nA : cA + (size_t)(t + 2) * kstep; const char* b2 = last ? nB : cB + (size_t)(t + 2) * kstep;
            const char* a3 = a2 + kstep; const char* b3 = b2 + kstep;
            PG8_LDB(B0, 0, 0); PG8_SCHED; PG8_LDA(At, 0, 0); PG8_STAGE(PG8_SA(1, 1), a1 + hstepA, voffA);
            PG8_WAIT_L(8); PG8_BAR; PG8_WAIT_L(0); PG8_MMA(0, 0, At, B0); PG8_BAR; PG8_SCHED;
            PG8_LDB(B1, 0, 1); PG8_STAGE(PG8_SB(0, 0), b2, voffB);
            PG8_BAR; PG8_WAIT_L(0); PG8_MMA(0, 1, At, B1); PG8_BAR;
            PG8_LDA(At, 0, 1); PG8_STAGE(PG8_SA(0, 0), a2, voffA);
            PG8_BAR; PG8_WAIT_L(0); PG8_MMA(1, 0, At, B0); PG8_BAR; PG8_SCHED;
            PG8_STAGE(PG8_SB(0, 1), b2 + hstepB, voffB);
            PG8_WAIT_V(6); PG8_BAR; PG8_MMA(1, 1, At, B1); PG8_BAR;
            PG8_LDB(B0, 1, 0); PG8_SCHED; PG8_LDA(At, 1, 0); PG8_STAGE(PG8_SA(0, 1), a2 + hstepA, voffA);
            PG8_WAIT_L(8); PG8_BAR; PG8_WAIT_L(0); PG8_MMA(0, 0, At, B0); PG8_BAR; PG8_SCHED;
            PG8_LDB(B1, 1, 1); PG8_STAGE(PG8_SB(1, 0), b3, voffB);
            PG8_BAR; PG8_WAIT_L(0); PG8_MMA(0, 1, At, B1); PG8_BAR;
            PG8_LDA(At, 1, 1); PG8_STAGE(PG8_SA(1, 0), a3, voffA);
            PG8_BAR; PG8_WAIT_L(0); PG8_MMA(1, 0, At, B0); PG8_BAR; PG8_SCHED;
            PG8_STAGE(PG8_SB(1, 1), b3 + hstepB, voffB);
            PG8_WAIT_V(6); PG8_BAR; PG8_MMA(1, 1, At, B1); PG8_BAR;
        }
        E(acc, cur, wr, wc, fr, fq);
        if (!has_next) break;
#pragma unroll
        for (int a = 0; a < 2; ++a)
#pragma unroll
            for (int b = 0; b < 2; ++b)
#pragma unroll
                for (int m = 0; m < 4; ++m)
#pragma unroll
                    for (int n = 0; n < 2; ++n) acc[a][b][m][n] = (f32x4){0.f, 0.f, 0.f, 0.f};
        cur = nxt; cA = nA; cB = nB; ++ui;
    }
    PG8_WAIT_V(0);
    if (wr == 0) PG8_BAR;
    PG8_BAR;
#undef PG8_SA
#undef PG8_SB
#undef PG8_STAGE
#undef PG8_LDA
#undef PG8_LDB
#undef PG8_MMA
#undef PG8_WAIT_V
#undef PG8_WAIT_L
#undef PG8_BAR
#undef PG8_SCHED
}

template <int MODE> struct EpiScaleBf16 {
    static constexpr bool PERM = true;
    bf16_t* O; int ldc; const float* rs;
    DI void operator()(const f32x4 (&acc)[2][2][4][2], const Unit& u, int wr, int wc, int fr, int fq) const {
        const int row0 = u.pm * BM + wr * 64 + fr, col0 = u.pn * BM + wc * 32 + 8 * fq;
#pragma unroll
        for (int ai = 0; ai < 2; ++ai)
#pragma unroll
            for (int m = 0; m < 4; ++m) {
                const int row = row0 + ai * HALF + m * 16;
                float sc = 1.f;
                if (MODE != 2) { sc = rs[row]; if (MODE == 1) sc = rsqrtf(sc * (1.f / 2048.f) + 1e-6f); }
                bf16_t* rowp = O + (size_t)row * ldc + col0;
#pragma unroll
                for (int bj = 0; bj < 2; ++bj) {
                    const f32x4 v0 = acc[ai][bj][m][0] * sc, v1 = acc[ai][bj][m][1] * sc;
                    u32x4 w; w.x = pk2(v0[0], v0[1]); w.y = pk2(v0[2], v0[3]); w.z = pk2(v1[0], v1[1]); w.w = pk2(v1[2], v1[3]);
                    *(u32x4*)(rowp + bj * HALF) = w;
                }
            }
    }
};
struct EpiResid {
    static constexpr bool PERM = false;
    const float* R; float* H; bf16_t* HB; float* SS;
    DI void operator()(const f32x4 (&acc)[2][2][4][2], const Unit& u, int wr, int wc, int fr, int fq) const {
        const int row0 = u.pm * BM + wr * 64 + fr, col0 = u.pn * BM + wc * 32 + 4 * fq;
#pragma unroll
        for (int ai = 0; ai < 2; ++ai)
#pragma unroll
            for (int m = 0; m < 4; ++m) {
                const int row = row0 + ai * HALF + m * 16;
                const size_t ro = (size_t)row * DM + col0;
                float ss = 0.f;
#pragma unroll
                for (int bj = 0; bj < 2; ++bj)
#pragma unroll
                    for (int n = 0; n < 2; ++n) {
                        const size_t o = ro + bj * HALF + n * 16;
                        const f32x4 r = *(const f32x4*)(R + o);
                        const f32x4 v = acc[ai][bj][m][n] + r;
                        *(f32x4*)(H + o) = v;
                        ss += v[0] * v[0] + v[1] * v[1] + v[2] * v[2] + v[3] * v[3];
                        if (HB) { u32x2 w; w.x = pk2(v[0], v[1]); w.y = pk2(v[2], v[3]); *(u32x2*)(HB + o) = w; }
                    }
                if (SS) { ss += __shfl_xor(ss, 16); ss += __shfl_xor(ss, 32); if (fq == 0) atomicAdd(SS + row, ss); }
            }
    }
};
}

DI void tconv(const float* src, int K, int N, bf16_t* dst, int Npad, const float* rs, int mode, LAS float* tile) {
    const int tid = threadIdx.x, nkt = K / 64, ntiles = nkt * (Npad / 128);
    float vv[16];
    auto ldt = [&](int tl) {
        const int kt = tl % nkt, ntb = tl / nkt, k0 = kt * 64, n0 = ntb * 128;
#pragma unroll
        for (int i = 0; i < 4; ++i) {
            const int idx = tid + i * 512, kk = idx >> 5, n = n0 + (idx & 31) * 4;
            int sc = n < N ? n : -1; float scale = 1.f;
            if (mode == 1) { scale = (n >= 2048 && n < 4096) ? 0.0625f : 1.f; }
            if (mode == 2) {
                if (n < 5120) { sc = n; scale = n < 2048 ? 0.12751743074602467f : 1.f; }
                else if (n < 7168) sc = n + 48;
                else if (n < 7216) sc = n - 2048;
                else sc = -1;
            }
            f32x4 v = (f32x4){0.f, 0.f, 0.f, 0.f};
            if (sc >= 0) { v = *(const f32x4*)(src + (size_t)(k0 + kk) * N + sc); if (rs) scale *= rs[k0 + kk]; v = v * scale; }
            vv[4 * i] = v[0]; vv[4 * i + 1] = v[1]; vv[4 * i + 2] = v[2]; vv[4 * i + 3] = v[3];
        }
    };
    if ((int)blockIdx.x < ntiles) ldt(blockIdx.x);
    for (int tl = blockIdx.x; tl < ntiles; tl += gridDim.x) {
        const int kt = tl % nkt, ntb = tl / nkt, k0 = kt * 64, n0 = ntb * 128;
#pragma unroll
        for (int i = 0; i < 4; ++i) { const int idx = tid + i * 512, kk = idx >> 5, nn = (idx & 31) * 4;
#pragma unroll
            for (int e = 0; e < 4; ++e) tile[kk * 129 + nn + e] = vv[4 * i + e]; }
        if (tl + (int)gridDim.x < ntiles) ldt(tl + gridDim.x);
        lds_barrier();
#pragma unroll
        for (int i = 0; i < 2; ++i) {
            const int id = tid + 512 * i, k8 = id & 7, nn = id >> 3;
            u32x4 w;
#pragma unroll
            for (int d = 0; d < 4; ++d) w[d] = pk2(tile[(k8 * 8 + 2 * d) * 129 + nn], tile[(k8 * 8 + 2 * d + 1) * 129 + nn]);
            *(u32x4*)(dst + (size_t)(n0 + nn) * K + k0 + k8 * 8) = w;
        }
        lds_barrier();
    }
}

DI void phase0(const Params& p, LAS unsigned char* lds) {
    unsigned char* ws = p.ws;
    LAS float* tile = (LAS float*)lds;
    const int tid = threadIdx.x, lane = tid & 63, wave = tid >> 6;
    tconv(p.ret_w_in, 2048, 12288, (bf16_t*)(ws + OFF_W1T), 12288, p.norm_g, 1, tile);
    tconv(p.ret_w_out, 4096, 2048, (bf16_t*)(ws + OFF_W2T), 2048, nullptr, 0, tile);
    tconv(p.nsa_w_in, 2048, 7216, (bf16_t*)(ws + OFF_W3T), LD1, p.norm_g + 2048, 2, tile);
    tconv(p.nsa_w_out, 2048, 2048, (bf16_t*)(ws + OFF_W4T), 2048, nullptr, 0, tile);
    tconv(p.w1_k, 4096, 128, (bf16_t*)(ws + OFF_CW1K), 128, nullptr, 0, tile);
    tconv(p.w1_v, 4096, 128, (bf16_t*)(ws + OFF_CW1V), 128, nullptr, 0, tile);
    tconv(p.w2_k, 128, 128, (bf16_t*)(ws + OFF_CW2K), 128, nullptr, 0, tile);
    tconv(p.w2_v, 128, 128, (bf16_t*)(ws + OFF_CW2V), 128, nullptr, 0, tile);
    bf16_t* xb = (bf16_t*)(ws + OFF_XB); float* rstd0 = (float*)(ws + OFF_RSTD0); float* ss1 = (float*)(ws + OFF_SS1);
    for (int row0 = (blockIdx.x * 8 + wave) * 2; row0 < T_; row0 += gridDim.x * 16) {
        f32x4 v[2][8]; float ss[2] = {0.f, 0.f};
#pragma unroll
        for (int q = 0; q < 2; ++q) {
            const f32x4* xr = (const f32x4*)(p.x + (size_t)(row0 + q) * DM);
#pragma unroll
            for (int i = 0; i < 8; ++i) v[q][i] = xr[lane + 64 * i];
        }
#pragma unroll
        for (int q = 0; q < 2; ++q)
#pragma unroll
            for (int i = 0; i < 8; ++i) ss[q] += v[q][i][0] * v[q][i][0] + v[q][i][1] * v[q][i][1] + v[q][i][2] * v[q][i][2] + v[q][i][3] * v[q][i][3];
        ss[0] = wave_sum(ss[0]); ss[1] = wave_sum(ss[1]);
#pragma unroll
        for (int q = 0; q < 2; ++q) {
            const float rs0 = rsqrtf(ss[q] * (1.f / 2048.f) + 1e-6f);
#pragma unroll
            for (int i = 0; i < 8; ++i) { u32x2 w; w.x = pk2(v[q][i][0] * rs0, v[q][i][1] * rs0); w.y = pk2(v[q][i][2] * rs0, v[q][i][3] * rs0); *(u32x2*)(xb + (size_t)(row0 + q) * DM + (lane + 64 * i) * 4) = w; }
        }
    }
    for (int i = blockIdx.x * NTHREADS + tid; i < T_; i += gridDim.x * NTHREADS) ss1[i] = 0.f;
    {
        float* cb = (float*)(ws + OFF_CBZ);
        LAS float* red = (LAS float*)lds;
        for (int bb = blockIdx.x; bb < 128; bb += gridDim.x) {
            const int kv = bb >> 6, i0 = 64 * (bb & 63);
            const float* pos = kv ? p.pos_v : p.pos_k; const float* w1 = kv ? p.w1_v : p.w1_k;
            float a0 = 0.f, a1 = 0.f;
#pragma unroll
            for (int r = 0; r < 8; ++r) {
                const int i = i0 + 8 * wave + r;
                const float pv = pos[i];
                const float2 wv = *(const float2*)(w1 + (size_t)i * 128 + 2 * lane);
                a0 += pv * wv.x; a1 += pv * wv.y;
            }
            lds_barrier();
            red[wave * 128 + 2 * lane] = a0; red[wave * 128 + 2 * lane + 1] = a1;
            lds_barrier();
            if (tid < 128) {
                float s = 0.f;
#pragma unroll
                for (int w = 0; w < 8; ++w) s += red[w * 128 + tid];
                atomicAdd(cb + kv * 128 + tid, s);
            }
        }
    }
}

DI void ret_intra(const bf16_t* PROJ, bf16_t* OI, bf16_t* KTG, LAS unsigned char* lds) {
    const int tid = threadIdx.x, lane = tid & 63, wave = tid >> 6, r32 = lane & 31, hh = lane >> 5;
    LAS bf16_t* Qs = (LAS bf16_t*)lds;
    LAS bf16_t* Ks = (LAS bf16_t*)(lds + 67584);
    LAS bf16_t* Ss = Qs;
    LAS bf16_t* OUTs = (LAS bf16_t*)(lds + 34816);
    LAS bf16_t* VT0 = (LAS bf16_t*)(lds + 69632);
    u32x4 qk[16];
    auto loadQK = [&](int u) {
        const int b = u >> 10, h = (u >> 7) & 7, ch = u & 127;
        unsigned tq = tid; asm volatile("" : "+v"(tq));
        const bf16_t* base = PROJ + ((size_t)b * S_ + ch * 128) * LD0 + h * 256;
#pragma unroll
        for (int i = 0; i < 8; ++i) {
            const unsigned pc = tq + i * 512, off = (pc >> 5) * LD0 + (pc & 31) * 8;
            qk[2 * i] = *(const u32x4*)(base + off);
            qk[2 * i + 1] = *(const u32x4*)(base + (off + 2048));
        }
    };
    if ((int)blockIdx.x < 2048) loadQK(blockIdx.x);
    for (int u = blockIdx.x; u < 2048; u += gridDim.x) {
        const int b = u >> 10, h = (u >> 7) & 7, ch = u & 127;
        const size_t t0 = (size_t)b * S_ + ch * 128;
        const float logg = log1pf(-exp2f(-5.f - (float)h));
        {
            int tq = tid; asm volatile("" : "+v"(tq));
#pragma unroll
            for (int i = 0; i < 8; ++i) {
                const int pc = tq + i * 512, row = pc >> 5, cs = pc & 31;
                *(LAS u32x4*)(Qs + row * 264 + cs * 8) = qk[2 * i];
                *(LAS u32x4*)(Ks + row * 264 + cs * 8) = qk[2 * i + 1];
            }
        }
        const int vg = (tid & 3) + 4 * (tid >> 7), mg = (tid >> 2) & 31;
        u32x4 VA[4], VB[4];
        const bf16_t* vbase = PROJ + t0 * LD0 + 4096 + h * 512;
        auto loadV = [&](u32x4 (&R)[4], int pz) {
            unsigned mq = mg, vq = vg; asm volatile("" : "+v"(mq)); asm volatile("" : "+v"(vq));
#pragma unroll
            for (int rr = 0; rr < 4; ++rr) R[rr] = *(const u32x4*)(vbase + ((4 * mq + rr) * LD0 + pz * 128 + 8 * vq));
        };
        auto writeV = [&](const u32x4 (&R)[4], int pz) {
            LAS bf16_t* VT = VT0 + (pz & 1) * (128 * 136);
            u32x2 o[8]; tr4x8(R, o);
#pragma unroll
            for (int jj = 0; jj < 8; ++jj) *(LAS u32x2*)(VT + (8 * vg + jj) * 136 + 4 * mg) = o[jj];
        };
        loadV(VA, 0); loadV(VB, 1);
        lds_barrier();
        const int nt = wave & 3, mtb = (wave >> 2) * 2;
        f32x16 sacc[2];
#pragma unroll
        for (int mi = 0; mi < 2; ++mi) {
            const int mt = mtb + mi; sacc[mi] = zero16();
            if (mt <= nt) {
#pragma unroll
                for (int s = 0; s < 16; ++s)
                    sacc[mi] = MFMA32(ldsfrag(Ks + (mt * 32 + r32) * 264 + 16 * s + 8 * hh), ldsfrag(Qs + (nt * 32 + r32) * 264 + 16 * s + 8 * hh), sacc[mi]);
            }
        }
        {
            bf16_t* kt = KTG + (size_t)u * 32768;
#pragma unroll
            for (int i = 0; i < 2; ++i) {
                const int bi = tid + 512 * i, mgk = bi & 31, dg = bi >> 5;
                u32x4 R[4]; u32x2 o[8];
#pragma unroll
                for (int rr = 0; rr < 4; ++rr) R[rr] = *(const LAS u32x4*)(Ks + (4 * mgk + rr) * 264 + 8 * dg);
                tr4x8(R, o);
#pragma unroll
                for (int jj = 0; jj < 8; ++jj) *(u32x2*)(kt + (8 * dg + jj) * 128 + 4 * mgk) = o[jj];
            }
        }
        lds_barrier();
        const int n = nt * 32 + r32;
#pragma unroll
        for (int mi = 0; mi < 2; ++mi) {
            const int mt = mtb + mi;
#pragma unroll
            for (int G = 0; G < 4; ++G) {
                const int m0 = mt * 32 + 8 * G + 4 * hh;
                float v[4];
#pragma unroll
                for (int j = 0; j < 4; ++j) { const int df = n - (m0 + j); v[j] = df >= 0 ? sacc[mi][4 * G + j] * __expf((float)df * logg) : 0.f; }
                u32x2 w; w.x = pk2(v[0], v[1]); w.y = pk2(v[2], v[3]);
                *(LAS u32x2*)(Ss + n * 136 + m0) = w;
            }
        }
        writeV(VA, 0); loadV(VA, 2);
        if (u + (int)gridDim.x < 2048) loadQK(u + gridDim.x);
        const int vtb = (wave >> 2) * 2;
        auto piece = [&](int pz) {
            LAS bf16_t* VT = VT0 + (pz & 1) * (128 * 136);
#pragma unroll
            for (int vi = 0; vi < 2; ++vi) {
                const int vt = vtb + vi; f32x16 acc = zero16();
                for (int s = 0; s < 2 * (nt + 1); ++s)
                    acc = MFMA32(ldsfrag(VT + (vt * 32 + r32) * 136 + 16 * s + 8 * hh), ldsfrag(Ss + (nt * 32 + r32) * 136 + 16 * s + 8 * hh), acc);
#pragma unroll
                for (int G = 0; G < 4; ++G) {
                    u32x2 w; w.x = pk2(acc[4 * G], acc[4 * G + 1]); w.y = pk2(acc[4 * G + 2], acc[4 * G + 3]);
                    *(LAS u32x2*)(OUTs + n * 136 + vt * 32 + 8 * G + 4 * hh) = w;
                }
            }
        };
        auto flush = [&](int pz) {
            int tq = tid; asm volatile("" : "+v"(tq));
#pragma unroll
            for (int i = 0; i < 4; ++i) {
                const int pc = tq + 512 * i, row = pc >> 4, c16 = pc & 15;
                *(u32x4*)(OI + (t0 + row) * 4096 + h * 512 + pz * 128 + c16 * 8) = *(const LAS u32x4*)(OUTs + row * 136 + c16 * 8);
            }
        };
        lds_barrier(); writeV(VB, 1); loadV(VB, 3); piece(0); lds_barrier(); flush(0);
        lds_barrier(); writeV(VA, 2); piece(1); lds_barrier(); flush(1);
        lds_barrier(); writeV(VB, 3); piece(2); lds_barrier(); flush(2);
        lds_barrier(); piece(3); lds_barrier(); flush(3);
        lds_barrier();
    }
}

DI void ret_inter(bf16_t* PROJ, const bf16_t* OI, const bf16_t* KTG, LAS unsigned char* lds, bool dummy = false) {
    const int tid = threadIdx.x, lane = tid & 63, wave = tid >> 6, r32 = lane & 31, hh = lane >> 5;
    LAS bf16_t* KT = (LAS bf16_t*)lds;
    LAS bf16_t* VT = (LAS bf16_t*)(lds + 69632);
    LAS bf16_t* ST = (LAS bf16_t*)(lds + 69632 + 8704);
    LAS bf16_t* Qs = (LAS bf16_t*)(lds + 69632 + 8704 + 16896);
    for (int u = blockIdx.x; u < 256; u += gridDim.x) {
        const int uu = (gridDim.x == 256) ? ((((u & 7) * 2 + (u >> 7)) << 4) + ((u >> 3) & 15)) : u;
        const int b = uu >> 7, h = (uu >> 4) & 7, vs = uu & 15, v0 = vs * 32;
        const float logg = log1pf(-exp2f(-5.f - (float)h));
        const float cd = __expf(128.f * logg);
        for (int i = tid; i < 32 * 264 / 2; i += NTHREADS) ((LAS unsigned*)ST)[i] = 0u;
        const size_t tb = (size_t)b * S_;
        if (wave < 4) {
            struct QSet { u32x4 q[16]; u32x4 o[2]; };
            QSet QA, QB;
            const int n = 32 * wave + r32;
            auto loadq = [&](QSet& Q, int c) {
                unsigned tq = tid; asm volatile("" : "+v"(tq));
                const bf16_t* qb_ = PROJ + (tb + c * 128) * LD0 + h * 256;
                const bf16_t* ob_ = OI + (tb + c * 128) * 4096 + h * 512 + v0;
#pragma unroll
                for (int i = 0; i < 16; ++i) { const unsigned pc = tq + 256 * i; Q.q[i] = *(const u32x4*)(qb_ + ((pc >> 5) * LD0 + (pc & 31) * 8)); }
                const unsigned nq = 32 * (tq >> 6) + (tq & 31), hq = (tq >> 5) & 1;
#pragma unroll
                for (int e = 0; e < 2; ++e) Q.o[e] = *(const u32x4*)(ob_ + (nq * 4096 + 16 * e + 8 * hq));
            };
            const float qd = __expf((float)(n + 1) * logg);
            auto stepq = [&](int c, QSet& Q) {
                {
                    int tq = tid; asm volatile("" : "+v"(tq));
#pragma unroll
                    for (int i = 0; i < 16; ++i) { const int pc = tq + 256 * i; *(LAS u32x4*)(Qs + (pc >> 5) * 264 + (pc & 31) * 8) = Q.q[i]; }
                }
                const u32x4 o0 = Q.o[0], o1 = Q.o[1];
                if (c + 2 < 128) loadq(Q, c + 2);
                lds_barrier();
                f32x16 acc = zero16(), acc1 = zero16();
#pragma unroll
                for (int s = 0; s < 16; s += 2) {
                    acc = MFMA32(ldsfrag(ST + r32 * 264 + 16 * s + 8 * hh), ldsfrag(Qs + n * 264 + 16 * s + 8 * hh), acc);
                    acc1 = MFMA32(ldsfrag(ST + r32 * 264 + 16 * (s + 1) + 8 * hh), ldsfrag(Qs + n * 264 + 16 * (s + 1) + 8 * hh), acc1);
                }
                acc = acc + acc1;
                u32x4 w0, w1;
#pragma unroll
                for (int d = 0; d < 4; ++d) {
                    w0[d] = pk2(bflo(o0[d]) + acc[2 * d] * qd, bfhi(o0[d]) + acc[2 * d + 1] * qd);
                    w1[d] = pk2(bflo(o1[d]) + acc[8 + 2 * d] * qd, bfhi(o1[d]) + acc[8 + 2 * d + 1] * qd);
                }
                {
                    unsigned nq = n; asm volatile("" : "+v"(nq));
                    bf16_t* wb_ = PROJ + (tb + c * 128) * LD0 + 4096 + h * 512 + v0;
                    const unsigned wo = nq * LD0 + 8 * hh;
                    if (!dummy) { *(u32x4*)(wb_ + wo) = w0; *(u32x4*)(wb_ + (wo + 16)) = w1; }
                }
                lds_barrier();
            };
            loadq(QA, 0); loadq(QB, 1);
            for (int c = 0; c < 128; c += 2) { stepq(c, QA); stepq(c + 1, QB); }
        } else {
            struct KSet { u32x4 k[4][4]; u32x4 v[2]; };
            KSet KA, KB;
            const int t4 = tid - 256;
            auto loadk = [&](KSet& K, int c) {
                unsigned tq = t4; asm volatile("" : "+v"(tq));
                const bf16_t* kb_ = KTG + ((size_t)((b * 8 + h) * 128 + c)) * 32768;
                const bf16_t* vb_ = PROJ + (tb + c * 128) * LD0 + 4096 + h * 512 + v0;
#pragma unroll
                for (int i = 0; i < 16; ++i) K.k[i >> 2][i & 3] = *(const u32x4*)(kb_ + (tq + 256 * i) * 8u);
#pragma unroll
                for (int i = 0; i < 2; ++i) { const unsigned pi = tq + 256 * i; K.v[i] = *(const u32x4*)(vb_ + ((pi >> 2) * LD0 + 8 * (pi & 3))); }
            };
            f32x16 sacc[2]; sacc[0] = zero16(); sacc[1] = zero16();
            auto stepk = [&](int c, KSet& K) {
                int tw = t4; asm volatile("" : "+v"(tw));
#pragma unroll
                for (int i = 0; i < 16; ++i) { const int pc = tw + 256 * i; *(LAS u32x4*)(KT + (pc >> 4) * 136 + (pc & 15) * 8) = K.k[i >> 2][i & 3]; }
#pragma unroll
                for (int i = 0; i < 2; ++i) {
                    const int pi = tw + 256 * i, vm = pi >> 2, vgq = pi & 3;
                    const float kd = __expf((float)(127 - vm) * logg);
#pragma unroll
                    for (int d = 0; d < 4; ++d) {
                        const unsigned wv = K.v[i][d];
                        const unsigned a = pk2(bflo(wv) * kd, bfhi(wv) * kd);
                        const int vl = 8 * vgq + 2 * d, q4 = vl >> 2, pq = ((q4 & 3) == 1 || (q4 & 3) == 2) ? (q4 ^ 3) : q4, rho = (pq << 2) | (vl & 3);
                        VT[rho * 136 + vm] = (bf16_t)(a & 0xffffu);
                        VT[(rho + 1) * 136 + vm] = (bf16_t)(a >> 16);
                    }
                }
                if (c + 2 < 128) loadk(K, c + 2);
                lds_barrier();
#pragma unroll
                for (int ti = 0; ti < 2; ++ti) sacc[ti] = sacc[ti] * cd;
#pragma unroll
                for (int s = 0; s < 8; ++s)
#pragma unroll
                    for (int ti = 0; ti < 2; ++ti) {
                        const int d = (2 * (wave - 4) + ti) * 32 + r32;
                        sacc[ti] = MFMA32(ldsfrag(KT + d * 136 + 16 * s + 8 * hh), ldsfrag(VT + r32 * 136 + 16 * s + 8 * hh), sacc[ti]);
                    }
                lds_barrier();
#pragma unroll
                for (int ti = 0; ti < 2; ++ti) {
                    const int dt = 2 * (wave - 4) + ti;
#pragma unroll
                    for (int G = 0; G < 4; ++G) {
                        u32x2 w; w.x = pk2(sacc[ti][4 * G], sacc[ti][4 * G + 1]); w.y = pk2(sacc[ti][4 * G + 2], sacc[ti][4 * G + 3]);
                        *(LAS u32x2*)(ST + r32 * 264 + dt * 32 + 8 * G + 4 * hh) = w;
                    }
                }
            };
            loadk(KA, 0); loadk(KB, 1);
            for (int c = 0; c < 128; c += 2) { stepk(c, KA); stepk(c + 1, KB); }
        }
        lds_barrier();
    }
}

DI void ret_gate(bf16_t* PROJ, bf16_t* dummy = nullptr) {
    const int lane = threadIdx.x & 63, wave = threadIdx.x >> 6;
    const int nw = gridDim.x * 8, gw = blockIdx.x * 8 + wave;
    for (int task0 = gw * 8; task0 < T_ * 8; task0 += nw * 8) {
        u32x4 o8[8], g8[8];
#pragma unroll
        for (int q = 0; q < 8; ++q) {
            const int task = task0 + q; const size_t t = task >> 3; const int h = task & 7;
            o8[q] = *(const u32x4*)(PROJ + t * LD0 + 4096 + h * 512 + lane * 8);
            g8[q] = *(const u32x4*)(PROJ + t * LD0 + 8192 + h * 512 + lane * 8);
        }
#pragma unroll
        for (int q = 0; q < 8; ++q) {
            const int task = task0 + q; const size_t t = task >> 3; const int h = task & 7;
            float f[8], gt[8];
#pragma unroll
            for (int d = 0; d < 4; ++d) { f[2 * d] = bflo(o8[q][d]); f[2 * d + 1] = bfhi(o8[q][d]); gt[2 * d] = bflo(g8[q][d]); gt[2 * d + 1] = bfhi(g8[q][d]); }
            float s = 0.f;
#pragma unroll
            for (int d = 0; d < 8; ++d) s += f[d];
            const float mu = wave_sum(s) * (1.f / 512.f);
            float s2 = 0.f;
#pragma unroll
            for (int d = 0; d < 8; ++d) { f[d] -= mu; s2 += f[d] * f[d]; }
            const float rs = rsqrtf(wave_sum(s2) * (1.f / 512.f) + 1e-6f);
            u32x4 w;
#pragma unroll
            for (int d = 0; d < 4; ++d) w[d] = pk2(silu_f(gt[2 * d]) * f[2 * d] * rs, silu_f(gt[2 * d + 1]) * f[2 * d + 1] * rs);
            if (dummy) *(u32x4*)(dummy + (t & 4095) * LD0 + 8192 + h * 512 + lane * 8) = w; else *(u32x4*)(PROJ + t * LD0 + 8192 + h * 512 + lane * 8) = w;
        }
    }
}

DI void nsa_compress(const bf16_t* P1, unsigned char* ws, bf16_t* KC, bf16_t* VCT, bf16_t* VST, bf16_t* VWT, bf16_t* KS2, bf16_t* KW2, LAS unsigned char* lds) {
    const int tid = threadIdx.x, lane = tid & 63, wave = tid >> 6, r32 = lane & 31, hh = lane >> 5;
    LAS bf16_t* As = (LAS bf16_t*)lds;
    LAS bf16_t* Ws = (LAS bf16_t*)(lds + 17408);
    LAS bf16_t* Hs = (LAS bf16_t*)(lds + 17408 + 34816);
    const float* cb = (const float*)(ws + OFF_CBZ);
    for (int u = blockIdx.x; u < 256; u += gridDim.x) {
        const int kv = u >> 7, bg = (u >> 4) & 7, ct = u & 15, b = bg >> 2, g = bg & 3;
        const bf16_t* W1T = (const bf16_t*)(ws + (kv ? OFF_CW1V : OFF_CW1K));
        const bf16_t* W2T = (const bf16_t*)(ws + (kv ? OFF_CW2V : OFF_CW2K));
        const int colA = (kv ? C_VC : C_KC) + g * 128;
        const int ch = wave & 1, jt = wave >> 1;
        f32x16 acc = zero16();
        u32x4 pa[2], pw[4];
        auto ldl = [&](int l) {
            unsigned tq = tid; asm volatile("" : "+v"(tq));
#pragma unroll
            for (int i = 0; i < 2; ++i) {
                const unsigned pc = tq + 512 * i, row = pc >> 4, cs = pc & 15;
                unsigned tok = 16 * (ct * 64 + row) + l; tok = tok < (unsigned)S_ ? tok : S_ - 1;
                pa[i] = *(const u32x4*)(P1 + ((size_t)b * S_ + tok) * LD1 + colA + cs * 8);
            }
#pragma unroll
            for (int i = 0; i < 4; ++i) {
                const unsigned pc = tq + 512 * i, row = pc >> 4, cs = pc & 15;
                pw[i] = *(const u32x4*)(W1T + (row * 4096 + l * 128 + cs * 8));
            }
        };
        ldl(0);
        for (int l = 0; l < 32; ++l) {
            lds_barrier();
            {
                int tq = tid; asm volatile("" : "+v"(tq));
#pragma unroll
                for (int i = 0; i < 2; ++i) { const int pc = tq + 512 * i; *(LAS u32x4*)(As + (pc >> 4) * 136 + (pc & 15) * 8) = pa[i]; }
#pragma unroll
                for (int i = 0; i < 4; ++i) { const int pc = tq + 512 * i; *(LAS u32x4*)(Ws + (pc >> 4) * 136 + (pc & 15) * 8) = pw[i]; }
            }
            if (l + 1 < 32) ldl(l + 1);
            lds_barrier();
#pragma unroll
            for (int s = 0; s < 8; ++s)
                acc = MFMA32(ldsfrag(Ws + (jt * 32 + r32) * 136 + 16 * s + 8 * hh), ldsfrag(As + (ch * 32 + r32) * 136 + 16 * s + 8 * hh), acc);
        }
#pragma unroll
        for (int G = 0; G < 4; ++G) {
            const int j0 = jt * 32 + 8 * G + 4 * hh;
            float v[4];
#pragma unroll
            for (int j = 0; j < 4; ++j) v[j] = silu_f(acc[4 * G + j] + cb[kv * 128 + j0 + j]);
            u32x2 w; w.x = pk2(v[0], v[1]); w.y = pk2(v[2], v[3]);
            *(LAS u32x2*)(Hs + (ch * 32 + r32) * 136 + j0) = w;
        }
        lds_barrier();
#pragma unroll
        for (int i = 0; i < 4; ++i) {
            const int pc = tid + 512 * i, row = pc >> 4, cs = pc & 15;
            *(LAS u32x4*)(Ws + row * 136 + cs * 8) = *(const u32x4*)(W2T + (size_t)row * 128 + cs * 8);
        }
        lds_barrier();
        f32x16 a2 = zero16();
        if (kv == 0) {
#pragma unroll
            for (int s = 0; s < 8; ++s)
                a2 = MFMA32(ldsfrag(Ws + (jt * 32 + r32) * 136 + 16 * s + 8 * hh), ldsfrag(Hs + (ch * 32 + r32) * 136 + 16 * s + 8 * hh), a2);
            const int c = ct * 64 + ch * 32 + r32;
#pragma unroll
            for (int G = 0; G < 4; ++G) {
                u32x2 w; w.x = pk2(a2[4 * G], a2[4 * G + 1]); w.y = pk2(a2[4 * G + 2], a2[4 * G + 3]);
                *(u32x2*)(KC + ((size_t)bg * 1024 + c) * 128 + jt * 32 + 8 * G + 4 * hh) = w;
            }
            {
                float am = 0.f;
#pragma unroll
                for (int i = 0; i < 16; ++i) am = fmaxf(am, fabsf(a2[i]));
#pragma unroll
                for (int o = 32; o >= 1; o >>= 1) am = fmaxf(am, __shfl_xor(am, o));
                if (lane == 0) atomicMax((unsigned*)(ws + OFF_KINF) + bg, __float_as_uint(am * 1.01f));
            }
        } else {
#pragma unroll
            for (int s = 0; s < 8; ++s)
                a2 = MFMA32(ldsfrag(Hs + (ch * 32 + r32) * 136 + 16 * s + 8 * hh), ldsfrag(Ws + (jt * 32 + r32) * 136 + 16 * s + 8 * hh), a2);
            const int j2 = jt * 32 + r32;
#pragma unroll
            for (int G = 0; G < 4; ++G) {
                u32x2 w; w.x = pk2(a2[4 * G], a2[4 * G + 1]); w.y = pk2(a2[4 * G + 2], a2[4 * G + 3]);
                *(u32x2*)(VCT + ((size_t)(bg * 16 + ct) * 128 + j2) * 64 + ch * 32 + 8 * G + 4 * hh) = w;
            }
        }
        lds_barrier();
    }
    {
        const int half = tid >> 8, t8 = tid & 255, dgq = (t8 & 3) + 4 * (t8 >> 6), mg = (t8 >> 2) & 15;
        for (int u2 = blockIdx.x * 2 + half; u2 < 4096; u2 += gridDim.x * 2) {
            const int which = u2 >> 11, bg = (u2 >> 8) & 7, jb = u2 & 255, b = bg >> 2, g = bg & 3;
            const int col = (which ? C_VW : C_VS) + g * 128, kcol = (which ? C_KW : C_KS) + g * 128;
            bf16_t* vdst = (which ? VWT : VST) + (size_t)(bg * 256 + jb) * 8192;
            bf16_t* kdst = (which ? KW2 : KS2) + (size_t)(bg * 256 + jb) * 8192;
            const bf16_t* srow = P1 + ((size_t)b * S_ + jb * 64) * LD1;
            u32x4 R[4]; u32x2 o[8]; u32x4 kk[4];
#pragma unroll
            for (int rr = 0; rr < 4; ++rr) R[rr] = *(const u32x4*)(srow + (size_t)(4 * mg + rr) * LD1 + col + 8 * dgq);
#pragma unroll
            for (int i = 0; i < 4; ++i) { const int pc = t8 + 256 * i; kk[i] = *(const u32x4*)(srow + (size_t)(pc >> 4) * LD1 + kcol + (pc & 15) * 8); }
            tr4x8(R, o);
#pragma unroll
            for (int jj = 0; jj < 8; ++jj) *(u32x2*)(vdst + (8 * dgq + jj) * 64 + 4 * mg) = o[jj];
#pragma unroll
            for (int i = 0; i < 4; ++i) { const int pc = t8 + 256 * i; *(u32x4*)(kdst + pc * 8) = kk[i]; }
            if (which == 0) {
                float am = 0.f;
#pragma unroll
                for (int i = 0; i < 4; ++i)
#pragma unroll
                    for (int d = 0; d < 4; ++d) am = fmaxf(am, fmaxf(fabsf(bflo(kk[i][d])), fabsf(bfhi(kk[i][d]))));
#pragma unroll
                for (int o = 32; o >= 1; o >>= 1) am = fmaxf(am, __shfl_xor(am, o));
                if (lane == 0) atomicMax((unsigned*)(ws + OFF_KINF) + 8 + bg, __float_as_uint(am));
            }
        }
    }
}

DI float dpp_x1(float v) { return __int_as_float(__builtin_amdgcn_mov_dpp(__float_as_int(v), 0xB1, 0xF, 0xF, true)); }
DI float dpp_x2(float v) { return __int_as_float(__builtin_amdgcn_mov_dpp(__float_as_int(v), 0x4E, 0xF, 0xF, true)); }

DI void nsa_attn(const bf16_t* P1, const bf16_t* KC, const bf16_t* VCT, const bf16_t* VST, const bf16_t* VWT, const bf16_t* KS2, const bf16_t* KW2, const float* KINF, bf16_t* Y1, LAS unsigned char* lds) {
    const int tid = threadIdx.x, lane = tid & 63, wave = tid >> 6, r32 = lane & 31, hh = lane >> 5;
    constexpr int KB_E = 64 * 136, VP = 68, VB_E = 128 * VP;
    LAS bf16_t* Kb = (LAS bf16_t*)lds;
    LAS bf16_t* Vb = (LAS bf16_t*)(lds + 2 * KB_E * 2);
    LAS unsigned char* r1base = lds + 2 * KB_E * 2 + 2 * VB_E * 2;
    LAS float* imp = (LAS float*)r1base;
    LAS bf16_t* R1 = (LAS bf16_t*)r1base;
    LAS unsigned* selm = (LAS unsigned*)(r1base + 67584);
    LAS unsigned* uni = selm + 512;
    LAS int* jcount = (LAS int*)(uni + 8);
    LAS unsigned char* jlist = (LAS unsigned char*)(uni + 16);
    LAS int* kt0w = (LAS int*)(uni + 12);
    LAS int* jf0w = (LAS int*)(uni + 13);
    const int G_ = gridDim.x;
    for (int U = blockIdx.x; U < 2048; U += G_) {
        const int bg = U >> 8, qraw = U & 255, qidx = (gridDim.x == 256) ? ((qraw & 7) * 32 + (qraw >> 3)) : qraw, qb = (bg & 1) ? 255 - qidx : qidx, b = bg >> 2, g = bg & 3;
        const int q0 = qb * 64, tkl = r32 >> 2, r = r32 & 3, head = g * 4 + r, tl = 8 * wave + tkl, t = q0 + tl;
        const unsigned token = (unsigned)b * S_ + t;
        const float slope = 1.4426950408889634f * exp2f(-0.5f * (float)(head + 1));
        bf16x8 qf[8];
#pragma unroll
        for (int s = 0; s < 8; ++s) qf[s] = *(const bf16x8*)(P1 + token * LD1 + head * 128 + 16 * s + 8 * hh);
        float gsig[3];
#pragma unroll
        for (int br = 0; br < 3; ++br) gsig[br] = sigm_f(__uint_as_float((unsigned)P1[token * LD1 + C_G + head * 3 + br] << 16));
        if (tid < 8) uni[tid] = 0u;
        if (tid == 8) *kt0w = 1 << 20;
        if (tid == 9) *jf0w = 1 << 20;

        struct TileRegs { u32x4 k[2], v[2]; };
        TileRegs RA, RB;
        auto issue = [&](TileRegs& R, const bf16_t* ktile, const bf16_t* vtile, bool withv) {
            unsigned tq = tid; asm volatile("" : "+v"(tq));
#pragma unroll
            for (int i = 0; i < 2; ++i) R.k[i] = *(const u32x4*)(ktile + (tq + 512 * i) * 8u);
            if (withv) {
#pragma unroll
                for (int i = 0; i < 2; ++i) R.v[i] = *(const u32x4*)(vtile + (tq + 512 * i) * 8u);
            }
        };
        auto commit = [&](const TileRegs& R, int buf, bool withv) {
            int tq = tid; asm volatile("" : "+v"(tq));
#pragma unroll
            for (int i = 0; i < 2; ++i) { const int pc = tq + 512 * i; *(LAS u32x4*)(Kb + buf * KB_E + (pc >> 4) * 136 + (pc & 15) * 8) = R.k[i]; }
            if (withv) {
#pragma unroll
                for (int i = 0; i < 2; ++i) { const int pc = tq + 512 * i; LAS bf16_t* vq = Vb + buf * VB_E + (pc >> 3) * VP + (pc & 7) * 8; u32x2 lo_, hi_; lo_.x = R.v[i].x; lo_.y = R.v[i].y; hi_.x = R.v[i].z; hi_.y = R.v[i].w; *(LAS u32x2*)vq = lo_; *(LAS u32x2*)(vq + 4) = hi_; }
            }
        };
        auto compS = [&](int buf, f32x16 (&S)[2]) {
            int ro = r32 * 136 + 8 * hh; asm volatile("" : "+v"(ro));
            S[0] = zero16(); S[1] = zero16();
#pragma unroll
            for (int s = 0; s < 8; ++s) {
                S[0] = MFMA32(ldsfrag(Kb + buf * KB_E + ro + 16 * s), qf[s], S[0]);
                S[1] = MFMA32(ldsfrag(Kb + buf * KB_E + 32 * 136 + ro + 16 * s), qf[s], S[1]);
            }
        };
        auto compPV = [&](int buf, const f32x16 (&P)[2], f32x16 (&O)[4]) {
            int vo = r32 * VP + 4 * hh; asm volatile("" : "+v"(vo));
#pragma unroll
            for (int s2 = 0; s2 < 4; ++s2) {
                const int ct = s2 >> 1, sh = s2 & 1;
                u32x4 pw;
#pragma unroll
                for (int d = 0; d < 4; ++d) pw[d] = pk2(P[ct][8 * sh + 2 * d], P[ct][8 * sh + 2 * d + 1]);
                const bf16x8 pf = __builtin_bit_cast(bf16x8, pw);
#pragma unroll
                for (int dt = 0; dt < 4; ++dt) {
                    const LAS bf16_t* vp = Vb + buf * VB_E + dt * 32 * VP + vo + 16 * s2;
                    const s16x4 lo = *(const LAS s16x4*)vp, hi = *(const LAS s16x4*)(vp + 8);
                    const bf16x8 xf = __builtin_shufflevector(lo, hi, 0, 1, 2, 3, 4, 5, 6, 7);
                    O[dt] = MFMA32(xf, pf, O[dt]);
                }
            }
        };

#define KCONST(ct, i) ((float)(32 * (ct) + ((i) & 3) + 8 * ((i) >> 2)))
#define EX2(x) __builtin_amdgcn_exp2f(x)
        const int nkt = (4 * qb + 66) >> 6;
        const bf16_t* kcb = KC + (size_t)bg * 1024 * 128;
        const bf16_t* vcb = VCT + (size_t)bg * 16 * 8192;
        const float skc = 16.f * slope;
        float m1 = -1e30f, l1 = 0.f;
        int kt0;
        {
            float q1 = 0.f;
#pragma unroll
            for (int s = 0; s < 8; ++s)
#pragma unroll
                for (int e = 0; e < 8; ++e) q1 += fabsf(__uint_as_float(((unsigned)(unsigned short)qf[s][e]) << 16));
            q1 += __shfl_xor(q1, 32);
            const float reach = 15.f + (160.f + 2.f * q1 * KINF[bg]) / slope;
            const float xk = ((float)(t - 1039) - reach) * (1.f / 1024.f);
            int kf = xk > 0.f ? (int)ceilf(xk) : 0;
#pragma unroll
            for (int o = 32; o >= 1; o >>= 1) { const int ov = __shfl_xor(kf, o); kf = ov < kf ? ov : kf; }
            const float reach_s = (160.f + 2.f * q1 * KINF[8 + bg]) / slope;
            const float xj = ((float)(t - 63) - reach_s) * (1.f / 64.f);
            int jf = xj > 0.f ? (int)ceilf(xj) : 0;
#pragma unroll
            for (int o = 32; o >= 1; o >>= 1) { const int ov = __shfl_xor(jf, o); jf = ov < jf ? ov : jf; }
            lds_barrier();
            if (lane == 0) { atomicMin((int*)kt0w, kf); atomicMin((int*)jf0w, jf); }
            lds_barrier();
            kt0 = __builtin_amdgcn_readfirstlane(*kt0w);
            kt0 = kt0 < nkt - 1 ? kt0 : nkt - 1;
            for (int tk = 0; tk < 8; ++tk)
                for (int cq = lane; cq < 16 * kt0; cq += 64) imp[(wave * 8 + tk) * 257 + cq] = 0.f;
        }
        lds_barrier();
        issue(RA, kcb + (size_t)kt0 * 8192, vcb, false);
        if (kt0 + 1 < nkt) issue(RB, kcb + (size_t)(kt0 + 1) * 8192, vcb, false);
        auto step1 = [&](int kt, TileRegs& R) {
            const int buf = kt & 1;
            commit(R, buf, false);
            if (kt + 2 < nkt) issue(R, kcb + (size_t)(kt + 2) * 8192, vcb, false);
            lds_barrier();
            f32x16 S[2]; compS(buf, S);
            const bool fast = (1024 * kt + 1039 <= q0);
            float rb = -slope * (float)(t - 31 - 1024 * kt) + skc * (float)(4 * hh); asm volatile("" : "+v"(rb));
            float mt = -1e30f;
#pragma unroll
            for (int ct = 0; ct < 2; ++ct)
#pragma unroll
                for (int i = 0; i < 16; ++i) S[ct][i] = fmaf(skc, KCONST(ct, i), S[ct][i]);
            if (!fast) {
                int d0 = t - 31 - 1024 * kt - 64 * hh; asm volatile("" : "+v"(d0));
#pragma unroll
                for (int ct = 0; ct < 2; ++ct)
#pragma unroll
                    for (int i = 0; i < 16; ++i) { const int dist = d0 - 16 * (32 * ct + (i & 3) + 8 * (i >> 2)); S[ct][i] = dist >= 0 ? S[ct][i] : -1e30f; }
            }
#pragma unroll
            for (int ct = 0; ct < 2; ++ct)
#pragma unroll
                for (int i = 0; i < 16; ++i) mt = fmaxf(mt, S[ct][i]);
            mt += rb;
            const float mn = fmaxf(m1, mt), off = mn - rb;
            float ls = 0.f;
            if (fast) {
#pragma unroll
                for (int ct = 0; ct < 2; ++ct)
#pragma unroll
                    for (int i = 0; i < 16; ++i) ls += EX2(S[ct][i] - off);
            } else {
#pragma unroll
                for (int ct = 0; ct < 2; ++ct)
#pragma unroll
                    for (int i = 0; i < 16; ++i) ls += S[ct][i] > -1e29f ? EX2(S[ct][i] - off) : 0.f;
            }
            l1 = l1 * EX2(m1 - mn) + ls; m1 = mn;
        };
        for (int kt = kt0; kt < nkt; kt += 2) { step1(kt, RA); if (kt + 1 < nkt) step1(kt + 1, RB); }
        float Mx, lgi;
        {
            const float mo = __shfl_xor(m1, 32), lo = __shfl_xor(l1, 32);
            Mx = fmaxf(m1, mo);
            const float L = l1 * EX2(m1 - Mx) + lo * EX2(mo - Mx);
            lgi = L > 0.f ? -__log2f(L) : -1e30f;
        }
        f32x16 O[4];
#pragma unroll
        for (int dt = 0; dt < 4; ++dt) O[dt] = zero16();
        float carry = 0.f;
        LAS float* impw = imp + (wave * 8 + tkl) * 257;
        lds_barrier();
        issue(RA, kcb + (size_t)kt0 * 8192, vcb + (size_t)kt0 * 8192, true);
        if (kt0 + 1 < nkt) issue(RB, kcb + (size_t)(kt0 + 1) * 8192, vcb + (size_t)(kt0 + 1) * 8192, true);
        auto step2 = [&](int kt, TileRegs& R) {
            const int buf = kt & 1;
            commit(R, buf, true);
            if (kt + 2 < nkt) issue(R, kcb + (size_t)(kt + 2) * 8192, vcb + (size_t)(kt + 2) * 8192, true);
            lds_barrier();
            f32x16 S[2]; compS(buf, S);
            const bool fast = (1024 * kt + 1039 <= q0);
            float rb = -slope * (float)(t - 31 - 1024 * kt) + skc * (float)(4 * hh); asm volatile("" : "+v"(rb));
            const float off = (Mx - rb) - lgi;
            if (fast) {
#pragma unroll
                for (int ct = 0; ct < 2; ++ct)
#pragma unroll
                    for (int i = 0; i < 16; ++i) S[ct][i] = EX2(fmaf(skc, KCONST(ct, i), S[ct][i]) - off);
            } else {
                int d0 = t - 31 - 1024 * kt - 64 * hh; asm volatile("" : "+v"(d0));
#pragma unroll
                for (int ct = 0; ct < 2; ++ct)
#pragma unroll
                    for (int i = 0; i < 16; ++i) {
                        const int dist = d0 - 16 * (32 * ct + (i & 3) + 8 * (i >> 2));
                        S[ct][i] = dist >= 0 ? EX2(fmaf(skc, KCONST(ct, i), S[ct][i]) - off) : 0.f;
                    }
            }
            float X[2][4];
#pragma unroll
            for (int ct = 0; ct < 2; ++ct)
#pragma unroll
                for (int G = 0; G < 4; ++G) X[ct][G] = __shfl_xor(S[ct][4 * G + 3], 32);
#pragma unroll
            for (int ct = 0; ct < 2; ++ct)
#pragma unroll
                for (int G = 0; G < 4; ++G) {
                    const float prev0 = G > 0 ? X[ct][G - 1] : (ct > 0 ? X[0][3] : carry);
                    const float prev = hh ? X[ct][G] : prev0;
                    float tot = S[ct][4 * G] + S[ct][4 * G + 1] + S[ct][4 * G + 2] + S[ct][4 * G + 3] + prev;
                    tot += dpp_x1(tot); tot += dpp_x2(tot);
                    const int cq = 16 * kt + 8 * ct + 2 * G + hh;
                    if (r == 0) impw[cq] = tot;
                }
            carry = X[1][3];
            compPV(buf, S, O);
        };
        for (int kt = kt0; kt < nkt; kt += 2) { step2(kt, RA); if (kt + 1 < nkt) step2(kt + 1, RB); }
        {
            const int cur = qb, nsel = cur + 1 < 16 ? cur + 1 : 16;
#pragma unroll 1
            for (int tk = 0; tk < 8; ++tk) {
                const LAS float* iw = imp + (wave * 8 + tk) * 257;
                unsigned key[4];
#pragma unroll
                for (int uu = 0; uu < 4; ++uu) {
                    const int j = lane + 64 * uu;
                    const bool forced = (j == 0 || j == cur || j == cur - 1);
                    const unsigned bits = forced ? 0x461C4000u   : __float_as_uint(iw[j < 256 ? j : 255]);
                    key[uu] = j <= cur ? ((bits & 0xFFFFFF00u) | (unsigned)(255 - j)) : 0u;
                }
                unsigned thr = 0u;
#pragma unroll 1
                for (int bit = 30; bit >= 0; --bit) {
                    const unsigned cand = thr | (1u << bit);
                    const int cnt = __popcll(__ballot(key[0] >= cand)) + __popcll(__ballot(key[1] >= cand)) + __popcll(__ballot(key[2] >= cand)) + __popcll(__ballot(key[3] >= cand));
                    thr = cnt >= nsel ? cand : thr;
                }
                unsigned word = 0u;
#pragma unroll
                for (int uu = 0; uu < 4; ++uu) {
                    const unsigned long long m = __ballot(key[uu] >= thr);
                    if (lane == 2 * uu) word = (unsigned)m;
                    if (lane == 2 * uu + 1) word = (unsigned)(m >> 32);
                }
                if (lane < 8) { selm[(wave * 8 + tk) * 8 + lane] = word; if (word) atomicOr((unsigned*)(uni + lane), word); }
            }
        }
        lds_barrier();
        {
            LAS bf16_t* rp = R1 + (wave * 32 + r32) * 132;
#pragma unroll
            for (int dt = 0; dt < 4; ++dt)
#pragma unroll
                for (int G = 0; G < 4; ++G) {
                    u32x2 w; w.x = pk2(O[dt][4 * G] * gsig[0], O[dt][4 * G + 1] * gsig[0]); w.y = pk2(O[dt][4 * G + 2] * gsig[0], O[dt][4 * G + 3] * gsig[0]);
                    *(LAS u32x2*)(rp + dt * 32 + 8 * G + 4 * hh) = w;
                }
            if (wave == 0) {
                const int jf0 = *jf0w;
                int n = 0;
#pragma unroll
                for (int u4 = 3; u4 >= 0; --u4) {
                    const int j = lane + 64 * u4;
                    const bool sel = ((uni[2 * u4 + (lane >> 5)] >> (lane & 31)) & 1u) && j >= jf0;
                    const unsigned long long m = __ballot(sel);
                    const unsigned long long above = lane == 63 ? 0ull : (m >> (lane + 1));
                    if (sel) jlist[n + __popcll(above)] = (unsigned char)j;
                    n += __popcll(m);
                }
                if (lane == 0) *jcount = n;
            }
        }
        lds_barrier();
        float mr, lr;
        auto flash_tile = [&](int buf, int kbase, bool rowsel, int wlim, bool fast) {
            f32x16 S[2]; compS(buf, S);
            float rb = -slope * (float)(t - kbase) + slope * (float)(4 * hh); asm volatile("" : "+v"(rb));
#pragma unroll
            for (int ct = 0; ct < 2; ++ct)
#pragma unroll
                for (int i = 0; i < 16; ++i) S[ct][i] = fmaf(slope, KCONST(ct, i), S[ct][i]);
            if (!fast) {
                int d0 = t - kbase - 4 * hh; asm volatile("" : "+v"(d0));
#pragma unroll
                for (int ct = 0; ct < 2; ++ct)
#pragma unroll
                    for (int i = 0; i < 16; ++i) {
                        const int dist = d0 - (32 * ct + (i & 3) + 8 * (i >> 2));
                        S[ct][i] = (rowsel && dist >= 0 && dist < wlim) ? S[ct][i] : -1e30f;
                    }
            }
            float mt = -1e30f;
#pragma unroll
            for (int ct = 0; ct < 2; ++ct)
#pragma unroll
                for (int i = 0; i < 16; ++i) mt = fmaxf(mt, S[ct][i]);
            mt += rb;
            mt = fmaxf(mt, __shfl_xor(mt, 32));
            const float mn = fmaxf(mr, mt);
            if (__any(mn > mr)) {
                const float alpha = EX2(mr - mn);
                lr *= alpha;
#pragma unroll
                for (int dt = 0; dt < 4; ++dt) O[dt] = O[dt] * alpha;
            }
            mr = mn;
            const float off = mn - rb;
            float ls = 0.f;
#pragma unroll
            for (int ct = 0; ct < 2; ++ct)
#pragma unroll
                for (int i = 0; i < 16; ++i) { const float pe = EX2(S[ct][i] - off); S[ct][i] = pe; ls += pe; }
            lr += ls;
            compPV(buf, S, O);
        };
        {
            const int nj = __builtin_amdgcn_readfirstlane(*jcount);
            mr = -1e30f; lr = 0.f;
#pragma unroll
            for (int dt = 0; dt < 4; ++dt) O[dt] = zero16();
            const bf16_t* ksb = KS2 + (size_t)bg * 256 * 8192;
            const bf16_t* vsb = VST + (size_t)bg * 256 * 8192;
            auto jat = [&](int i) { return __builtin_amdgcn_readfirstlane((int)jlist[i]); };
            { const int j = jat(0); issue(RA, ksb + (size_t)j * 8192, vsb + (size_t)j * 8192, true); }
            if (nj > 1) { const int j = jat(1); issue(RB, ksb + (size_t)j * 8192, vsb + (size_t)j * 8192, true); }
            auto step3 = [&](int i, TileRegs& R) {
                const int buf = i & 1, j = jat(i);
                commit(R, buf, true);
                if (i + 2 < nj) { const int jn = jat(i + 2); issue(R, ksb + (size_t)jn * 8192, vsb + (size_t)jn * 8192, true); }
                lds_barrier();
                const bool rowsel = (selm[tl * 8 + (j >> 5)] >> (j & 31)) & 1u;
                if (__any(rowsel)) flash_tile(buf, 64 * j, rowsel, 1 << 30, j < qb && __all(rowsel));
            };
            for (int i = 0; i < nj; i += 2) { step3(i, RA); if (i + 1 < nj) step3(i + 1, RB); }
            const float lt = lr + __shfl_xor(lr, 32), inv = gsig[1] / lt;
            LAS bf16_t* rp = R1 + (wave * 32 + r32) * 132;
#pragma unroll
            for (int dt = 0; dt < 4; ++dt)
#pragma unroll
                for (int G = 0; G < 4; ++G) {
                    LAS u32x2* q = (LAS u32x2*)(rp + dt * 32 + 8 * G + 4 * hh);
                    const u32x2 old = *q; u32x2 w;
                    w.x = pk2(bflo(old.x) + O[dt][4 * G] * inv, bfhi(old.x) + O[dt][4 * G + 1] * inv);
                    w.y = pk2(bflo(old.y) + O[dt][4 * G + 2] * inv, bfhi(old.y) + O[dt][4 * G + 3] * inv);
                    *q = w;
                }
        }
        {
            mr = -1e30f; lr = 0.f;
#pragma unroll
            for (int dt = 0; dt < 4; ++dt) O[dt] = zero16();
            const bf16_t* kwb = KW2 + (size_t)bg * 256 * 8192;
            const bf16_t* vwb = VWT + (size_t)bg * 256 * 8192;
            const int j0 = qb - 8 > 0 ? qb - 8 : 0, nj = qb - j0 + 1;
            lds_barrier();
            issue(RA, kwb + (size_t)qb * 8192, vwb + (size_t)qb * 8192, true);
            if (nj > 1) issue(RB, kwb + (size_t)(qb - 1) * 8192, vwb + (size_t)(qb - 1) * 8192, true);
            auto step4 = [&](int i, TileRegs& R) {
                const int buf = i & 1, j = qb - i;
                commit(R, buf, true);
                if (i + 2 < nj) issue(R, kwb + (size_t)(j - 2) * 8192, vwb + (size_t)(j - 2) * 8192, true);
                lds_barrier();
                flash_tile(buf, 64 * j, true, 512, j < qb && j > qb - 8);
            };
            for (int i = 0; i < nj; i += 2) { step4(i, RA); if (i + 1 < nj) step4(i + 1, RB); }
            const float lt = lr + __shfl_xor(lr, 32), inv = gsig[2] / lt;
            const LAS bf16_t* rp = R1 + (wave * 32 + r32) * 132;
#pragma unroll
            for (int dt = 0; dt < 4; ++dt)
#pragma unroll
                for (int G = 0; G < 4; ++G) {
                    const int d0 = dt * 32 + 8 * G + 4 * hh;
                    const u32x2 old = *(const LAS u32x2*)(rp + d0);
                    const u32x2 zz = *(const u32x2*)(P1 + token * LD1 + C_Z + head * 128 + d0);
                    u32x2 w;
                    w.x = pk2(silu_f(bflo(zz.x)) * (bflo(old.x) + O[dt][4 * G] * inv), silu_f(bfhi(zz.x)) * (bfhi(old.x) + O[dt][4 * G + 1] * inv));
                    w.y = pk2(silu_f(bflo(zz.y)) * (bflo(old.y) + O[dt][4 * G + 2] * inv), silu_f(bfhi(zz.y)) * (bfhi(old.y) + O[dt][4 * G + 3] * inv));
                    *(u32x2*)(Y1 + token * DM + head * 128 + d0) = w;
                }
        }
        lds_barrier();
    }
}

DI void final_norm(float* out, const float* fg) {
    const int lane = threadIdx.x & 63, wave = threadIdx.x >> 6;
    const int nw = gridDim.x * 8, gw = blockIdx.x * 8 + wave;
    for (int row0 = gw * 2; row0 < T_; row0 += nw * 2) {
        f32x4 v[2][8]; float ss[2] = {0.f, 0.f};
#pragma unroll
        for (int q = 0; q < 2; ++q) {
            const f32x4* xr = (const f32x4*)(out + (size_t)(row0 + q) * DM);
#pragma unroll
            for (int i = 0; i < 8; ++i) v[q][i] = xr[lane + 64 * i];
        }
#pragma unroll
        for (int q = 0; q < 2; ++q)
#pragma unroll
            for (int i = 0; i < 8; ++i) ss[q] += v[q][i][0] * v[q][i][0] + v[q][i][1] * v[q][i][1] + v[q][i][2] * v[q][i][2] + v[q][i][3] * v[q][i][3];
        ss[0] = wave_sum(ss[0]); ss[1] = wave_sum(ss[1]);
#pragma unroll
        for (int q = 0; q < 2; ++q) {
            const float rs = rsqrtf(ss[q] * (1.f / 2048.f) + 1e-6f);
            f32x4* xr = (f32x4*)(out + (size_t)(row0 + q) * DM);
#pragma unroll
            for (int i = 0; i < 8; ++i) { const f32x4 gq = ((const f32x4*)fg)[lane + 64 * i]; xr[lane + 64 * i] = v[q][i] * rs * gq; }
        }
    }
}

#define XB_TMO      128
#define XB_XCNT(j)  (256  + 64 * (j))
#define XB_XSUB(j)  (1280 + 64 * (j))
#define XB_XGEN(j)  (2304 + 64 * (j))
#define XB_TOP      3328
#define XB_TOPGEN   3392
#define XCD_BAR_WORDS 3456
#define XB_SPIN_CAP (1u << 20)
DI unsigned xb_ld(unsigned* p) { return __hip_atomic_load(p, __ATOMIC_RELAXED, __HIP_MEMORY_SCOPE_AGENT); }
DI unsigned xb_add(unsigned* p, unsigned v) { return __hip_atomic_fetch_add(p, v, __ATOMIC_RELAXED, __HIP_MEMORY_SCOPE_AGENT); }
DI unsigned xb_xcc_id() { return (unsigned)__builtin_amdgcn_s_getreg((3 << 11) | 20) & 0xFu; }
#define XB_SPIN(cond, bar) do { unsigned _sp = 0; while (cond) { __builtin_amdgcn_s_sleep(1); \
    if ((++_sp & 255u) == 0u) { if (xb_ld(&(bar)[XB_TMO])) break; if (_sp > XB_SPIN_CAP) { atomicAdd(&(bar)[XB_TMO], 1u); break; } } } } while (0)
struct XcdBarrier { unsigned* bar; unsigned x; volatile LAS unsigned* st; };
DI XcdBarrier xcd_barrier_post(unsigned* bar, volatile LAS unsigned* st) {
    XcdBarrier b; b.bar = bar; b.x = xb_xcc_id(); b.st = st;
    if (threadIdx.x == 0) (void)xb_add(&bar[XB_XCNT(b.x)], 1u);
    return b;
}
DI void xcd_barrier_complete(unsigned* bar, unsigned x, unsigned& nloc, unsigned& nx) {
    const unsigned G = gridDim.x * gridDim.y * gridDim.z;
    unsigned sum, cnt, mine, sp = 0u;
    for (;;) {
        sum = 0u; cnt = 0u; mine = 0u;
#pragma unroll
        for (unsigned j = 0; j < 16; ++j) { const unsigned c = xb_ld(&bar[XB_XCNT(j)]); sum += c; cnt += (c > 0u) ? 1u : 0u; mine = (j == x) ? c : mine; }
        if (sum == G) break;
        __builtin_amdgcn_s_sleep(1);
        if ((++sp & 255u) == 0u) { if (xb_ld(&bar[XB_TMO])) break; if (sp > XB_SPIN_CAP) { atomicAdd(&bar[XB_TMO], 1u); break; } }
    }
    nloc = mine > 0u ? mine : 1u; nx = cnt > 0u ? cnt : 1u;
}
DI void xcd_barrier(const XcdBarrier& b) {
    asm volatile("s_waitcnt vmcnt(0)" ::: "memory");
    __syncthreads();
    if (threadIdx.x == 0) {
        unsigned* bar = b.bar;
        __builtin_amdgcn_s_waitcnt(0);
        unsigned nloc = b.st[0], nx = b.st[1];
        if (nloc == 0u) { xcd_barrier_complete(bar, b.x, nloc, nx); b.st[0] = nloc; b.st[1] = nx; }
        const unsigned old = xb_add(&bar[XB_XSUB(b.x)], 1u);
        const unsigned gen = old / nloc;
        if (old + 1u == (gen + 1u) * nloc) {
            __builtin_amdgcn_fence(__ATOMIC_RELEASE, "agent");
            asm volatile("s_waitcnt vmcnt(0)" ::: "memory");
            const unsigned og = xb_add(&bar[XB_TOP], 1u);
            const unsigned tg = og / nx;
            if (og + 1u == (tg + 1u) * nx) xb_add(&bar[XB_TOPGEN], 1u);
            else XB_SPIN(xb_ld(&bar[XB_TOPGEN]) == tg, bar);
            __builtin_amdgcn_fence(__ATOMIC_ACQUIRE, "agent");
            xb_add(&bar[XB_XGEN(b.x)], 1u);
            asm volatile("s_waitcnt vmcnt(0)" ::: "memory");
        } else {
            XB_SPIN(xb_ld(&bar[XB_XGEN(b.x)]) == gen, bar);
            __builtin_amdgcn_fence(__ATOMIC_ACQUIRE, "agent");
            asm volatile("s_waitcnt vmcnt(0)" ::: "memory");
        }
    }
    __syncthreads();
}

constexpr int NPHASE = 11;
__global__ void __launch_bounds__(NTHREADS, 2) fwd_kernel(Params p) {
    extern __shared__ __attribute__((aligned(16))) unsigned char lds_raw[];
    LAS unsigned char* lds = (LAS unsigned char*)lds_raw;
    unsigned char* ws = p.ws;
    bf16_t* PROJ = (bf16_t*)(ws + OFF_PROJ);
    bf16_t* XB = (bf16_t*)(ws + OFF_XB);
    const int lo = p.ph_lo, hi = p.ph_hi;
#ifndef PHMASK
#define PHMASK 0x7ff
#endif
#define IN(k) (((PHMASK >> (k)) & 1) && lo <= (k) && (k) < hi)
    volatile LAS unsigned* xst = (volatile LAS unsigned*)(lds + LDS_BYTES - 16);
    XcdBarrier xbar; xbar.bar = (unsigned*)(ws + OFF_BAR); xbar.x = 0; xbar.st = xst;
    if (hi - lo > 1) {
        if (threadIdx.x < 2) xst[threadIdx.x] = 0u;
        __syncthreads();
        xbar = xcd_barrier_post((unsigned*)(ws + OFF_BAR), xst);
    }
#define SEAM(k) do { if ((k) + 1 < hi) { if ((k) == 0) cg::this_grid().sync(); else xcd_barrier(xbar); } } while (0)
#ifndef REPMASK
#define REPMASK 0
#endif
#define REP(k) ((REPMASK >> (k)) & 1)
#define GS() cg::this_grid().sync()
    if (IN(0)) { if (REP(0)) { phase0(p, lds); GS(); } phase0(p, lds); SEAM(0); }
    if (IN(1)) {
        pg8::Gemm g{XB, (const bf16_t*)(ws + OFF_W1T), 2048, 2048, T_, 12288, 2048}; pg8::StaticOrder S; S.init(T_, 12288, gridDim.x, blockIdx.x);
        pg8::EpiScaleBf16<2> E{PROJ, LD0, nullptr};
        if (REP(1)) { pg8::gemm_phase(lds, g, S, E); GS(); }
        pg8::gemm_phase(lds, g, S, E); SEAM(1);
    }
    if (IN(2)) { if (REP(2)) { ret_intra(PROJ, (bf16_t*)p.out, XB, lds); GS(); } ret_intra(PROJ, (bf16_t*)p.out, XB, lds); SEAM(2); }
    if (IN(3)) { for (int rep = REP(3) ? 0 : 1; rep < 2; ++rep) { ret_inter(PROJ, (const bf16_t*)p.out, XB, lds, rep == 0); if (rep == 0) GS(); } SEAM(3); }
    if (IN(4)) { if (REP(4)) { ret_gate(PROJ, XB); GS(); } ret_gate(PROJ); SEAM(4); }
    if (IN(5)) {
        pg8::Gemm g{PROJ + 8192, (const bf16_t*)(ws + OFF_W2T), LD0, 4096, T_, 2048, 4096}; pg8::StaticOrder S; S.init(T_, 2048, gridDim.x, blockIdx.x);
        if (REP(5)) { pg8::EpiResid E0{p.x, p.out, XB, nullptr}; pg8::gemm_phase(lds, g, S, E0); GS(); }
        pg8::EpiResid E{p.x, p.out, XB, (float*)(ws + OFF_SS1)};
        pg8::gemm_phase(lds, g, S, E); SEAM(5);
    }
    if (IN(6)) {
        pg8::Gemm g{XB, (const bf16_t*)(ws + OFF_W3T), 2048, 2048, T_, LD1, 2048}; pg8::StaticOrder S; S.init(T_, LD1, gridDim.x, blockIdx.x);
        pg8::EpiScaleBf16<1> E{PROJ, LD1, (const float*)(ws + OFF_SS1)};
        if (REP(6)) { pg8::gemm_phase(lds, g, S, E); GS(); }
        pg8::gemm_phase(lds, g, S, E); SEAM(6);
    }
    if (IN(7)) {
        if (REP(7)) { nsa_compress(PROJ, ws, (bf16_t*)(ws + OFF_KC), (bf16_t*)(ws + OFF_VCT), (bf16_t*)(ws + OFF_VST), (bf16_t*)(ws + OFF_VWT), (bf16_t*)(ws + OFF_KS2), (bf16_t*)(ws + OFF_KW2), lds); GS(); }
        nsa_compress(PROJ, ws, (bf16_t*)(ws + OFF_KC), (bf16_t*)(ws + OFF_VCT), (bf16_t*)(ws + OFF_VST), (bf16_t*)(ws + OFF_VWT), (bf16_t*)(ws + OFF_KS2), (bf16_t*)(ws + OFF_KW2), lds); SEAM(7); }
    if (IN(8)) {
        if (REP(8)) { nsa_attn(PROJ, (const bf16_t*)(ws + OFF_KC), (const bf16_t*)(ws + OFF_VCT), (const bf16_t*)(ws + OFF_VST), (const bf16_t*)(ws + OFF_VWT), (const bf16_t*)(ws + OFF_KS2), (const bf16_t*)(ws + OFF_KW2), (const float*)(ws + OFF_KINF), XB, lds); GS(); }
        nsa_attn(PROJ, (const bf16_t*)(ws + OFF_KC), (const bf16_t*)(ws + OFF_VCT), (const bf16_t*)(ws + OFF_VST), (const bf16_t*)(ws + OFF_VWT), (const bf16_t*)(ws + OFF_KS2), (const bf16_t*)(ws + OFF_KW2), (const float*)(ws + OFF_KINF), XB, lds); SEAM(8); }
    if (IN(9)) {
        pg8::Gemm g{XB, (const bf16_t*)(ws + OFF_W4T), 2048, 2048, T_, 2048, 2048}; pg8::StaticOrder S; S.init(T_, 2048, gridDim.x, blockIdx.x);
        if (REP(9)) { pg8::EpiResid E0{p.out, (float*)PROJ, nullptr, nullptr}; pg8::gemm_phase(lds, g, S, E0); GS(); }
        pg8::EpiResid E{p.out, p.out, nullptr, nullptr};
        pg8::gemm_phase(lds, g, S, E); SEAM(9);
    }
    if (IN(10)) { final_norm(p.out, p.final_g); }
#undef IN
#undef SEAM
}

extern "C" void kernel_launch(void* const* d_in, const int* in_sizes, int n_in, void* d_out, int out_size, void* d_ws, size_t ws_size, hipStream_t stream) {
    static int grid = 0;
    if (grid == 0) {
        if (n_in != 13 || out_size != T_ * DM || ws_size < WS_END) { fprintf(stderr, "kernel_launch: unexpected shapes (n_in %d out %d ws %zu need %zu)\n", n_in, out_size, ws_size, (size_t)WS_END); grid = -1; return; }
        int dev = 0, cus = 0, per_cu = 0;
        hipGetDevice(&dev); hipDeviceGetAttribute(&cus, hipDeviceAttributeMultiprocessorCount, dev);
        if (hipFuncSetAttribute((const void*)fwd_kernel, hipFuncAttributeMaxDynamicSharedMemorySize, LDS_BYTES) != hipSuccess) { fprintf(stderr, "kernel_launch: hipFuncSetAttribute failed\n"); grid = -1; return; }
        hipOccupancyMaxActiveBlocksPerMultiprocessor(&per_cu, (const void*)fwd_kernel, NTHREADS, LDS_BYTES);
        (void)hipGetLastError();
        if (per_cu < 1) per_cu = 1;
        grid = cus * 1;
    }
    if (grid < 0) return;
    Params p{};
    p.x = (const float*)d_in[0]; p.norm_g = (const float*)d_in[1]; p.ret_w_in = (const float*)d_in[2]; p.ret_w_out = (const float*)d_in[3];
    p.nsa_w_in = (const float*)d_in[4]; p.pos_k = (const float*)d_in[5]; p.w1_k = (const float*)d_in[6]; p.w2_k = (const float*)d_in[7];
    p.pos_v = (const float*)d_in[8]; p.w1_v = (const float*)d_in[9]; p.w2_v = (const float*)d_in[10]; p.nsa_w_out = (const float*)d_in[11];
    p.final_g = (const float*)d_in[12]; p.out = (float*)d_out; p.ws = (unsigned char*)d_ws;
#if SINGLE_LAUNCH
    hipMemsetAsync((char*)d_ws + OFF_BAR, 0, 16384, stream);
    p.ph_lo = 0; p.ph_hi = NPHASE;
    void* args[] = {&p};
    hipError_t e = hipLaunchCooperativeKernel((const void*)fwd_kernel, dim3(grid), dim3(NTHREADS), args, LDS_BYTES, stream);
    if (e != hipSuccess) fprintf(stderr, "cooperative launch failed: %s (grid %d)\n", hipGetErrorString(e), grid);
#else
    for (int k = 0; k < NPHASE; ++k) {
        p.ph_lo = k; p.ph_hi = k + 1;
        hipLaunchKernelGGL(fwd_kernel, dim3(grid), dim3(NTHREADS), LDS_BYTES, stream, p);
    }
#endif
}
```

```cpp
#include <hip/hip_runtime.h>
#include <hip/hip_cooperative_groups.h>
#include <cstdio>
namespace cg = cooperative_groups;

#ifndef SINGLE_LAUNCH
#define SINGLE_LAUNCH 1
#endif

#define DI __device__ __forceinline__
#define LAS __attribute__((address_space(3)))
typedef unsigned short bf16_t;
typedef short bf16x8 __attribute__((ext_vector_type(8)));
typedef short s16x4 __attribute__((ext_vector_type(4)));
typedef float f32x4 __attribute__((ext_vector_type(4)));
typedef float f32x16 __attribute__((ext_vector_type(16)));
typedef unsigned u32x4 __attribute__((ext_vector_type(4)));
typedef unsigned u32x2 __attribute__((ext_vector_type(2)));
typedef __bf16 bf2_t __attribute__((ext_vector_type(2)));

constexpr int T_ = 32768, S_ = 16384, DM = 2048;
constexpr int LD0 = 12288;
constexpr int LD1 = 7424;
constexpr int C_KC = 2048, C_VC = 2560, C_KS = 3072, C_VS = 3584, C_KW = 4096, C_VW = 4608, C_Z = 5120, C_G = 7168;
constexpr int NTHREADS = 512;
constexpr int LDS_BYTES = 160 * 1024;

constexpr size_t OFF_W1T = 0;
constexpr size_t OFF_W2T = OFF_W1T + (size_t)12288 * 2048 * 2;
constexpr size_t OFF_W3T = OFF_W2T + (size_t)2048 * 4096 * 2;
constexpr size_t OFF_W4T = OFF_W3T + (size_t)LD1 * 2048 * 2;
constexpr size_t OFF_CW1K = OFF_W4T + (size_t)2048 * 2048 * 2;
constexpr size_t OFF_CW1V = OFF_CW1K + (size_t)128 * 4096 * 2;
constexpr size_t OFF_CW2K = OFF_CW1V + (size_t)128 * 4096 * 2;
constexpr size_t OFF_CW2V = OFF_CW2K + (size_t)128 * 128 * 2;
constexpr size_t OFF_CB = OFF_CW2V + (size_t)128 * 128 * 2;
constexpr size_t OFF_RSTD0 = OFF_CB + 1024;
constexpr size_t OFF_SS1 = OFF_RSTD0 + (size_t)T_ * 4;
constexpr size_t OFF_KC = OFF_SS1 + (size_t)T_ * 4;
constexpr size_t OFF_VCT = OFF_KC + (size_t)8 * 1024 * 128 * 2;
constexpr size_t OFF_XB = OFF_VCT + (size_t)8 * 1024 * 128 * 2;
constexpr size_t OFF_PROJ = OFF_XB + (size_t)T_ * 2048 * 2;
constexpr size_t OFF_VST = OFF_PROJ + (size_t)T_ * LD1 * 2;
constexpr size_t OFF_VWT = OFF_VST + (size_t)8 * 128 * S_ * 2;
constexpr size_t OFF_KS2 = OFF_VWT + (size_t)8 * 128 * S_ * 2;
constexpr size_t OFF_KW2 = OFF_KS2 + (size_t)8 * 128 * S_ * 2;
constexpr size_t OFF_BAR = OFF_PROJ + (size_t)T_ * LD0 * 2;
constexpr size_t OFF_CBZ = OFF_BAR + 14336;
constexpr size_t OFF_KINF = OFF_BAR + 15360;
constexpr size_t WS_END = OFF_BAR + 16384;
static_assert(OFF_KW2 + (size_t)8 * 128 * S_ * 2 <= WS_END, "ws map");

struct Params {
    const float* x; const float* norm_g; const float* ret_w_in; const float* ret_w_out; const float* nsa_w_in;
    const float* pos_k; const float* w1_k; const float* w2_k; const float* pos_v; const float* w1_v; const float* w2_v;
    const float* nsa_w_out; const float* final_g; float* out; unsigned char* ws; int ph_lo, ph_hi;
};

DI unsigned pk2(float lo, float hi) { bf2_t v; v.x = (__bf16)lo; v.y = (__bf16)hi; return __builtin_bit_cast(unsigned, v); }
DI float bflo(unsigned u) { return __uint_as_float(u << 16); }
DI float bfhi(unsigned u) { return __uint_as_float(u & 0xffff0000u); }
#define DPPF(v, ctrl) __int_as_float(__builtin_amdgcn_mov_dpp(__float_as_int(v), (ctrl), 0xF, 0xF, true))
DI float wave_sum(float v) {
    v += DPPF(v, 0xB1);
    v += DPPF(v, 0x4E);
    v += DPPF(v, 0x141);
    v += DPPF(v, 0x140);
    return (__int_as_float(__builtin_amdgcn_readlane(__float_as_int(v), 0)) + __int_as_float(__builtin_amdgcn_readlane(__float_as_int(v), 16))) +
           (__int_as_float(__builtin_amdgcn_readlane(__float_as_int(v), 32)) + __int_as_float(__builtin_amdgcn_readlane(__float_as_int(v), 48)));
}
DI void lds_barrier() { asm volatile("s_waitcnt lgkmcnt(0)\n\ts_barrier" ::: "memory"); }
DI float silu_f(float x) { return x / (1.f + __expf(-x)); }
DI float sigm_f(float x) { return 1.f / (1.f + __expf(-x)); }
DI int crow(int i, int hh) { return (i & 3) + 8 * (i >> 2) + 4 * hh; }
#define MFMA32(a, b, c) __builtin_amdgcn_mfma_f32_32x32x16_bf16((a), (b), (c), 0, 0, 0)
DI f32x16 zero16() { f32x16 z; for (int i = 0; i < 16; ++i) z[i] = 0.f; return z; }
DI bf16x8 ldsfrag(const LAS bf16_t* p) { return *(const LAS bf16x8*)p; }
DI void tr4x8(const u32x4 (&R)[4], u32x2 (&o)[8]) {
#pragma unroll
    for (int d = 0; d < 4; ++d) {
        const unsigned a0 = R[0][d], a1 = R[1][d], a2 = R[2][d], a3 = R[3][d];
        o[2 * d][0] = (a0 & 0xffffu) | (a1 << 16); o[2 * d][1] = (a2 & 0xffffu) | (a3 << 16);
        o[2 * d + 1][0] = (a0 >> 16) | (a1 & 0xffff0000u); o[2 * d + 1][1] = (a2 >> 16) | (a3 & 0xffff0000u);
    }
}

namespace pg8 {
constexpr int BM = 256, BK = 64, HALF = 128, HTB = HALF * BK * 2, STAGE_BYTES = 8 * HTB, NXCD = 8, WGM = 8;
DI int lds_byte(int r, int c) { const int st = (r >> 4) * 2 + (c >> 5), rr = r & 15, cc = c & 31, ob = rr * 64 + cc * 2; return st * 1024 + (ob ^ (((ob >> 9) & 1) << 5)); }
DI void stage_rc(int b, int& R, int& C) { const int st = b / 1024, sb = b % 1024, swz = sb ^ (((sb >> 9) & 1) << 5); R = (st >> 1) * 16 + swz / 64; C = (st & 1) * 32 + (swz % 64) / 2; }
DI int perm32(int rho) { const int n = rho >> 4, i = rho & 15; return 8 * (i >> 2) + 4 * n + (i & 3); }
struct Unit { int pm, pn; };
struct Gemm { const bf16_t* A; const bf16_t* Bt; int lda, ldb, M, N, K; };
struct StaticOrder {
    int nM, nN, nwg, G, c;
    DI void init(int M, int N, int G_, int c_) { nM = M / BM; nN = N / BM; nwg = nM * nN; G = G_; c = c_; }
    DI bool next(int i, Unit& u) const {
        const long L = (long)i * G + c; if (L >= nwg) return false;
        int wgid = (int)L; { const int q = nwg / NXCD, r = nwg % NXCD, xcd = wgid % NXCD, off = wgid / NXCD; wgid = (xcd < r ? xcd * (q + 1) : r * (q + 1) + (xcd - r) * q) + off; }
        const int nig = WGM * nN, gid = wgid / nig, fm = gid * WGM, gsz = (nM - fm) < WGM ? (nM - fm) : WGM;
        u.pm = fm + ((wgid % nig) % gsz); u.pn = (wgid % nig) / gsz; return true;
    }
};

template <class Epi>
DI void gemm_phase(LAS unsigned char* lds, const Gemm g, const StaticOrder& S, const Epi& E) {
    const int tid = threadIdx.x, wid = __builtin_amdgcn_readfirstlane(tid >> 6), lane = tid & 63, wr = wid >> 2, wc = wid & 3, fr = lane & 15, fq = lane >> 4;
    const int K = g.K, nt = K / BK;
    unsigned voffA[2], voffB[2];
#pragma unroll
    for (int i = 0; i < 2; ++i) { int R, C; stage_rc(tid * 16 + i * 8192, R, C); const int Rb = Epi::PERM ? ((R & ~31) + perm32(R & 31)) : R;
        voffA[i] = (unsigned)(R * g.lda + C) * 2u; voffB[i] = (unsigned)(Rb * g.ldb + C) * 2u; }
    const size_t kstep = (size_t)(BK * 2);
    const size_t hstepA = (size_t)HALF * g.lda * 2, hstepB = (size_t)HALF * g.ldb * 2;
    const size_t tstepA = 2 * hstepA, tstepB = 2 * hstepB;
    const unsigned ldsw = (unsigned)wid * 1024u;
    const int aoff = lds_byte(wr * 64 + fr, fq * 8), boff = lds_byte(wc * 32 + fr, fq * 8);
#define PG8_SA(b, h) (((b) * 2 + (h)) * HTB)
#define PG8_SB(b, h) ((4 + (b) * 2 + (h)) * HTB)
#define PG8_STAGE(bufoff, gbase, voff) do { _Pragma("unroll") for (int _i = 0; _i < 2; ++_i) \
        __builtin_amdgcn_global_load_lds((const unsigned*)((const char*)(gbase) + (voff)[_i]), (LAS unsigned*)(lds + (bufoff) + ldsw + _i * 8192), 16, 0, 0); } while (0)
#define PG8_LDA(dst, b, h) do { _Pragma("unroll") for (int m = 0; m < 4; ++m) _Pragma("unroll") for (int k = 0; k < 2; ++k) dst[m][k] = *(const LAS bf16x8*)(lds + PG8_SA(b, h) + aoff + m * 2048 + k * 1024); } while (0)
#define PG8_LDB(dst, b, h) do { _Pragma("unroll") for (int n = 0; n < 2; ++n) _Pragma("unroll") for (int k = 0; k < 2; ++k) dst[n][k] = *(const LAS bf16x8*)(lds + PG8_SB(b, h) + boff + n * 2048 + k * 1024); } while (0)
#define PG8_MMA(ai, bj, At, Bt) do { __builtin_amdgcn_s_setprio(1); _Pragma("unroll") for (int m = 0; m < 4; ++m) _Pragma("unroll") for (int n = 0; n < 2; ++n) _Pragma("unroll") for (int k = 0; k < 2; ++k) \
        acc[ai][bj][m][n] = __builtin_amdgcn_mfma_f32_16x16x32_bf16(Bt[n][k], At[m][k], acc[ai][bj][m][n], 0, 0, 0); __builtin_amdgcn_s_setprio(0); } while (0)
#define PG8_WAIT_V(n) asm volatile("s_waitcnt vmcnt(" #n ")" ::: "memory")
#define PG8_WAIT_L(n) asm volatile("s_waitcnt lgkmcnt(" #n ")" ::: "memory")
#define PG8_BAR __builtin_amdgcn_s_barrier()
#define PG8_SCHED __builtin_amdgcn_sched_barrier(0)
    Unit cur, nxt; int ui = 0;
    if (!S.next(0, cur)) return;
    f32x4 acc[2][2][4][2];
#pragma unroll
    for (int a = 0; a < 2; ++a)
#pragma unroll
        for (int b = 0; b < 2; ++b)
#pragma unroll
            for (int m = 0; m < 4; ++m)
#pragma unroll
                for (int n = 0; n < 2; ++n) acc[a][b][m][n] = (f32x4){0.f, 0.f, 0.f, 0.f};
    bf16x8 At[4][2], B0[2][2], B1[2][2];
    const char* cA = (const char*)g.A + (size_t)cur.pm * tstepA; const char* cB = (const char*)g.Bt + (size_t)cur.pn * tstepB;
    PG8_STAGE(PG8_SB(0, 0), cB, voffB); PG8_STAGE(PG8_SA(0, 0), cA, voffA); PG8_STAGE(PG8_SB(0, 1), cB + hstepB, voffB); PG8_STAGE(PG8_SA(0, 1), cA + hstepA, voffA);
    if (wr == 1) PG8_BAR;
    PG8_WAIT_V(4); PG8_BAR;
    PG8_STAGE(PG8_SB(1, 0), cB + kstep, voffB); PG8_STAGE(PG8_SA(1, 0), cA + kstep, voffA); PG8_STAGE(PG8_SB(1, 1), cB + hstepB + kstep, voffB);
    PG8_WAIT_V(6); PG8_BAR;
    for (;;) {
        const bool has_next = S.next(ui + 1, nxt);
        const char* nA = has_next ? (const char*)g.A + (size_t)nxt.pm * tstepA : cA; const char* nB = has_next ? (const char*)g.Bt + (size_t)nxt.pn * tstepB : cB;
        for (int t = 0; t < nt; t += 2) {
            const bool last = (t == nt - 2);
            const char* a1 = cA + (size_t)(t + 1) * kstep;
            const char* a2 = last ? nA : cA + (size_t)(t + 2) * kstep; const char* b2 = last ? nB : cB + (size_t)(t + 2) * kstep;
            const char* a3 = a2 + kstep; const char* b3 = b2 + kstep;
            PG8_LDB(B0, 0, 0); PG8_SCHED; PG8_LDA(At, 0, 0); PG8_STAGE(PG8_SA(1, 1), a1 + hstepA, voffA);
            PG8_WAIT_L(8); PG8_BAR; PG8_WAIT_L(0); PG8_MMA(0, 0, At, B0); PG8_BAR; PG8_SCHED;
            PG8_LDB(B1, 0, 1); PG8_STAGE(PG8_SB(0, 0), b2, voffB);
            PG8_BAR; PG8_WAIT_L(0); PG8_MMA(0, 1, At, B1); PG8_BAR;
            PG8_LDA(At, 0, 1); PG8_STAGE(PG8_SA(0, 0), a2, voffA);
            PG8_BAR; PG8_WAIT_L(0); PG8_MMA(1, 0, At, B0); PG8_BAR; PG8_SCHED;
            PG8_STAGE(PG8_SB(0, 1), b2 + hstepB, voffB);
            PG8_WAIT_V(6); PG8_BAR; PG8_MMA(1, 1, At, B1); PG8_BAR;
            PG8_LDB(B0, 1, 0); PG8_SCHED; PG8_LDA(At, 1, 0); PG8_STAGE(PG8_SA(0, 1), a2 + hstepA, voffA);
            PG8_WAIT_L(8); PG8_BAR; PG8_WAIT_L(0); PG8_MMA(0, 0, At, B0); PG8_BAR; PG8_SCHED;
            PG8_LDB(B1, 1, 1); PG8_STAGE(PG8_SB(1, 0), b3, voffB);
            PG8_BAR; PG8_WAIT_L(0); PG8_MMA(0, 1, At, B1); PG8_BAR;
            PG8_LDA(At, 1, 1); PG8_STAGE(PG8_SA(1, 0), a3, voffA);
            PG8_BAR; PG8_WAIT_L(0); PG8_MMA(1, 0, At, B0); PG8_BAR; PG8_SCHED;
            PG8_STAGE(PG8_SB(1, 1), b3 + hstepB, voffB);
            PG8_WAIT_V(6); PG8_BAR; PG8_MMA(1, 1, At, B1); PG8_BAR;
        }
        E(acc, cur, wr, wc, fr, fq);
        if (!has_next) break;
#pragma unroll
        for (int a = 0; a < 2; ++a)
#pragma unroll
            for (int b = 0; b < 2; ++b)
#pragma unroll
                for (int m = 0; m < 4; ++m)
#pragma unroll
                    for (int n = 0; n < 2; ++n) acc[a][b][m][n] = (f32x4){0.f, 0.f, 0.f, 0.f};
        cur = nxt; cA = nA; cB = nB; ++ui;
    }
    PG8_WAIT_V(0);
    if (wr == 0) PG8_BAR;
    PG8_BAR;
#undef PG8_SA
#undef PG8_SB
#undef PG8_STAGE
#undef PG8_LDA
#undef PG8_LDB
#undef PG8_MMA
#undef PG8_WAIT_V
#undef PG8_WAIT_L
#undef PG8_BAR
#undef PG8_SCHED
}

template <int MODE> struct EpiScaleBf16 {
    static constexpr bool PERM = true;
    bf16_t* O; int ldc; const float* rs;
    DI void operator()(const f32x4 (&acc)[2][2][4][2], const Unit& u, int wr, int wc, int fr, int fq) const {
        const int row0 = u.pm * BM + wr * 64 + fr, col0 = u.pn * BM + wc * 32 + 8 * fq;
#pragma unroll
        for (int ai = 0; ai < 2; ++ai)
#pragma unroll
            for (int m = 0; m < 4; ++m) {
                const int row = row0 + ai * HALF + m * 16;
                float sc = 1.f;
                if (MODE != 2) { sc = rs[row]; if (MODE == 1) sc = rsqrtf(sc * (1.f / 2048.f) + 1e-6f); }
                bf16_t* rowp = O + (size_t)row * ldc + col0;
#pragma unroll
                for (int bj = 0; bj < 2; ++bj) {
                    const f32x4 v0 = acc[ai][bj][m][0] * sc, v1 = acc[ai][bj][m][1] * sc;
                    u32x4 w; w.x = pk2(v0[0], v0[1]); w.y = pk2(v0[2], v0[3]); w.z = pk2(v1[0], v1[1]); w.w = pk2(v1[2], v1[3]);
                    *(u32x4*)(rowp + bj * HALF) = w;
                }
            }
    }
};
struct EpiResid {
    static constexpr bool PERM = false;
    const float* R; float* H; bf16_t* HB; float* SS;
    DI void operator()(const f32x4 (&acc)[2][2][4][2], const Unit& u, int wr, int wc, int fr, int fq) const {
        const int row0 = u.pm * BM + wr * 64 + fr, col0 = u.pn * BM + wc * 32 + 4 * fq;
#pragma unroll
        for (int ai = 0; ai < 2; ++ai)
#pragma unroll
            for (int m = 0; m < 4; ++m) {
                const int row = row0 + ai * HALF + m * 16;
                const size_t ro = (size_t)row * DM + col0;
                float ss = 0.f;
#pragma unroll
                for (int bj = 0; bj < 2; ++bj)
#pragma unroll
                    for (int n = 0; n < 2; ++n) {
                        const size_t o = ro + bj * HALF + n * 16;
                        const f32x4 r = *(const f32x4*)(R + o);
                        const f32x4 v = acc[ai][bj][m][n] + r;
                        *(f32x4*)(H + o) = v;
                        ss += v[0] * v[0] + v[1] * v[1] + v[2] * v[2] + v[3] * v[3];
                        if (HB) { u32x2 w; w.x = pk2(v[0], v[1]); w.y = pk2(v[2], v[3]); *(u32x2*)(HB + o) = w; }
                    }
                if (SS) { ss += __shfl_xor(ss, 16); ss += __shfl_xor(ss, 32); if (fq == 0) atomicAdd(SS + row, ss); }
            }
    }
};
}

DI void tconv(const float* src, int K, int N, bf16_t* dst, int Npad, const float* rs, int mode, LAS float* tile) {
    const int tid = threadIdx.x, nkt = K / 64, ntiles = nkt * (Npad / 128);
    float vv[16];
    auto ldt = [&](int tl) {
        const int kt = tl % nkt, ntb = tl / nkt, k0 = kt * 64, n0 = ntb * 128;
#pragma unroll
        for (int i = 0; i < 4; ++i) {
            const int idx = tid + i * 512, kk = idx >> 5, n = n0 + (idx & 31) * 4;
            int sc = n < N ? n : -1; float scale = 1.f;
            if (mode == 1) { scale = (n >= 2048 && n < 4096) ? 0.0625f : 1.f; }
            if (mode == 2) {
                if (n < 5120) { sc = n; scale = n < 2048 ? 0.12751743074602467f : 1.f; }
                else if (n < 7168) sc = n + 48;
                else if (n < 7216) sc = n - 2048;
                else sc = -1;
            }
            f32x4 v = (f32x4){0.f, 0.f, 0.f, 0.f};
            if (sc >= 0) { v = *(const f32x4*)(src + (size_t)(k0 + kk) * N + sc); if (rs) scale *= rs[k0 + kk]; v = v * scale; }
            vv[4 * i] = v[0]; vv[4 * i + 1] = v[1]; vv[4 * i + 2] = v[2]; vv[4 * i + 3] = v[3];
        }
    };
    if ((int)blockIdx.x < ntiles) ldt(blockIdx.x);
    for (int tl = blockIdx.x; tl < ntiles; tl += gridDim.x) {
        const int kt = tl % nkt, ntb = tl / nkt, k0 = kt * 64, n0 = ntb * 128;
#pragma unroll
        for (int i = 0; i < 4; ++i) { const int idx = tid + i * 512, kk = idx >> 5, nn = (idx & 31) * 4;
#pragma unroll
            for (int e = 0; e < 4; ++e) tile[kk * 129 + nn + e] = vv[4 * i + e]; }
        if (tl + (int)gridDim.x < ntiles) ldt(tl + gridDim.x);
        lds_barrier();
#pragma unroll
        for (int i = 0; i < 2; ++i) {
            const int id = tid + 512 * i, k8 = id & 7, nn = id >> 3;
            u32x4 w;
#pragma unroll
            for (int d = 0; d < 4; ++d) w[d] = pk2(tile[(k8 * 8 + 2 * d) * 129 + nn], tile[(k8 * 8 + 2 * d + 1) * 129 + nn]);
            *(u32x4*)(dst + (size_t)(n0 + nn) * K + k0 + k8 * 8) = w;
        }
        lds_barrier();
    }
}

DI void phase0(const Params& p, LAS unsigned char* lds) {
    unsigned char* ws = p.ws;
    LAS float* tile = (LAS float*)lds;
    const int tid = threadIdx.x, lane = tid & 63, wave = tid >> 6;
    tconv(p.ret_w_in, 2048, 12288, (bf16_t*)(ws + OFF_W1T), 12288, p.norm_g, 1, tile);
    tconv(p.ret_w_out, 4096, 2048, (bf16_t*)(ws + OFF_W2T), 2048, nullptr, 0, tile);
    tconv(p.nsa_w_in, 2048, 7216, (bf16_t*)(ws + OFF_W3T), LD1, p.norm_g + 2048, 2, tile);
    tconv(p.nsa_w_out, 2048, 2048, (bf16_t*)(ws + OFF_W4T), 2048, nullptr, 0, tile);
    tconv(p.w1_k, 4096, 128, (bf16_t*)(ws + OFF_CW1K), 128, nullptr, 0, tile);
    tconv(p.w1_v, 4096, 128, (bf16_t*)(ws + OFF_CW1V), 128, nullptr, 0, tile);
    tconv(p.w2_k, 128, 128, (bf16_t*)(ws + OFF_CW2K), 128, nullptr, 0, tile);
    tconv(p.w2_v, 128, 128, (bf16_t*)(ws + OFF_CW2V), 128, nullptr, 0, tile);
    bf16_t* xb = (bf16_t*)(ws + OFF_XB); float* rstd0 = (float*)(ws + OFF_RSTD0); float* ss1 = (float*)(ws + OFF_SS1);
    for (int row0 = (blockIdx.x * 8 + wave) * 2; row0 < T_; row0 += gridDim.x * 16) {
        f32x4 v[2][8]; float ss[2] = {0.f, 0.f};
#pragma unroll
        for (int q = 0; q < 2; ++q) {
            const f32x4* xr = (const f32x4*)(p.x + (size_t)(row0 + q) * DM);
#pragma unroll
            for (int i = 0; i < 8; ++i) v[q][i] = xr[lane + 64 * i];
        }
#pragma unroll
        for (int q = 0; q < 2; ++q)
#pragma unroll
            for (int i = 0; i < 8; ++i) ss[q] += v[q][i][0] * v[q][i][0] + v[q][i][1] * v[q][i][1] + v[q][i][2] * v[q][i][2] + v[q][i][3] * v[q][i][3];
        ss[0] = wave_sum(ss[0]); ss[1] = wave_sum(ss[1]);
#pragma unroll
        for (int q = 0; q < 2; ++q) {
            const float rs0 = rsqrtf(ss[q] * (1.f / 2048.f) + 1e-6f);
#pragma unroll
            for (int i = 0; i < 8; ++i) { u32x2 w; w.x = pk2(v[q][i][0] * rs0, v[q][i][1] * rs0); w.y = pk2(v[q][i][2] * rs0, v[q][i][3] * rs0); *(u32x2*)(xb + (size_t)(row0 + q) * DM + (lane + 64 * i) * 4) = w; }
        }
    }
    for (int i = blockIdx.x * NTHREADS + tid; i < T_; i += gridDim.x * NTHREADS) ss1[i] = 0.f;
    {
        float* cb = (float*)(ws + OFF_CBZ);
        LAS float* red = (LAS float*)lds;
        for (int bb = blockIdx.x; bb < 128; bb += gridDim.x) {
            const int kv = bb >> 6, i0 = 64 * (bb & 63);
            const float* pos = kv ? p.pos_v : p.pos_k; const float* w1 = kv ? p.w1_v : p.w1_k;
            float a0 = 0.f, a1 = 0.f;
#pragma unroll
            for (int r = 0; r < 8; ++r) {
                const int i = i0 + 8 * wave + r;
                const float pv = pos[i];
                const float2 wv = *(const float2*)(w1 + (size_t)i * 128 + 2 * lane);
                a0 += pv * wv.x; a1 += pv * wv.y;
            }
            lds_barrier();
            red[wave * 128 + 2 * lane] = a0; red[wave * 128 + 2 * lane + 1] = a1;
            lds_barrier();
            if (tid < 128) {
                float s = 0.f;
#pragma unroll
                for (int w = 0; w < 8; ++w) s += red[w * 128 + tid];
                atomicAdd(cb + kv * 128 + tid, s);
            }
        }
    }
}

DI void ret_intra(const bf16_t* PROJ, bf16_t* OI, bf16_t* KTG, LAS unsigned char* lds) {
    const int tid = threadIdx.x, lane = tid & 63, wave = tid >> 6, r32 = lane & 31, hh = lane >> 5;
    LAS bf16_t* Qs = (LAS bf16_t*)lds;
    LAS bf16_t* Ks = (LAS bf16_t*)(lds + 67584);
    LAS bf16_t* Ss = Qs;
    LAS bf16_t* OUTs = (LAS bf16_t*)(lds + 34816);
    LAS bf16_t* VT0 = (LAS bf16_t*)(lds + 69632);
    u32x4 qk[16];
    auto loadQK = [&](int u) {
        const int b = u >> 10, h = (u >> 7) & 7, ch = u & 127;
        unsigned tq = tid; asm volatile("" : "+v"(tq));
        const bf16_t* base = PROJ + ((size_t)b * S_ + ch * 128) * LD0 + h * 256;
#pragma unroll
        for (int i = 0; i < 8; ++i) {
            const unsigned pc = tq + i * 512, off = (pc >> 5) * LD0 + (pc & 31) * 8;
            qk[2 * i] = *(const u32x4*)(base + off);
            qk[2 * i + 1] = *(const u32x4*)(base + (off + 2048));
        }
    };
    if ((int)blockIdx.x < 2048) loadQK(blockIdx.x);
    for (int u = blockIdx.x; u < 2048; u += gridDim.x) {
        const int b = u >> 10, h = (u >> 7) & 7, ch = u & 127;
        const size_t t0 = (size_t)b * S_ + ch * 128;
        const float logg = log1pf(-exp2f(-5.f - (float)h));
        {
            int tq = tid; asm volatile("" : "+v"(tq));
#pragma unroll
            for (int i = 0; i < 8; ++i) {
                const int pc = tq + i * 512, row = pc >> 5, cs = pc & 31;
                *(LAS u32x4*)(Qs + row * 264 + cs * 8) = qk[2 * i];
                *(LAS u32x4*)(Ks + row * 264 + cs * 8) = qk[2 * i + 1];
            }
        }
        const int vg = (tid & 3) + 4 * (tid >> 7), mg = (tid >> 2) & 31;
        u32x4 VA[4], VB[4];
        const bf16_t* vbase = PROJ + t0 * LD0 + 4096 + h * 512;
        auto loadV = [&](u32x4 (&R)[4], int pz) {
            unsigned mq = mg, vq = vg; asm volatile("" : "+v"(mq)); asm volatile("" : "+v"(vq));
#pragma unroll
            for (int rr = 0; rr < 4; ++rr) R[rr] = *(const u32x4*)(vbase + ((4 * mq + rr) * LD0 + pz * 128 + 8 * vq));
        };
        auto writeV = [&](const u32x4 (&R)[4], int pz) {
            LAS bf16_t* VT = VT0 + (pz & 1) * (128 * 136);
            u32x2 o[8]; tr4x8(R, o);
#pragma unroll
            for (int jj = 0; jj < 8; ++jj) *(LAS u32x2*)(VT + (8 * vg + jj) * 136 + 4 * mg) = o[jj];
        };
        loadV(VA, 0); loadV(VB, 1);
        lds_barrier();
        const int nt = wave & 3, mtb = (wave >> 2) * 2;
        f32x16 sacc[2];
#pragma unroll
        for (int mi = 0; mi < 2; ++mi) {
            const int mt = mtb + mi; sacc[mi] = zero16();
            if (mt <= nt) {
#pragma unroll
                for (int s = 0; s < 16; ++s)
                    sacc[mi] = MFMA32(ldsfrag(Ks + (mt * 32 + r32) * 264 + 16 * s + 8 * hh), ldsfrag(Qs + (nt * 32 + r32) * 264 + 16 * s + 8 * hh), sacc[mi]);
            }
        }
        {
            bf16_t* kt = KTG + (size_t)u * 32768;
#pragma unroll
            for (int i = 0; i < 2; ++i) {
                const int bi = tid + 512 * i, mgk = bi & 31, dg = bi >> 5;
                u32x4 R[4]; u32x2 o[8];
#pragma unroll
                for (int rr = 0; rr < 4; ++rr) R[rr] = *(const LAS u32x4*)(Ks + (4 * mgk + rr) * 264 + 8 * dg);
                tr4x8(R, o);
#pragma unroll
                for (int jj = 0; jj < 8; ++jj) *(u32x2*)(kt + (8 * dg + jj) * 128 + 4 * mgk) = o[jj];
            }
        }
        lds_barrier();
        const int n = nt * 32 + r32;
#pragma unroll
        for (int mi = 0; mi < 2; ++mi) {
            const int mt = mtb + mi;
#pragma unroll
            for (int G = 0; G < 4; ++G) {
                const int m0 = mt * 32 + 8 * G + 4 * hh;
                float v[4];
#pragma unroll
                for (int j = 0; j < 4; ++j) { const int df = n - (m0 + j); v[j] = df >= 0 ? sacc[mi][4 * G + j] * __expf((float)df * logg) : 0.f; }
                u32x2 w; w.x = pk2(v[0], v[1]); w.y = pk2(v[2], v[3]);
                *(LAS u32x2*)(Ss + n * 136 + m0) = w;
            }
        }
        writeV(VA, 0); loadV(VA, 2);
        if (u + (int)gridDim.x < 2048) loadQK(u + gridDim.x);
        const int vtb = (wave >> 2) * 2;
        auto piece = [&](int pz) {
            LAS bf16_t* VT = VT0 + (pz & 1) * (128 * 136);
#pragma unroll
            for (int vi = 0; vi < 2; ++vi) {
                const int vt = vtb + vi; f32x16 acc = zero16();
                for (int s = 0; s < 2 * (nt + 1); ++s)
                    acc = MFMA32(ldsfrag(VT + (vt * 32 + r32) * 136 + 16 * s + 8 * hh), ldsfrag(Ss + (nt * 32 + r32) * 136 + 16 * s + 8 * hh), acc);
#pragma unroll
                for (int G = 0; G < 4; ++G) {
                    u32x2 w; w.x = pk2(acc[4 * G], acc[4 * G + 1]); w.y = pk2(acc[4 * G + 2], acc[4 * G + 3]);
                    *(LAS u32x2*)(OUTs + n * 136 + vt * 32 + 8 * G + 4 * hh) = w;
                }
            }
        };
        auto flush = [&](int pz) {
            int tq = tid; asm volatile("" : "+v"(tq));
#pragma unroll
            for (int i = 0; i < 4; ++i) {
                const int pc = tq + 512 * i, row = pc >> 4, c16 = pc & 15;
                *(u32x4*)(OI + (t0 + row) * 4096 + h * 512 + pz * 128 + c16 * 8) = *(const LAS u32x4*)(OUTs + row * 136 + c16 * 8);
            }
        };
        lds_barrier(); writeV(VB, 1); loadV(VB, 3); piece(0); lds_barrier(); flush(0);
        lds_barrier(); writeV(VA, 2); piece(1); lds_barrier(); flush(1);
        lds_barrier(); writeV(VB, 3); piece(2); lds_barrier(); flush(2);
        lds_barrier(); piece(3); lds_barrier(); flush(3);
        lds_barrier();
    }
}

DI void ret_inter(bf16_t* PROJ, const bf16_t* OI, const bf16_t* KTG, LAS unsigned char* lds, bool dummy = false) {
    const int tid = threadIdx.x, lane = tid & 63, wave = tid >> 6, r32 = lane & 31, hh = lane >> 5;
    LAS bf16_t* KT = (LAS bf16_t*)lds;
    LAS bf16_t* VT = (LAS bf16_t*)(lds + 69632);
    LAS bf16_t* ST = (LAS bf16_t*)(lds + 69632 + 8704);
    LAS bf16_t* Qs = (LAS bf16_t*)(lds + 69632 + 8704 + 16896);
    for (int u = blockIdx.x; u < 256; u += gridDim.x) {
        const int uu = (gridDim.x == 256) ? ((((u & 7) * 2 + (u >> 7)) << 4) + ((u >> 3) & 15)) : u;
        const int b = uu >> 7, h = (uu >> 4) & 7, vs = uu & 15, v0 = vs * 32;
        const float logg = log1pf(-exp2f(-5.f - (float)h));
        const float cd = __expf(128.f * logg);
        for (int i = tid; i < 32 * 264 / 2; i += NTHREADS) ((LAS unsigned*)ST)[i] = 0u;
        const size_t tb = (size_t)b * S_;
        if (wave < 4) {
            struct QSet { u32x4 q[16]; u32x4 o[2]; };
            QSet QA, QB;
            const int n = 32 * wave + r32;
            auto loadq = [&](QSet& Q, int c) {
                unsigned tq = tid; asm volatile("" : "+v"(tq));
                const bf16_t* qb_ = PROJ + (tb + c * 128) * LD0 + h * 256;
                const bf16_t* ob_ = OI + (tb + c * 128) * 4096 + h * 512 + v0;
#pragma unroll
                for (int i = 0; i < 16; ++i) { const unsigned pc = tq + 256 * i; Q.q[i] = *(const u32x4*)(qb_ + ((pc >> 5) * LD0 + (pc & 31) * 8)); }
                const unsigned nq = 32 * (tq >> 6) + (tq & 31), hq = (tq >> 5) & 1;
#pragma unroll
                for (int e = 0; e < 2; ++e) Q.o[e] = *(const u32x4*)(ob_ + (nq * 4096 + 16 * e + 8 * hq));
            };
            const float qd = __expf((float)(n + 1) * logg);
            auto stepq = [&](int c, QSet& Q) {
                {
                    int tq = tid; asm volatile("" : "+v"(tq));
#pragma unroll
                    for (int i = 0; i < 16; ++i) { const int pc = tq + 256 * i; *(LAS u32x4*)(Qs + (pc >> 5) * 264 + (pc & 31) * 8) = Q.q[i]; }
                }
                const u32x4 o0 = Q.o[0], o1 = Q.o[1];
                if (c + 2 < 128) loadq(Q, c + 2);
                lds_barrier();
                f32x16 acc = zero16(), acc1 = zero16();
#pragma unroll
                for (int s = 0; s < 16; s += 2) {
                    acc = MFMA32(ldsfrag(ST + r32 * 264 + 16 * s + 8 * hh), ldsfrag(Qs + n * 264 + 16 * s + 8 * hh), acc);
                    acc1 = MFMA32(ldsfrag(ST + r32 * 264 + 16 * (s + 1) + 8 * hh), ldsfrag(Qs + n * 264 + 16 * (s + 1) + 8 * hh), acc1);
                }
                acc = acc + acc1;
                u32x4 w0, w1;
#pragma unroll
                for (int d = 0; d < 4; ++d) {
                    w0[d] = pk2(bflo(o0[d]) + acc[2 * d] * qd, bfhi(o0[d]) + acc[2 * d + 1] * qd);
                    w1[d] = pk2(bflo(o1[d]) + acc[8 + 2 * d] * qd, bfhi(o1[d]) + acc[8 + 2 * d + 1] * qd);
                }
                {
                    unsigned nq = n; asm volatile("" : "+v"(nq));
                    bf16_t* wb_ = PROJ + (tb + c * 128) * LD0 + 4096 + h * 512 + v0;
                    const unsigned wo = nq * LD0 + 8 * hh;
                    if (!dummy) { *(u32x4*)(wb_ + wo) = w0; *(u32x4*)(wb_ + (wo + 16)) = w1; }
                }
                lds_barrier();
            };
            loadq(QA, 0); loadq(QB, 1);
            for (int c = 0; c < 128; c += 2) { stepq(c, QA); stepq(c + 1, QB); }
        } else {
            struct KSet { u32x4 k[4][4]; u32x4 v[2]; };
            KSet KA, KB;
            const int t4 = tid - 256;
            auto loadk = [&](KSet& K, int c) {
                unsigned tq = t4; asm volatile("" : "+v"(tq));
                const bf16_t* kb_ = KTG + ((size_t)((b * 8 + h) * 128 + c)) * 32768;
                const bf16_t* vb_ = PROJ + (tb + c * 128) * LD0 + 4096 + h * 512 + v0;
#pragma unroll
                for (int i = 0; i < 16; ++i) K.k[i >> 2][i & 3] = *(const u32x4*)(kb_ + (tq + 256 * i) * 8u);
#pragma unroll
                for (int i = 0; i < 2; ++i) { const unsigned pi = tq + 256 * i; K.v[i] = *(const u32x4*)(vb_ + ((pi >> 2) * LD0 + 8 * (pi & 3))); }
            };
            f32x16 sacc[2]; sacc[0] = zero16(); sacc[1] = zero16();
            auto stepk = [&](int c, KSet& K) {
                int tw = t4; asm volatile("" : "+v"(tw));
#pragma unroll
                for (int i = 0; i < 16; ++i) { const int pc = tw + 256 * i; *(LAS u32x4*)(KT + (pc >> 4) * 136 + (pc & 15) * 8) = K.k[i >> 2][i & 3]; }
#pragma unroll
                for (int i = 0; i < 2; ++i) {
                    const int pi = tw + 256 * i, vm = pi >> 2, vgq = pi & 3;
                    const float kd = __expf((float)(127 - vm) * logg);
#pragma unroll
                    for (int d = 0; d < 4; ++d) {
                        const unsigned wv = K.v[i][d];
                        const unsigned a = pk2(bflo(wv) * kd, bfhi(wv) * kd);
                        const int vl = 8 * vgq + 2 * d, q4 = vl >> 2, pq = ((q4 & 3) == 1 || (q4 & 3) == 2) ? (q4 ^ 3) : q4, rho = (pq << 2) | (vl & 3);
                        VT[rho * 136 + vm] = (bf16_t)(a & 0xffffu);
                        VT[(rho + 1) * 136 + vm] = (bf16_t)(a >> 16);
                    }
                }
                if (c + 2 < 128) loadk(K, c + 2);
                lds_barrier();
#pragma unroll
                for (int ti = 0; ti < 2; ++ti) sacc[ti] = sacc[ti] * cd;
#pragma unroll
                for (int s = 0; s < 8; ++s)
#pragma unroll
                    for (int ti = 0; ti < 2; ++ti) {
                        const int d = (2 * (wave - 4) + ti) * 32 + r32;
                        sacc[ti] = MFMA32(ldsfrag(KT + d * 136 + 16 * s + 8 * hh), ldsfrag(VT + r32 * 136 + 16 * s + 8 * hh), sacc[ti]);
                    }
                lds_barrier();
#pragma unroll
                for (int ti = 0; ti < 2; ++ti) {
                    const int dt = 2 * (wave - 4) + ti;
#pragma unroll
                    for (int G = 0; G < 4; ++G) {
                        u32x2 w; w.x = pk2(sacc[ti][4 * G], sacc[ti][4 * G + 1]); w.y = pk2(sacc[ti][4 * G + 2], sacc[ti][4 * G + 3]);
                        *(LAS u32x2*)(ST + r32 * 264 + dt * 32 + 8 * G + 4 * hh) = w;
                    }
                }
            };
            loadk(KA, 0); loadk(KB, 1);
            for (int c = 0; c < 128; c += 2) { stepk(c, KA); stepk(c + 1, KB); }
        }
        lds_barrier();
    }
}

DI void ret_gate(bf16_t* PROJ, bf16_t* dummy = nullptr) {
    const int lane = threadIdx.x & 63, wave = threadIdx.x >> 6;
    const int nw = gridDim.x * 8, gw = blockIdx.x * 8 + wave;
    for (int task0 = gw * 8; task0 < T_ * 8; task0 += nw * 8) {
        u32x4 o8[8], g8[8];
#pragma unroll
        for (int q = 0; q < 8; ++q) {
            const int task = task0 + q; const size_t t = task >> 3; const int h = task & 7;
            o8[q] = *(const u32x4*)(PROJ + t * LD0 + 4096 + h * 512 + lane * 8);
            g8[q] = *(const u32x4*)(PROJ + t * LD0 + 8192 + h * 512 + lane * 8);
        }
#pragma unroll
        for (int q = 0; q < 8; ++q) {
            const int task = task0 + q; const size_t t = task >> 3; const int h = task & 7;
            float f[8], gt[8];
#pragma unroll
            for (int d = 0; d < 4; ++d) { f[2 * d] = bflo(o8[q][d]); f[2 * d + 1] = bfhi(o8[q][d]); gt[2 * d] = bflo(g8[q][d]); gt[2 * d + 1] = bfhi(g8[q][d]); }
            float s = 0.f;
#pragma unroll
            for (int d = 0; d < 8; ++d) s += f[d];
            const float mu = wave_sum(s) * (1.f / 512.f);
            float s2 = 0.f;
#pragma unroll
            for (int d = 0; d < 8; ++d) { f[d] -= mu; s2 += f[d] * f[d]; }
            const float rs = rsqrtf(wave_sum(s2) * (1.f / 512.f) + 1e-6f);
            u32x4 w;
#pragma unroll
            for (int d = 0; d < 4; ++d) w[d] = pk2(silu_f(gt[2 * d]) * f[2 * d] * rs, silu_f(gt[2 * d + 1]) * f[2 * d + 1] * rs);
            if (dummy) *(u32x4*)(dummy + (t & 4095) * LD0 + 8192 + h * 512 + lane * 8) = w; else *(u32x4*)(PROJ + t * LD0 + 8192 + h * 512 + lane * 8) = w;
        }
    }
}

DI void nsa_compress(const bf16_t* P1, unsigned char* ws, bf16_t* KC, bf16_t* VCT, bf16_t* VST, bf16_t* VWT, bf16_t* KS2, bf16_t* KW2, LAS unsigned char* lds) {
    const int tid = threadIdx.x, lane = tid & 63, wave = tid >> 6, r32 = lane & 31, hh = lane >> 5;
    LAS bf16_t* As = (LAS bf16_t*)lds;
    LAS bf16_t* Ws = (LAS bf16_t*)(lds + 17408);
    LAS bf16_t* Hs = (LAS bf16_t*)(lds + 17408 + 34816);
    const float* cb = (const float*)(ws + OFF_CBZ);
    for (int u = blockIdx.x; u < 256; u += gridDim.x) {
        const int kv = u >> 7, bg = (u >> 4) & 7, ct = u & 15, b = bg >> 2, g = bg & 3;
        const bf16_t* W1T = (const bf16_t*)(ws + (kv ? OFF_CW1V : OFF_CW1K));
        const bf16_t* W2T = (const bf16_t*)(ws + (kv ? OFF_CW2V : OFF_CW2K));
        const int colA = (kv ? C_VC : C_KC) + g * 128;
        const int ch = wave & 1, jt = wave >> 1;
        f32x16 acc = zero16();
        u32x4 pa[2], pw[4];
        auto ldl = [&](int l) {
            unsigned tq = tid; asm volatile("" : "+v"(tq));
#pragma unroll
            for (int i = 0; i < 2; ++i) {
                const unsigned pc = tq + 512 * i, row = pc >> 4, cs = pc & 15;
                unsigned tok = 16 * (ct * 64 + row) + l; tok = tok < (unsigned)S_ ? tok : S_ - 1;
                pa[i] = *(const u32x4*)(P1 + ((size_t)b * S_ + tok) * LD1 + colA + cs * 8);
            }
#pragma unroll
            for (int i = 0; i < 4; ++i) {
                const unsigned pc = tq + 512 * i, row = pc >> 4, cs = pc & 15;
                pw[i] = *(const u32x4*)(W1T + (row * 4096 + l * 128 + cs * 8));
            }
        };
        ldl(0);
        for (int l = 0; l < 32; ++l) {
            lds_barrier();
            {
                int tq = tid; asm volatile("" : "+v"(tq));
#pragma unroll
                for (int i = 0; i < 2; ++i) { const int pc = tq + 512 * i; *(LAS u32x4*)(As + (pc >> 4) * 136 + (pc & 15) * 8) = pa[i]; }
#pragma unroll
                for (int i = 0; i < 4; ++i) { const int pc = tq + 512 * i; *(LAS u32x4*)(Ws + (pc >> 4) * 136 + (pc & 15) * 8) = pw[i]; }
            }
            if (l + 1 < 32) ldl(l + 1);
            lds_barrier();
#pragma unroll
            for (int s = 0; s < 8; ++s)
                acc = MFMA32(ldsfrag(Ws + (jt * 32 + r32) * 136 + 16 * s + 8 * hh), ldsfrag(As + (ch * 32 + r32) * 136 + 16 * s + 8 * hh), acc);
        }
#pragma unroll
        for (int G = 0; G < 4; ++G) {
            const int j0 = jt * 32 + 8 * G + 4 * hh;
            float v[4];
#pragma unroll
            for (int j = 0; j < 4; ++j) v[j] = silu_f(acc[4 * G + j] + cb[kv * 128 + j0 + j]);
            u32x2 w; w.x = pk2(v[0], v[1]); w.y = pk2(v[2], v[3]);
            *(LAS u32x2*)(Hs + (ch * 32 + r32) * 136 + j0) = w;
        }
        lds_barrier();
#pragma unroll
        for (int i = 0; i < 4; ++i) {
            const int pc = tid + 512 * i, row = pc >> 4, cs = pc & 15;
            *(LAS u32x4*)(Ws + row * 136 + cs * 8) = *(const u32x4*)(W2T + (size_t)row * 128 + cs * 8);
        }
        lds_barrier();
        f32x16 a2 = zero16();
        if (kv == 0) {
#pragma unroll
            for (int s = 0; s < 8; ++s)
                a2 = MFMA32(ldsfrag(Ws + (jt * 32 + r32) * 136 + 16 * s + 8 * hh), ldsfrag(Hs + (ch * 32 + r32) * 136 + 16 * s + 8 * hh), a2);
            const int c = ct * 64 + ch * 32 + r32;
#pragma unroll
            for (int G = 0; G < 4; ++G) {
                u32x2 w; w.x = pk2(a2[4 * G], a2[4 * G + 1]); w.y = pk2(a2[4 * G + 2], a2[4 * G + 3]);
                *(u32x2*)(KC + ((size_t)bg * 1024 + c) * 128 + jt * 32 + 8 * G + 4 * hh) = w;
            }
            {
                float am = 0.f;
#pragma unroll
                for (int i = 0; i < 16; ++i) am = fmaxf(am, fabsf(a2[i]));
#pragma unroll
                for (int o = 32; o >= 1; o >>= 1) am = fmaxf(am, __shfl_xor(am, o));
                if (lane == 0) atomicMax((unsigned*)(ws + OFF_KINF) + bg, __float_as_uint(am * 1.01f));
            }
        } else {
#pragma unroll
            for (int s = 0; s < 8; ++s)
                a2 = MFMA32(ldsfrag(Hs + (ch * 32 + r32) * 136 + 16 * s + 8 * hh), ldsfrag(Ws + (jt * 32 + r32) * 136 + 16 * s + 8 * hh), a2);
            const int j2 = jt * 32 + r32;
#pragma unroll
            for (int G = 0; G < 4; ++G) {
                u32x2 w; w.x = pk2(a2[4 * G], a2[4 * G + 1]); w.y = pk2(a2[4 * G + 2], a2[4 * G + 3]);
                *(u32x2*)(VCT + ((size_t)(bg * 16 + ct) * 128 + j2) * 64 + ch * 32 + 8 * G + 4 * hh) = w;
            }
        }
        lds_barrier();
    }
    {
        const int half = tid >> 8, t8 = tid & 255, dgq = (t8 & 3) + 4 * (t8 >> 6), mg = (t8 >> 2) & 15;
        for (int u2 = blockIdx.x * 2 + half; u2 < 4096; u2 += gridDim.x * 2) {
            const int which = u2 >> 11, bg = (u2 >> 8) & 7, jb = u2 & 255, b = bg >> 2, g = bg & 3;
            const int col = (which ? C_VW : C_VS) + g * 128, kcol = (which ? C_KW : C_KS) + g * 128;
            bf16_t* vdst = (which ? VWT : VST) + (size_t)(bg * 256 + jb) * 8192;
            bf16_t* kdst = (which ? KW2 : KS2) + (size_t)(bg * 256 + jb) * 8192;
            const bf16_t* srow = P1 + ((size_t)b * S_ + jb * 64) * LD1;
            u32x4 R[4]; u32x2 o[8]; u32x4 kk[4];
#pragma unroll
            for (int rr = 0; rr < 4; ++rr) R[rr] = *(const u32x4*)(srow + (size_t)(4 * mg + rr) * LD1 + col + 8 * dgq);
#pragma unroll
            for (int i = 0; i < 4; ++i) { const int pc = t8 + 256 * i; kk[i] = *(const u32x4*)(srow + (size_t)(pc >> 4) * LD1 + kcol + (pc & 15) * 8); }
            tr4x8(R, o);
#pragma unroll
            for (int jj = 0; jj < 8; ++jj) *(u32x2*)(vdst + (8 * dgq + jj) * 64 + 4 * mg) = o[jj];
#pragma unroll
            for (int i = 0; i < 4; ++i) { const int pc = t8 + 256 * i; *(u32x4*)(kdst + pc * 8) = kk[i]; }
            if (which == 0) {
                float am = 0.f;
#pragma unroll
                for (int i = 0; i < 4; ++i)
#pragma unroll
                    for (int d = 0; d < 4; ++d) am = fmaxf(am, fmaxf(fabsf(bflo(kk[i][d])), fabsf(bfhi(kk[i][d]))));
#pragma unroll
                for (int o = 32; o >= 1; o >>= 1) am = fmaxf(am, __shfl_xor(am, o));
                if (lane == 0) atomicMax((unsigned*)(ws + OFF_KINF) + 8 + bg, __float_as_uint(am));
            }
        }
    }
}

DI float dpp_x1(float v) { return __int_as_float(__builtin_amdgcn_mov_dpp(__float_as_int(v), 0xB1, 0xF, 0xF, true)); }
DI float dpp_x2(float v) { return __int_as_float(__builtin_amdgcn_mov_dpp(__float_as_int(v), 0x4E, 0xF, 0xF, true)); }

DI void nsa_attn(const bf16_t* P1, const bf16_t* KC, const bf16_t* VCT, const bf16_t* VST, const bf16_t* VWT, const bf16_t* KS2, const bf16_t* KW2, const float* KINF, bf16_t* Y1, LAS unsigned char* lds) {
    const int tid = threadIdx.x, lane = tid & 63, wave = tid >> 6, r32 = lane & 31, hh = lane >> 5;
    constexpr int KB_E = 64 * 136, VP = 68, VB_E = 128 * VP;
    LAS bf16_t* Kb = (LAS bf16_t*)lds;
    LAS bf16_t* Vb = (LAS bf16_t*)(lds + 2 * KB_E * 2);
    LAS unsigned char* r1base = lds + 2 * KB_E * 2 + 2 * VB_E * 2;
    LAS float* imp = (LAS float*)r1base;
    LAS bf16_t* R1 = (LAS bf16_t*)r1base;
    LAS unsigned* selm = (LAS unsigned*)(r1base + 67584);
    LAS unsigned* uni = selm + 512;
    LAS int* jcount = (LAS int*)(uni + 8);
    LAS unsigned char* jlist = (LAS unsigned char*)(uni + 16);
    LAS int* kt0w = (LAS int*)(uni + 12);
    LAS int* jf0w = (LAS int*)(uni + 13);
    const int G_ = gridDim.x;
    for (int U = blockIdx.x; U < 2048; U += G_) {
        const int bg = U >> 8, qraw = U & 255, qidx = (gridDim.x == 256) ? ((qraw & 7) * 32 + (qraw >> 3)) : qraw, qb = (bg & 1) ? 255 - qidx : qidx, b = bg >> 2, g = bg & 3;
        const int q0 = qb * 64, tkl = r32 >> 2, r = r32 & 3, head = g * 4 + r, tl = 8 * wave + tkl, t = q0 + tl;
        const unsigned token = (unsigned)b * S_ + t;
        const float slope = 1.4426950408889634f * exp2f(-0.5f * (float)(head + 1));
        bf16x8 qf[8];
#pragma unroll
        for (int s = 0; s < 8; ++s) qf[s] = *(const bf16x8*)(P1 + token * LD1 + head * 128 + 16 * s + 8 * hh);
        float gsig[3];
#pragma unroll
        for (int br = 0; br < 3; ++br) gsig[br] = sigm_f(__uint_as_float((unsigned)P1[token * LD1 + C_G + head * 3 + br] << 16));
        if (tid < 8) uni[tid] = 0u;
        if (tid == 8) *kt0w = 1 << 20;
        if (tid == 9) *jf0w = 1 << 20;

        struct TileRegs { u32x4 k[2], v[2]; };
        TileRegs RA, RB;
        auto issue = [&](TileRegs& R, const bf16_t* ktile, const bf16_t* vtile, bool withv) {
            unsigned tq = tid; asm volatile("" : "+v"(tq));
#pragma unroll
            for (int i = 0; i < 2; ++i) R.k[i] = *(const u32x4*)(ktile + (tq + 512 * i) * 8u);
            if (withv) {
#pragma unroll
                for (int i = 0; i < 2; ++i) R.v[i] = *(const u32x4*)(vtile + (tq + 512 * i) * 8u);
            }
        };
        auto commit = [&](const TileRegs& R, int buf, bool withv) {
            int tq = tid; asm volatile("" : "+v"(tq));
#pragma unroll
            for (int i = 0; i < 2; ++i) { const int pc = tq + 512 * i; *(LAS u32x4*)(Kb + buf * KB_E + (pc >> 4) * 136 + (pc & 15) * 8) = R.k[i]; }
            if (withv) {
#pragma unroll
                for (int i = 0; i < 2; ++i) { const int pc = tq + 512 * i; LAS bf16_t* vq = Vb + buf * VB_E + (pc >> 3) * VP + (pc & 7) * 8; u32x2 lo_, hi_; lo_.x = R.v[i].x; lo_.y = R.v[i].y; hi_.x = R.v[i].z; hi_.y = R.v[i].w; *(LAS u32x2*)vq = lo_; *(LAS u32x2*)(vq + 4) = hi_; }
            }
        };
        auto compS = [&](int buf, f32x16 (&S)[2]) {
            int ro = r32 * 136 + 8 * hh; asm volatile("" : "+v"(ro));
            S[0] = zero16(); S[1] = zero16();
#pragma unroll
            for (int s = 0; s < 8; ++s) {
                S[0] = MFMA32(ldsfrag(Kb + buf * KB_E + ro + 16 * s), qf[s], S[0]);
                S[1] = MFMA32(ldsfrag(Kb + buf * KB_E + 32 * 136 + ro + 16 * s), qf[s], S[1]);
            }
        };
        auto compPV = [&](int buf, const f32x16 (&P)[2], f32x16 (&O)[4]) {
            int vo = r32 * VP + 4 * hh; asm volatile("" : "+v"(vo));
#pragma unroll
            for (int s2 = 0; s2 < 4; ++s2) {
                const int ct = s2 >> 1, sh = s2 & 1;
                u32x4 pw;
#pragma unroll
                for (int d = 0; d < 4; ++d) pw[d] = pk2(P[ct][8 * sh + 2 * d], P[ct][8 * sh + 2 * d + 1]);
                const bf16x8 pf = __builtin_bit_cast(bf16x8, pw);
#pragma unroll
                for (int dt = 0; dt < 4; ++dt) {
                    const LAS bf16_t* vp = Vb + buf * VB_E + dt * 32 * VP + vo + 16 * s2;
                    const s16x4 lo = *(const LAS s16x4*)vp, hi = *(const LAS s16x4*)(vp + 8);
                    const bf16x8 xf = __builtin_shufflevector(lo, hi, 0, 1, 2, 3, 4, 5, 6, 7);
                    O[dt] = MFMA32(xf, pf, O[dt]);
                }
            }
        };

#define KCONST(ct, i) ((float)(32 * (ct) + ((i) & 3) + 8 * ((i) >> 2)))
#define EX2(x) __builtin_amdgcn_exp2f(x)
        const int nkt = (4 * qb + 66) >> 6;
        const bf16_t* kcb = KC + (size_t)bg * 1024 * 128;
        const bf16_t* vcb = VCT + (size_t)bg * 16 * 8192;
        const float skc = 16.f * slope;
        float m1 = -1e30f, l1 = 0.f;
        int kt0;
        {
            float q1 = 0.f;
#pragma unroll
            for (int s = 0; s < 8; ++s)
#pragma unroll
                for (int e = 0; e < 8; ++e) q1 += fabsf(__uint_as_float(((unsigned)(unsigned short)qf[s][e]) << 16));
            q1 += __shfl_xor(q1, 32);
            const float reach = 15.f + (160.f + 2.f * q1 * KINF[bg]) / slope;
            const float xk = ((float)(t - 1039) - reach) * (1.f / 1024.f);
            int kf = xk > 0.f ? (int)ceilf(xk) : 0;
#pragma unroll
            for (int o = 32; o >= 1; o >>= 1) { const int ov = __shfl_xor(kf, o); kf = ov < kf ? ov : kf; }
            const float reach_s = (160.f + 2.f * q1 * KINF[8 + bg]) / slope;
            const float xj = ((float)(t - 63) - reach_s) * (1.f / 64.f);
            int jf = xj > 0.f ? (int)ceilf(xj) : 0;
#pragma unroll
            for (int o = 32; o >= 1; o >>= 1) { const int ov = __shfl_xor(jf, o); jf = ov < jf ? ov : jf; }
            lds_barrier();
            if (lane == 0) { atomicMin((int*)kt0w, kf); atomicMin((int*)jf0w, jf); }
            lds_barrier();
            kt0 = __builtin_amdgcn_readfirstlane(*kt0w);
            kt0 = kt0 < nkt - 1 ? kt0 : nkt - 1;
            for (int tk = 0; tk < 8; ++tk)
                for (int cq = lane; cq < 16 * kt0; cq += 64) imp[(wave * 8 + tk) * 257 + cq] = 0.f;
        }
        lds_barrier();
        issue(RA, kcb + (size_t)kt0 * 8192, vcb, false);
        if (kt0 + 1 < nkt) issue(RB, kcb + (size_t)(kt0 + 1) * 8192, vcb, false);
        auto step1 = [&](int kt, TileRegs& R) {
            const int buf = kt & 1;
            commit(R, buf, false);
            if (kt + 2 < nkt) issue(R, kcb + (size_t)(kt + 2) * 8192, vcb, false);
            lds_barrier();
            f32x16 S[2]; compS(buf, S);
            const bool fast = (1024 * kt + 1039 <= q0);
            float rb = -slope * (float)(t - 31 - 1024 * kt) + skc * (float)(4 * hh); asm volatile("" : "+v"(rb));
            float mt = -1e30f;
#pragma unroll
            for (int ct = 0; ct < 2; ++ct)
#pragma unroll
                for (int i = 0; i < 16; ++i) S[ct][i] = fmaf(skc, KCONST(ct, i), S[ct][i]);
            if (!fast) {
                int d0 = t - 31 - 1024 * kt - 64 * hh; asm volatile("" : "+v"(d0));
#pragma unroll
                for (int ct = 0; ct < 2; ++ct)
#pragma unroll
                    for (int i = 0; i < 16; ++i) { const int dist = d0 - 16 * (32 * ct + (i & 3) + 8 * (i >> 2)); S[ct][i] = dist >= 0 ? S[ct][i] : -1e30f; }
            }
#pragma unroll
            for (int ct = 0; ct < 2; ++ct)
#pragma unroll
                for (int i = 0; i < 16; ++i) mt = fmaxf(mt, S[ct][i]);
            mt += rb;
            const float mn = fmaxf(m1, mt), off = mn - rb;
            float ls = 0.f;
            if (fast) {
#pragma unroll
                for (int ct = 0; ct < 2; ++ct)
#pragma unroll
                    for (int i = 0; i < 16; ++i) ls += EX2(S[ct][i] - off);
            } else {
#pragma unroll
                for (int ct = 0; ct < 2; ++ct)
#pragma unroll
                    for (int i = 0; i < 16; ++i) ls += S[ct][i] > -1e29f ? EX2(S[ct][i] - off) : 0.f;
            }
            l1 = l1 * EX2(m1 - mn) + ls; m1 = mn;
        };
        for (int kt = kt0; kt < nkt; kt += 2) { step1(kt, RA); if (kt + 1 < nkt) step1(kt + 1, RB); }
        float Mx, lgi;
        {
            const float mo = __shfl_xor(m1, 32), lo = __shfl_xor(l1, 32);
            Mx = fmaxf(m1, mo);
            const float L = l1 * EX2(m1 - Mx) + lo * EX2(mo - Mx);
            lgi = L > 0.f ? -__log2f(L) : -1e30f;
        }
        f32x16 O[4];
#pragma unroll
        for (int dt = 0; dt < 4; ++dt) O[dt] = zero16();
        float carry = 0.f;
        LAS float* impw = imp + (wave * 8 + tkl) * 257;
        lds_barrier();
        issue(RA, kcb + (size_t)kt0 * 8192, vcb + (size_t)kt0 * 8192, true);
        if (kt0 + 1 < nkt) issue(RB, kcb + (size_t)(kt0 + 1) * 8192, vcb + (size_t)(kt0 + 1) * 8192, true);
        auto step2 = [&](int kt, TileRegs& R) {
            const int buf = kt & 1;
            commit(R, buf, true);
            if (kt + 2 < nkt) issue(R, kcb + (size_t)(kt + 2) * 8192, vcb + (size_t)(kt + 2) * 8192, true);
            lds_barrier();
            f32x16 S[2]; compS(buf, S);
            const bool fast = (1024 * kt + 1039 <= q0);
            float rb = -slope * (float)(t - 31 - 1024 * kt) + skc * (float)(4 * hh); asm volatile("" : "+v"(rb));
            const float off = (Mx - rb) - lgi;
            if (fast) {
#pragma unroll
                for (int ct = 0; ct < 2; ++ct)
#pragma unroll
                    for (int i = 0; i < 16; ++i) S[ct][i] = EX2(fmaf(skc, KCONST(ct, i), S[ct][i]) - off);
            } else {
                int d0 = t - 31 - 1024 * kt - 64 * hh; asm volatile("" : "+v"(d0));
#pragma unroll
                for (int ct = 0; ct < 2; ++ct)
#pragma unroll
                    for (int i = 0; i < 16; ++i) {
                        const int dist = d0 - 16 * (32 * ct + (i & 3) + 8 * (i >> 2));
                        S[ct][i] = dist >= 0 ? EX2(fmaf(skc, KCONST(ct, i), S[ct][i]) - off) : 0.f;
                    }
            }
            float X[2][4];
#pragma unroll
            for (int ct = 0; ct < 2; ++ct)
#pragma unroll
                for (int G = 0; G < 4; ++G) X[ct][G] = __shfl_xor(S[ct][4 * G + 3], 32);
#pragma unroll
            for (int ct = 0; ct < 2; ++ct)
#pragma unroll
                for (int G = 0; G < 4; ++G) {
                    const float prev0 = G > 0 ? X[ct][G - 1] : (ct > 0 ? X[0][3] : carry);
                    const float prev = hh ? X[ct][G] : prev0;
                    float tot = S[ct][4 * G] + S[ct][4 * G + 1] + S[ct][4 * G + 2] + S[ct][4 * G + 3] + prev;
                    tot += dpp_x1(tot); tot += dpp_x2(tot);
                    const int cq = 16 * kt + 8 * ct + 2 * G + hh;
                    if (r == 0) impw[cq] = tot;
                }
            carry = X[1][3];
            compPV(buf, S, O);
        };
        for (int kt = kt0; kt < nkt; kt += 2) { step2(kt, RA); if (kt + 1 < nkt) step2(kt + 1, RB); }
        {
            const int cur = qb, nsel = cur + 1 < 16 ? cur + 1 : 16;
#pragma unroll 1
            for (int tk = 0; tk < 8; ++tk) {
                const LAS float* iw = imp + (wave * 8 + tk) * 257;
                unsigned key[4];
#pragma unroll
                for (int uu = 0; uu < 4; ++uu) {
                    const int j = lane + 64 * uu;
                    const bool forced = (j == 0 || j == cur || j == cur - 1);
                    const unsigned bits = forced ? 0x461C4000u   : __float_as_uint(iw[j < 256 ? j : 255]);
                    key[uu] = j <= cur ? ((bits & 0xFFFFFF00u) | (unsigned)(255 - j)) : 0u;
                }
                unsigned thr = 0u;
#pragma unroll 1
                for (int bit = 30; bit >= 0; --bit) {
                    const unsigned cand = thr | (1u << bit);
                    const int cnt = __popcll(__ballot(key[0] >= cand)) + __popcll(__ballot(key[1] >= cand)) + __popcll(__ballot(key[2] >= cand)) + __popcll(__ballot(key[3] >= cand));
                    thr = cnt >= nsel ? cand : thr;
                }
                unsigned word = 0u;
#pragma unroll
                for (int uu = 0; uu < 4; ++uu) {
                    const unsigned long long m = __ballot(key[uu] >= thr);
                    if (lane == 2 * uu) word = (unsigned)m;
                    if (lane == 2 * uu + 1) word = (unsigned)(m >> 32);
                }
                if (lane < 8) { selm[(wave * 8 + tk) * 8 + lane] = word; if (word) atomicOr((unsigned*)(uni + lane), word); }
            }
        }
        lds_barrier();
        {
            LAS bf16_t* rp = R1 + (wave * 32 + r32) * 132;
#pragma unroll
            for (int dt = 0; dt < 4; ++dt)
#pragma unroll
                for (int G = 0; G < 4; ++G) {
                    u32x2 w; w.x = pk2(O[dt][4 * G] * gsig[0], O[dt][4 * G + 1] * gsig[0]); w.y = pk2(O[dt][4 * G + 2] * gsig[0], O[dt][4 * G + 3] * gsig[0]);
                    *(LAS u32x2*)(rp + dt * 32 + 8 * G + 4 * hh) = w;
                }
            if (wave == 0) {
                const int jf0 = *jf0w;
                int n = 0;
#pragma unroll
                for (int u4 = 3; u4 >= 0; --u4) {
                    const int j = lane + 64 * u4;
                    const bool sel = ((uni[2 * u4 + (lane >> 5)] >> (lane & 31)) & 1u) && j >= jf0;
                    const unsigned long long m = __ballot(sel);
                    const unsigned long long above = lane == 63 ? 0ull : (m >> (lane + 1));
                    if (sel) jlist[n + __popcll(above)] = (unsigned char)j;
                    n += __popcll(m);
                }
                if (lane == 0) *jcount = n;
            }
        }
        lds_barrier();
        float mr, lr;
        auto flash_tile = [&](int buf, int kbase, bool rowsel, int wlim, bool fast) {
            f32x16 S[2]; compS(buf, S);
            float rb = -slope * (float)(t - kbase) + slope * (float)(4 * hh); asm volatile("" : "+v"(rb));
#pragma unroll
            for (int ct = 0; ct < 2; ++ct)
#pragma unroll
                for (int i = 0; i < 16; ++i) S[ct][i] = fmaf(slope, KCONST(ct, i), S[ct][i]);
            if (!fast) {
                int d0 = t - kbase - 4 * hh; asm volatile("" : "+v"(d0));
#pragma unroll
                for (int ct = 0; ct < 2; ++ct)
#pragma unroll
                    for (int i = 0; i < 16; ++i) {
                        const int dist = d0 - (32 * ct + (i & 3) + 8 * (i >> 2));
                        S[ct][i] = (rowsel && dist >= 0 && dist < wlim) ? S[ct][i] : -1e30f;
                    }
            }
            float mt = -1e30f;
#pragma unroll
            for (int ct = 0; ct < 2; ++ct)
#pragma unroll
                for (int i = 0; i < 16; ++i) mt = fmaxf(mt, S[ct][i]);
            mt += rb;
            mt = fmaxf(mt, __shfl_xor(mt, 32));
            const float mn = fmaxf(mr, mt);
            if (__any(mn > mr)) {
                const float alpha = EX2(mr - mn);
                lr *= alpha;
#pragma unroll
                for (int dt = 0; dt < 4; ++dt) O[dt] = O[dt] * alpha;
            }
            mr = mn;
            const float off = mn - rb;
            float ls = 0.f;
#pragma unroll
            for (int ct = 0; ct < 2; ++ct)
#pragma unroll
                for (int i = 0; i < 16; ++i) { const float pe = EX2(S[ct][i] - off); S[ct][i] = pe; ls += pe; }
            lr += ls;
            compPV(buf, S, O);
        };
        {
            const int nj = __builtin_amdgcn_readfirstlane(*jcount);
            mr = -1e30f; lr = 0.f;
#pragma unroll
            for (int dt = 0; dt < 4; ++dt) O[dt] = zero16();
            const bf16_t* ksb = KS2 + (size_t)bg * 256 * 8192;
            const bf16_t* vsb = VST + (size_t)bg * 256 * 8192;
            auto jat = [&](int i) { return __builtin_amdgcn_readfirstlane((int)jlist[i]); };
            { const int j = jat(0); issue(RA, ksb + (size_t)j * 8192, vsb + (size_t)j * 8192, true); }
            if (nj > 1) { const int j = jat(1); issue(RB, ksb + (size_t)j * 8192, vsb + (size_t)j * 8192, true); }
            auto step3 = [&](int i, TileRegs& R) {
                const int buf = i & 1, j = jat(i);
                commit(R, buf, true);
                if (i + 2 < nj) { const int jn = jat(i + 2); issue(R, ksb + (size_t)jn * 8192, vsb + (size_t)jn * 8192, true); }
                lds_barrier();
                const bool rowsel = (selm[tl * 8 + (j >> 5)] >> (j & 31)) & 1u;
                if (__any(rowsel)) flash_tile(buf, 64 * j, rowsel, 1 << 30, j < qb && __all(rowsel));
            };
            for (int i = 0; i < nj; i += 2) { step3(i, RA); if (i + 1 < nj) step3(i + 1, RB); }
            const float lt = lr + __shfl_xor(lr, 32), inv = gsig[1] / lt;
            LAS bf16_t* rp = R1 + (wave * 32 + r32) * 132;
#pragma unroll
            for (int dt = 0; dt < 4; ++dt)
#pragma unroll
                for (int G = 0; G < 4; ++G) {
                    LAS u32x2* q = (LAS u32x2*)(rp + dt * 32 + 8 * G + 4 * hh);
                    const u32x2 old = *q; u32x2 w;
                    w.x = pk2(bflo(old.x) + O[dt][4 * G] * inv, bfhi(old.x) + O[dt][4 * G + 1] * inv);
                    w.y = pk2(bflo(old.y) + O[dt][4 * G + 2] * inv, bfhi(old.y) + O[dt][4 * G + 3] * inv);
                    *q = w;
                }
        }
        {
            mr = -1e30f; lr = 0.f;
#pragma unroll
            for (int dt = 0; dt < 4; ++dt) O[dt] = zero16();
            const bf16_t* kwb = KW2 + (size_t)bg * 256 * 8192;
            const bf16_t* vwb = VWT + (size_t)bg * 256 * 8192;
            const int j0 = qb - 8 > 0 ? qb - 8 : 0, nj = qb - j0 + 1;
            lds_barrier();
            issue(RA, kwb + (size_t)qb * 8192, vwb + (size_t)qb * 8192, true);
            if (nj > 1) issue(RB, kwb + (size_t)(qb - 1) * 8192, vwb + (size_t)(qb - 1) * 8192, true);
            auto step4 = [&](int i, TileRegs& R) {
                const int buf = i & 1, j = qb - i;
                commit(R, buf, true);
                if (i + 2 < nj) issue(R, kwb + (size_t)(j - 2) * 8192, vwb + (size_t)(j - 2) * 8192, true);
                lds_barrier();
                flash_tile(buf, 64 * j, true, 512, j < qb && j > qb - 8);
            };
            for (int i = 0; i < nj; i += 2) { step4(i, RA); if (i + 1 < nj) step4(i + 1, RB); }
            const float lt = lr + __shfl_xor(lr, 32), inv = gsig[2] / lt;
            const LAS bf16_t* rp = R1 + (wave * 32 + r32) * 132;
#pragma unroll
            for (int dt = 0; dt < 4; ++dt)
#pragma unroll
                for (int G = 0; G < 4; ++G) {
                    const int d0 = dt * 32 + 8 * G + 4 * hh;
                    const u32x2 old = *(const LAS u32x2*)(rp + d0);
                    const u32x2 zz = *(const u32x2*)(P1 + token * LD1 + C_Z + head * 128 + d0);
                    u32x2 w;
                    w.x = pk2(silu_f(bflo(zz.x)) * (bflo(old.x) + O[dt][4 * G] * inv), silu_f(bfhi(zz.x)) * (bfhi(old.x) + O[dt][4 * G + 1] * inv));
                    w.y = pk2(silu_f(bflo(zz.y)) * (bflo(old.y) + O[dt][4 * G + 2] * inv), silu_f(bfhi(zz.y)) * (bfhi(old.y) + O[dt][4 * G + 3] * inv));
                    *(u32x2*)(Y1 + token * DM + head * 128 + d0) = w;
                }
        }
        lds_barrier();
    }
}

DI void final_norm(float* out, const float* fg) {
    const int lane = threadIdx.x & 63, wave = threadIdx.x >> 6;
    const int nw = gridDim.x * 8, gw = blockIdx.x * 8 + wave;
    for (int row0 = gw * 2; row0 < T_; row0 += nw * 2) {
        f32x4 v[2][8]; float ss[2] = {0.f, 0.f};
#pragma unroll
        for (int q = 0; q < 2; ++q) {
            const f32x4* xr = (const f32x4*)(out + (size_t)(row0 + q) * DM);
#pragma unroll
            for (int i = 0; i < 8; ++i) v[q][i] = xr[lane + 64 * i];
        }
#pragma unroll
        for (int q = 0; q < 2; ++q)
#pragma unroll
            for (int i = 0; i < 8; ++i) ss[q] += v[q][i][0] * v[q][i][0] + v[q][i][1] * v[q][i][1] + v[q][i][2] * v[q][i][2] + v[q][i][3] * v[q][i][3];
        ss[0] = wave_sum(ss[0]); ss[1] = wave_sum(ss[1]);
#pragma unroll
        for (int q = 0; q < 2; ++q) {
            const float rs = rsqrtf(ss[q] * (1.f / 2048.f) + 1e-6f);
            f32x4* xr = (f32x4*)(out + (size_t)(row0 + q) * DM);
#pragma unroll
            for (int i = 0; i < 8; ++i) { const f32x4 gq = ((const f32x4*)fg)[lane + 64 * i]; xr[lane + 64 * i] = v[q][i] * rs * gq; }
        }
    }
}

#define XB_TMO      128
#define XB_XCNT(j)  (256  + 64 * (j))
#define XB_XSUB(j)  (1280 + 64 * (j))
#define XB_XGEN(j)  (2304 + 64 * (j))
#define XB_TOP      3328
#define XB_TOPGEN   3392
#define XCD_BAR_WORDS 3456
#define XB_SPIN_CAP (1u << 20)
DI unsigned xb_ld(unsigned* p) { return __hip_atomic_load(p, __ATOMIC_RELAXED, __HIP_MEMORY_SCOPE_AGENT); }
DI unsigned xb_add(unsigned* p, unsigned v) { return __hip_atomic_fetch_add(p, v, __ATOMIC_RELAXED, __HIP_MEMORY_SCOPE_AGENT); }
DI unsigned xb_xcc_id() { return (unsigned)__builtin_amdgcn_s_getreg((3 << 11) | 20) & 0xFu; }
#define XB_SPIN(cond, bar) do { unsigned _sp = 0; while (cond) { __builtin_amdgcn_s_sleep(1); \
    if ((++_sp & 255u) == 0u) { if (xb_ld(&(bar)[XB_TMO])) break; if (_sp > XB_SPIN_CAP) { atomicAdd(&(bar)[XB_TMO], 1u); break; } } } } while (0)
struct XcdBarrier { unsigned* bar; unsigned x; volatile LAS unsigned* st; };
DI XcdBarrier xcd_barrier_post(unsigned* bar, volatile LAS unsigned* st) {
    XcdBarrier b; b.bar = bar; b.x = xb_xcc_id(); b.st = st;
    if (threadIdx.x == 0) (void)xb_add(&bar[XB_XCNT(b.x)], 1u);
    return b;
}
DI void xcd_barrier_complete(unsigned* bar, unsigned x, unsigned& nloc, unsigned& nx) {
    const unsigned G = gridDim.x * gridDim.y * gridDim.z;
    unsigned sum, cnt, mine, sp = 0u;
    for (;;) {
        sum = 0u; cnt = 0u; mine = 0u;
#pragma unroll
        for (unsigned j = 0; j < 16; ++j) { const unsigned c = xb_ld(&bar[XB_XCNT(j)]); sum += c; cnt += (c > 0u) ? 1u : 0u; mine = (j == x) ? c : mine; }
        if (sum == G) break;
        __builtin_amdgcn_s_sleep(1);
        if ((++sp & 255u) == 0u) { if (xb_ld(&bar[XB_TMO])) break; if (sp > XB_SPIN_CAP) { atomicAdd(&bar[XB_TMO], 1u); break; } }
    }
    nloc = mine > 0u ? mine : 1u; nx = cnt > 0u ? cnt : 1u;
}
DI void xcd_barrier(const XcdBarrier& b) {
    asm volatile("s_waitcnt vmcnt(0)" ::: "memory");
    __syncthreads();
    if (threadIdx.x == 0) {
        unsigned* bar = b.bar;
        __builtin_amdgcn_s_waitcnt(0);
        unsigned nloc = b.st[0], nx = b.st[1];
        if (nloc == 0u) { xcd_barrier_complete(bar, b.x, nloc, nx); b.st[0] = nloc; b.st[1] = nx; }
        const unsigned old = xb_add(&bar[XB_XSUB(b.x)], 1u);
        const unsigned gen = old / nloc;
        if (old + 1u == (gen + 1u) * nloc) {
            __builtin_amdgcn_fence(__ATOMIC_RELEASE, "agent");
            asm volatile("s_waitcnt vmcnt(0)" ::: "memory");
            const unsigned og = xb_add(&bar[XB_TOP], 1u);
            const unsigned tg = og / nx;
            if (og + 1u == (tg + 1u) * nx) xb_add(&bar[XB_TOPGEN], 1u);
            else XB_SPIN(xb_ld(&bar[XB_TOPGEN]) == tg, bar);
            __builtin_amdgcn_fence(__ATOMIC_ACQUIRE, "agent");
            xb_add(&bar[XB_XGEN(b.x)], 1u);
            asm volatile("s_waitcnt vmcnt(0)" ::: "memory");
        } else {
            XB_SPIN(xb_ld(&bar[XB_XGEN(b.x)]) == gen, bar);
            __builtin_amdgcn_fence(__ATOMIC_ACQUIRE, "agent");
            asm volatile("s_waitcnt vmcnt(0)" ::: "memory");
        }
    }
    __syncthreads();
}

constexpr int NPHASE = 11;
__global__ void __launch_bounds__(NTHREADS, 2) fwd_kernel(Params p) {
    extern __shared__ __attribute__((aligned(16))) unsigned char lds_raw[];
    LAS unsigned char* lds = (LAS unsigned char*)lds_raw;
    unsigned char* ws = p.ws;
    bf16_t* PROJ = (bf16_t*)(ws + OFF_PROJ);
    bf16_t* XB = (bf16_t*)(ws + OFF_XB);
    const int lo = p.ph_lo, hi = p.ph_hi;
#ifndef PHMASK
#define PHMASK 0x7ff
#endif
#define IN(k) (((PHMASK >> (k)) & 1) && lo <= (k) && (k) < hi)
    volatile LAS unsigned* xst = (volatile LAS unsigned*)(lds + LDS_BYTES - 16);
    XcdBarrier xbar; xbar.bar = (unsigned*)(ws + OFF_BAR); xbar.x = 0; xbar.st = xst;
    if (hi - lo > 1) {
        if (threadIdx.x < 2) xst[threadIdx.x] = 0u;
        __syncthreads();
        xbar = xcd_barrier_post((unsigned*)(ws + OFF_BAR), xst);
    }
#define SEAM(k) do { if ((k) + 1 < hi) { if (hi > 1000) cg::this_grid().sync();   xcd_barrier(xbar); } } while (0)
#ifndef REPMASK
#define REPMASK 0
#endif
#define REP(k) ((REPMASK >> (k)) & 1)
#define GS() cg::this_grid().sync()
    if (IN(0)) { if (REP(0)) { phase0(p, lds); GS(); } phase0(p, lds); SEAM(0); }
    if (IN(1)) {
        pg8::Gemm g{XB, (const bf16_t*)(ws + OFF_W1T), 2048, 2048, T_, 12288, 2048}; pg8::StaticOrder S; S.init(T_, 12288, gridDim.x, blockIdx.x);
        pg8::EpiScaleBf16<2> E{PROJ, LD0, nullptr};
        if (REP(1)) { pg8::gemm_phase(lds, g, S, E); GS(); }
        pg8::gemm_phase(lds, g, S, E); SEAM(1);
    }
    if (IN(2)) { if (REP(2)) { ret_intra(PROJ, (bf16_t*)p.out, XB, lds); GS(); } ret_intra(PROJ, (bf16_t*)p.out, XB, lds); SEAM(2); }
    if (IN(3)) { for (int rep = REP(3) ? 0 : 1; rep < 2; ++rep) { ret_inter(PROJ, (const bf16_t*)p.out, XB, lds, rep == 0); if (rep == 0) GS(); } SEAM(3); }
    if (IN(4)) { if (REP(4)) { ret_gate(PROJ, XB); GS(); } ret_gate(PROJ); SEAM(4); }
    if (IN(5)) {
        pg8::Gemm g{PROJ + 8192, (const bf16_t*)(ws + OFF_W2T), LD0, 4096, T_, 2048, 4096}; pg8::StaticOrder S; S.init(T_, 2048, gridDim.x, blockIdx.x);
        if (REP(5)) { pg8::EpiResid E0{p.x, p.out, XB, nullptr}; pg8::gemm_phase(lds, g, S, E0); GS(); }
        pg8::EpiResid E{p.x, p.out, XB, (float*)(ws + OFF_SS1)};
        pg8::gemm_phase(lds, g, S, E); SEAM(5);
    }
    if (IN(6)) {
        pg8::Gemm g{XB, (const bf16_t*)(ws + OFF_W3T), 2048, 2048, T_, LD1, 2048}; pg8::StaticOrder S; S.init(T_, LD1, gridDim.x, blockIdx.x);
        pg8::EpiScaleBf16<1> E{PROJ, LD1, (const float*)(ws + OFF_SS1)};
        if (REP(6)) { pg8::gemm_phase(lds, g, S, E); GS(); }
        pg8::gemm_phase(lds, g, S, E); SEAM(6);
    }
    if (IN(7)) {
        if (REP(7)) { nsa_compress(PROJ, ws, (bf16_t*)(ws + OFF_KC), (bf16_t*)(ws + OFF_VCT), (bf16_t*)(ws + OFF_VST), (bf16_t*)(ws + OFF_VWT), (bf16_t*)(ws + OFF_KS2), (bf16_t*)(ws + OFF_KW2), lds); GS(); }
        nsa_compress(PROJ, ws, (bf16_t*)(ws + OFF_KC), (bf16_t*)(ws + OFF_VCT), (bf16_t*)(ws + OFF_VST), (bf16_t*)(ws + OFF_VWT), (bf16_t*)(ws + OFF_KS2), (bf16_t*)(ws + OFF_KW2), lds); SEAM(7); }
    if (IN(8)) {
        if (REP(8)) { nsa_attn(PROJ, (const bf16_t*)(ws + OFF_KC), (const bf16_t*)(ws + OFF_VCT), (const bf16_t*)(ws + OFF_VST), (const bf16_t*)(ws + OFF_VWT), (const bf16_t*)(ws + OFF_KS2), (const bf16_t*)(ws + OFF_KW2), (const float*)(ws + OFF_KINF), XB, lds); GS(); }
        nsa_attn(PROJ, (const bf16_t*)(ws + OFF_KC), (const bf16_t*)(ws + OFF_VCT), (const bf16_t*)(ws + OFF_VST), (const bf16_t*)(ws + OFF_VWT), (const bf16_t*)(ws + OFF_KS2), (const bf16_t*)(ws + OFF_KW2), (const float*)(ws + OFF_KINF), XB, lds); SEAM(8); }
    if (IN(9)) {
        pg8::Gemm g{XB, (const bf16_t*)(ws + OFF_W4T), 2048, 2048, T_, 2048, 2048}; pg8::StaticOrder S; S.init(T_, 2048, gridDim.x, blockIdx.x);
        if (REP(9)) { pg8::EpiResid E0{p.out, (float*)PROJ, nullptr, nullptr}; pg8::gemm_phase(lds, g, S, E0); GS(); }
        pg8::EpiResid E{p.out, p.out, nullptr, nullptr};
        pg8::gemm_phase(lds, g, S, E); SEAM(9);
    }
    if (IN(10)) { final_norm(p.out, p.final_g); }
#undef IN
#undef SEAM
}

extern "C" void kernel_launch(void* const* d_in, const int* in_sizes, int n_in, void* d_out, int out_size, void* d_ws, size_t ws_size, hipStream_t stream) {
    static int grid = 0;
    if (grid == 0) {
        if (n_in != 13 || out_size != T_ * DM || ws_size < WS_END) { fprintf(stderr, "kernel_launch: unexpected shapes (n_in %d out %d ws %zu need %zu)\n", n_in, out_size, ws_size, (size_t)WS_END); grid = -1; return; }
        int dev = 0, cus = 0, per_cu = 0;
        hipGetDevice(&dev); hipDeviceGetAttribute(&cus, hipDeviceAttributeMultiprocessorCount, dev);
        if (hipFuncSetAttribute((const void*)fwd_kernel, hipFuncAttributeMaxDynamicSharedMemorySize, LDS_BYTES) != hipSuccess) { fprintf(stderr, "kernel_launch: hipFuncSetAttribute failed\n"); grid = -1; return; }
        hipOccupancyMaxActiveBlocksPerMultiprocessor(&per_cu, (const void*)fwd_kernel, NTHREADS, LDS_BYTES);
        (void)hipGetLastError();
        if (per_cu < 1) per_cu = 1;
        grid = cus * 1;
    }
    if (grid < 0) return;
    Params p{};
    p.x = (const float*)d_in[0]; p.norm_g = (const float*)d_in[1]; p.ret_w_in = (const float*)d_in[2]; p.ret_w_out = (const float*)d_in[3];
    p.nsa_w_in = (const float*)d_in[4]; p.pos_k = (const float*)d_in[5]; p.w1_k = (const float*)d_in[6]; p.w2_k = (const float*)d_in[7];
    p.pos_v = (const float*)d_in[8]; p.w1_v = (const float*)d_in[9]; p.w2_v = (const float*)d_in[10]; p.nsa_w_out = (const float*)d_in[11];
    p.final_g = (const float*)d_in[12]; p.out = (float*)d_out; p.ws = (unsigned char*)d_ws;
#if SINGLE_LAUNCH
    hipMemsetAsync((char*)d_ws + OFF_BAR, 0, 16384, stream);
    p.ph_lo = 0; p.ph_hi = NPHASE;
    void* args[] = {&p};
    hipError_t e = hipLaunchCooperativeKernel((const void*)fwd_kernel, dim3(grid), dim3(NTHREADS), args, LDS_BYTES, stream);
    if (e != hipSuccess) fprintf(stderr, "cooperative launch failed: %s (grid %d)\n", hipGetErrorString(e), grid);
#else
    for (int k = 0; k < NPHASE; ++k) {
        p.ph_lo = k; p.ph_hi = k + 1;
        hipLaunchKernelGGL(fwd_kernel, dim3(grid), dim3(NTHREADS), LDS_BYTES, stream, p);
    }
#endif
}
```

```cpp
#include <hip/hip_runtime.h>
#include <hip/hip_cooperative_groups.h>
#include <cstdio>
namespace cg = cooperative_groups;

#ifndef SINGLE_LAUNCH
#define SINGLE_LAUNCH 1
#endif

#define DI __device__ __forceinline__
#define LAS __attribute__((address_space(3)))
typedef unsigned short bf16_t;
typedef short bf16x8 __attribute__((ext_vector_type(8)));
typedef short s16x4 __attribute__((ext_vector_type(4)));
typedef float f32x4 __attribute__((ext_vector_type(4)));
typedef float f32x16 __attribute__((ext_vector_type(16)));
typedef unsigned u32x4 __attribute__((ext_vector_type(4)));
typedef unsigned u32x2 __attribute__((ext_vector_type(2)));
typedef __bf16 bf2_t __attribute__((ext_vector_type(2)));

constexpr int T_ = 32768, S_ = 16384, DM = 2048;
constexpr int LD0 = 12288;
constexpr int LD1 = 7424;
constexpr int C_KC = 2048, C_VC = 2560, C_KS = 3072, C_VS = 3584, C_KW = 4096, C_VW = 4608, C_Z = 5120, C_G = 7168;
constexpr int NTHREADS = 512;
constexpr int LDS_BYTES = 160 * 1024;

constexpr size_t OFF_W1T = 0;
constexpr size_t OFF_W2T = OFF_W1T + (size_t)12288 * 2048 * 2;
constexpr size_t OFF_W3T = OFF_W2T + (size_t)2048 * 4096 * 2;
constexpr size_t OFF_W4T = OFF_W3T + (size_t)LD1 * 2048 * 2;
constexpr size_t OFF_CW1K = OFF_W4T + (size_t)2048 * 2048 * 2;
constexpr size_t OFF_CW1V = OFF_CW1K + (size_t)128 * 4096 * 2;
constexpr size_t OFF_CW2K = OFF_CW1V + (size_t)128 * 4096 * 2;
constexpr size_t OFF_CW2V = OFF_CW2K + (size_t)128 * 128 * 2;
constexpr size_t OFF_CB = OFF_CW2V + (size_t)128 * 128 * 2;
constexpr size_t OFF_RSTD0 = OFF_CB + 1024;
constexpr size_t OFF_SS1 = OFF_RSTD0 + (size_t)T_ * 4;
constexpr size_t OFF_KC = OFF_SS1 + (size_t)T_ * 4;
constexpr size_t OFF_VCT = OFF_KC + (size_t)8 * 1024 * 128 * 2;
constexpr size_t OFF_XB = OFF_VCT + (size_t)8 * 1024 * 128 * 2;
constexpr size_t OFF_PROJ = OFF_XB + (size_t)T_ * 2048 * 2;
constexpr size_t OFF_VST = OFF_PROJ + (size_t)T_ * LD1 * 2;
constexpr size_t OFF_VWT = OFF_VST + (size_t)8 * 128 * S_ * 2;
constexpr size_t OFF_KS2 = OFF_VWT + (size_t)8 * 128 * S_ * 2;
constexpr size_t OFF_KW2 = OFF_KS2 + (size_t)8 * 128 * S_ * 2;
constexpr size_t OFF_BAR = OFF_PROJ + (size_t)T_ * LD0 * 2;
constexpr size_t OFF_CBZ = OFF_BAR + 14336;
constexpr size_t OFF_KINF = OFF_BAR + 15360;
constexpr size_t WS_END = OFF_BAR + 16384;
static_assert(OFF_KW2 + (size_t)8 * 128 * S_ * 2 <= WS_END, "ws map");

struct Params {
    const float* x; const float* norm_g; const float* ret_w_in; const float* ret_w_out; const float* nsa_w_in;
    const float* pos_k; const float* w1_k; const float* w2_k; const float* pos_v; const float* w1_v; const float* w2_v;
    const float* nsa_w_out; const float* final_g; float* out; unsigned char* ws; int ph_lo, ph_hi;
};

DI unsigned pk2(float lo, float hi) { bf2_t v; v.x = (__bf16)lo; v.y = (__bf16)hi; return __builtin_bit_cast(unsigned, v); }
DI float bflo(unsigned u) { return __uint_as_float(u << 16); }
DI float bfhi(unsigned u) { return __uint_as_float(u & 0xffff0000u); }
#define DPPF(v, ctrl) __int_as_float(__builtin_amdgcn_mov_dpp(__float_as_int(v), (ctrl), 0xF, 0xF, true))
DI float wave_sum(float v) {
    v += DPPF(v, 0xB1);
    v += DPPF(v, 0x4E);
    v += DPPF(v, 0x141);
    v += DPPF(v, 0x140);
    return (__int_as_float(__builtin_amdgcn_readlane(__float_as_int(v), 0)) + __int_as_float(__builtin_amdgcn_readlane(__float_as_int(v), 16))) +
           (__int_as_float(__builtin_amdgcn_readlane(__float_as_int(v), 32)) + __int_as_float(__builtin_amdgcn_readlane(__float_as_int(v), 48)));
}
DI void lds_barrier() { asm volatile("s_waitcnt lgkmcnt(0)\n\ts_barrier" ::: "memory"); }
DI float silu_f(float x) { return x / (1.f + __expf(-x)); }
DI float sigm_f(float x) { return 1.f / (1.f + __expf(-x)); }
DI int crow(int i, int hh) { return (i & 3) + 8 * (i >> 2) + 4 * hh; }
#define MFMA32(a, b, c) __builtin_amdgcn_mfma_f32_32x32x16_bf16((a), (b), (c), 0, 0, 0)
DI f32x16 zero16() { f32x16 z; for (int i = 0; i < 16; ++i) z[i] = 0.f; return z; }
DI bf16x8 ldsfrag(const LAS bf16_t* p) { return *(const LAS bf16x8*)p; }
DI void tr4x8(const u32x4 (&R)[4], u32x2 (&o)[8]) {
#pragma unroll
    for (int d = 0; d < 4; ++d) {
        const unsigned a0 = R[0][d], a1 = R[1][d], a2 = R[2][d], a3 = R[3][d];
        o[2 * d][0] = (a0 & 0xffffu) | (a1 << 16); o[2 * d][1] = (a2 & 0xffffu) | (a3 << 16);
        o[2 * d + 1][0] = (a0 >> 16) | (a1 & 0xffff0000u); o[2 * d + 1][1] = (a2 >> 16) | (a3 & 0xffff0000u);
    }
}

namespace pg8 {
constexpr int BM = 256, BK = 64, HALF = 128, HTB = HALF * BK * 2, STAGE_BYTES = 8 * HTB, NXCD = 8, WGM = 8;
DI int lds_byte(int r, int c) { const int st = (r >> 4) * 2 + (c >> 5), rr = r & 15, cc = c & 31, ob = rr * 64 + cc * 2; return st * 1024 + (ob ^ (((ob >> 9) & 1) << 5)); }
DI void stage_rc(int b, int& R, int& C) { const int st = b / 1024, sb = b % 1024, swz = sb ^ (((sb >> 9) & 1) << 5); R = (st >> 1) * 16 + swz / 64; C = (st & 1) * 32 + (swz % 64) / 2; }
DI int perm32(int rho) { const int n = rho >> 4, i = rho & 15; return 8 * (i >> 2) + 4 * n + (i & 3); }
struct Unit { int pm, pn; };
struct Gemm { const bf16_t* A; const bf16_t* Bt; int lda, ldb, M, N, K; };
struct StaticOrder {
    int nM, nN, nwg, G, c;
    DI void init(int M, int N, int G_, int c_) { nM = M / BM; nN = N / BM; nwg = nM * nN; G = G_; c = c_; }
    DI bool next(int i, Unit& u) const {
        const long L = (long)i * G + c; if (L >= nwg) return false;
        int wgid = (int)L; { const int q = nwg / NXCD, r = nwg % NXCD, xcd = wgid % NXCD, off = wgid / NXCD; wgid = (xcd < r ? xcd * (q + 1) : r * (q + 1) + (xcd - r) * q) + off; }
        const int nig = WGM * nN, gid = wgid / nig, fm = gid * WGM, gsz = (nM - fm) < WGM ? (nM - fm) : WGM;
        u.pm = fm + ((wgid % nig) % gsz); u.pn = (wgid % nig) / gsz; return true;
    }
};

template <class Epi>
DI void gemm_phase(LAS unsigned char* lds, const Gemm g, const StaticOrder& S, const Epi& E) {
    const int tid = threadIdx.x, wid = __builtin_amdgcn_readfirstlane(tid >> 6), lane = tid & 63, wr = wid >> 2, wc = wid & 3, fr = lane & 15, fq = lane >> 4;
    const int K = g.K, nt = K / BK;
    unsigned voffA[2], voffB[2];
#pragma unroll
    for (int i = 0; i < 2; ++i) { int R, C; stage_rc(tid * 16 + i * 8192, R, C); const int Rb = Epi::PERM ? ((R & ~31) + perm32(R & 31)) : R;
        voffA[i] = (unsigned)(R * g.lda + C) * 2u; voffB[i] = (unsigned)(Rb * g.ldb + C) * 2u; }
    const size_t kstep = (size_t)(BK * 2);
    const size_t hstepA = (size_t)HALF * g.lda * 2, hstepB = (size_t)HALF * g.ldb * 2;
    const size_t tstepA = 2 * hstepA, tstepB = 2 * hstepB;
    const unsigned ldsw = (unsigned)wid * 1024u;
    const int aoff = lds_byte(wr * 64 + fr, fq * 8), boff = lds_byte(wc * 32 + fr, fq * 8);
#define PG8_SA(b, h) (((b) * 2 + (h)) * HTB)
#define PG8_SB(b, h) ((4 + (b) * 2 + (h)) * HTB)
#define PG8_STAGE(bufoff, gbase, voff) do { _Pragma("unroll") for (int _i = 0; _i < 2; ++_i) \
        __builtin_amdgcn_global_load_lds((const unsigned*)((const char*)(gbase) + (voff)[_i]), (LAS unsigned*)(lds + (bufoff) + ldsw + _i * 8192), 16, 0, 0); } while (0)
#define PG8_LDA(dst, b, h) do { _Pragma("unroll") for (int m = 0; m < 4; ++m) _Pragma("unroll") for (int k = 0; k < 2; ++k) dst[m][k] = *(const LAS bf16x8*)(lds + PG8_SA(b, h) + aoff + m * 2048 + k * 1024); } while (0)
#define PG8_LDB(dst, b, h) do { _Pragma("unroll") for (int n = 0; n < 2; ++n) _Pragma("unroll") for (int k = 0; k < 2; ++k) dst[n][k] = *(const LAS bf16x8*)(lds + PG8_SB(b, h) + boff + n * 2048 + k * 1024); } while (0)
#define PG8_MMA(ai, bj, At, Bt) do { __builtin_amdgcn_s_setprio(1); _Pragma("unroll") for (int m = 0; m < 4; ++m) _Pragma("unroll") for (int n = 0; n < 2; ++n) _Pragma("unroll") for (int k = 0; k < 2; ++k) \
        acc[ai][bj][m][n] = __builtin_amdgcn_mfma_f32_16x16x32_bf16(Bt[n][k], At[m][k], acc[ai][bj][m][n], 0, 0, 0); __builtin_amdgcn_s_setprio(0); } while (0)
#define PG8_WAIT_V(n) asm volatile("s_waitcnt vmcnt(" #n ")" ::: "memory")
#define PG8_WAIT_L(n) asm volatile("s_waitcnt lgkmcnt(" #n ")" ::: "memory")
#define PG8_BAR __builtin_amdgcn_s_barrier()
#define PG8_SCHED __builtin_amdgcn_sched_barrier(0)
    Unit cur, nxt; int ui = 0;
    if (!S.next(0, cur)) return;
    f32x4 acc[2][2][4][2];
#pragma unroll
    for (int a = 0; a < 2; ++a)
#pragma unroll
        for (int b = 0; b < 2; ++b)
#pragma unroll
            for (int m = 0; m < 4; ++m)
#pragma unroll
                for (int n = 0; n < 2; ++n) acc[a][b][m][n] = (f32x4){0.f, 0.f, 0.f, 0.f};
    bf16x8 At[4][2], B0[2][2], B1[2][2];
    const char* cA = (const char*)g.A + (size_t)cur.pm * tstepA; const char* cB = (const char*)g.Bt + (size_t)cur.pn * tstepB;
    PG8_STAGE(PG8_SB(0, 0), cB, voffB); PG8_STAGE(PG8_SA(0, 0), cA, voffA); PG8_STAGE(PG8_SB(0, 1), cB + hstepB, voffB); PG8_STAGE(PG8_SA(0, 1), cA + hstepA, voffA);
    if (wr == 1) PG8_BAR;
    PG8_WAIT_V(4); PG8_BAR;
    PG8_STAGE(PG8_SB(1, 0), cB + kstep, voffB); PG8_STAGE(PG8_SA(1, 0), cA + kstep, voffA); PG8_STAGE(PG8_SB(1, 1), cB + hstepB + kstep, voffB);
    PG8_WAIT_V(6); PG8_BAR;
    for (;;) {
        const bool has_next = S.next(ui + 1, nxt);
        const char* nA = has_next ? (const char*)g.A + (size_t)nxt.pm * tstepA : cA; const char* nB = has_next ? (const char*)g.Bt + (size_t)nxt.pn * tstepB : cB;
        for (int t = 0; t < nt; t += 2) {
            const bool last = (t == nt - 2);
            const char* a1 = cA + (size_t)(t + 1) * kstep;
            const char* a2 = last ? nA : cA + (size_t)(t + 2) * kstep; const char* b2 = last ? nB : cB + (size_t)(t + 2) * kstep;
            const char* a3 = a2 + kstep; const char* b3 = b2 + kstep;
            PG8_LDB(B0, 0, 0); PG8_SCHED; PG8_LDA(At, 0, 0); PG8_STAGE(PG8_SA(1, 1), a1 + hstepA, voffA);
            PG8_WAIT_L(8); PG8_BAR; PG8_WAIT_L(0); PG8_MMA(0, 0, At, B0); PG8_BAR; PG8_SCHED;
            PG8_LDB(B1, 0, 1); PG8_STAGE(PG8_SB(0, 0), b2, voffB);
            PG8_BAR; PG8_WAIT_L(0); PG8_MMA(0, 1, At, B1); PG8_BAR;
            PG8_LDA(At, 0, 1); PG8_STAGE(PG8_SA(0, 0), a2, voffA);
            PG8_BAR; PG8_WAIT_L(0); PG8_MMA(1, 0, At, B0); PG8_BAR; PG8_SCHED;
            PG8_STAGE(PG8_SB(0, 1), b2 + hstepB, voffB);
            PG8_WAIT_V(6); PG8_BAR; PG8_MMA(1, 1, At, B1); PG8_BAR;
            PG8_LDB(B0, 1, 0); PG8_SCHED; PG8_LDA(At, 1, 0); PG8_STAGE(PG8_SA(0, 1), a2 + hstepA, voffA);
            PG8_WAIT_L(8); PG8_BAR; PG8_WAIT_L(0); PG8_MMA(0, 0, At, B0); PG8_BAR; PG8_SCHED;
            PG8_LDB(B1, 1, 1); PG8_STAGE(PG8_SB(1, 0), b3, voffB);
            PG8_BAR; PG8_WAIT_L(0); PG8_MMA(0, 1, At, B1); PG8_BAR;
            PG8_LDA(At, 1, 1); PG8_STAGE(PG8_SA(1, 0), a3, voffA);
            PG8_BAR; PG8_WAIT_L(0); PG8_MMA(1, 0, At, B0); PG8_BAR; PG8_SCHED;
            PG8_STAGE(PG8_SB(1, 1), b3 + hstepB, voffB);
            PG8_WAIT_V(6); PG8_BAR; PG8_MMA(1, 1, At, B1); PG8_BAR;
        }
        E(acc, cur, wr, wc, fr, fq);
        if (!has_next) break;
#pragma unroll
        for (int a = 0; a < 2; ++a)
#pragma unroll
            for (int b = 0; b < 2; ++b)
#pragma unroll
                for (int m = 0; m < 4; ++m)
#pragma unroll
                    for (int n = 0; n < 2; ++n) acc[a][b][m][n] = (f32x4){0.f, 0.f, 0.f, 0.f};
        cur = nxt; cA = nA; cB = nB; ++ui;
    }
    PG8_WAIT_V(0);
    if (wr == 0) PG8_BAR;
    PG8_BAR;
#undef PG8_SA
#undef PG8_SB
#undef PG8_STAGE
#undef PG8_LDA
#undef PG8_LDB
#undef PG8_MMA
#undef PG8_WAIT_V
#undef PG8_WAIT_L
#undef PG8_BAR
#undef PG8_SCHED
}

template <int MODE> struct EpiScaleBf16 {
    static constexpr bool PERM = true;
    bf16_t* O; int ldc; const float* rs;
    DI void operator()(const f32x4 (&acc)[2][2][4][2], const Unit& u, int wr, int wc, int fr, int fq) const {
        const int row0 = u.pm * BM + wr * 64 + fr, col0 = u.pn * BM + wc * 32 + 8 * fq;
#pragma unroll
        for (int ai = 0; ai < 2; ++ai)
#pragma unroll
            for (int m = 0; m < 4; ++m) {
                const int row = row0 + ai * HALF + m * 16;
                float sc = 1.f;
                if (MODE != 2) { sc = rs[row]; if (MODE == 1) sc = rsqrtf(sc * (1.f / 2048.f) + 1e-6f); }
                bf16_t* rowp = O + (size_t)row * ldc + col0;
#pragma unroll
                for (int bj = 0; bj < 2; ++bj) {
                    const f32x4 v0 = acc[ai][bj][m][0] * sc, v1 = acc[ai][bj][m][1] * sc;
                    u32x4 w; w.x = pk2(v0[0], v0[1]); w.y = pk2(v0[2], v0[3]); w.z = pk2(v1[0], v1[1]); w.w = pk2(v1[2], v1[3]);
                    *(u32x4*)(rowp + bj * HALF) = w;
                }
            }
    }
};
struct EpiResid {
    static constexpr bool PERM = false;
    const float* R; float* H; bf16_t* HB; float* SS;
    DI void operator()(const f32x4 (&acc)[2][2][4][2], const Unit& u, int wr, int wc, int fr, int fq) const {
        const int row0 = u.pm * BM + wr * 64 + fr, col0 = u.pn * BM + wc * 32 + 4 * fq;
#pragma unroll
        for (int ai = 0; ai < 2; ++ai)
#pragma unroll
            for (int m = 0; m < 4; ++m) {
                const int row = row0 + ai * HALF + m * 16;
                const size_t ro = (size_t)row * DM + col0;
                float ss = 0.f;
#pragma unroll
                for (int bj = 0; bj < 2; ++bj)
#pragma unroll
                    for (int n = 0; n < 2; ++n) {
                        const size_t o = ro + bj * HALF + n * 16;
                        const f32x4 r = *(const f32x4*)(R + o);
                        const f32x4 v = acc[ai][bj][m][n] + r;
                        *(f32x4*)(H + o) = v;
                        ss += v[0] * v[0] + v[1] * v[1] + v[2] * v[2] + v[3] * v[3];
                        if (HB) { u32x2 w; w.x = pk2(v[0], v[1]); w.y = pk2(v[2], v[3]); *(u32x2*)(HB + o) = w; }
                    }
                if (SS) { ss += __shfl_xor(ss, 16); ss += __shfl_xor(ss, 32); if (fq == 0) atomicAdd(SS + row, ss); }
            }
    }
};
}

DI void tconv(const float* src, int K, int N, bf16_t* dst, int Npad, const float* rs, int mode, LAS float* tile) {
    const int tid = threadIdx.x, nkt = K / 64, ntiles = nkt * (Npad / 128);
    float vv[16];
    auto ldt = [&](int tl) {
        const int kt = tl % nkt, ntb = tl / nkt, k0 = kt * 64, n0 = ntb * 128;
#pragma unroll
        for (int i = 0; i < 4; ++i) {
            const int idx = tid + i * 512, kk = idx >> 5, n = n0 + (idx & 31) * 4;
            int sc = n < N ? n : -1; float scale = 1.f;
            if (mode == 1) { scale = (n >= 2048 && n < 4096) ? 0.0625f : 1.f; }
            if (mode == 2) {
                if (n < 5120) { sc = n; scale = n < 2048 ? 0.12751743074602467f : 1.f; }
                else if (n < 7168) sc = n + 48;
                else if (n < 7216) sc = n - 2048;
                else sc = -1;
            }
            f32x4 v = (f32x4){0.f, 0.f, 0.f, 0.f};
            if (sc >= 0) { v = *(const f32x4*)(src + (size_t)(k0 + kk) * N + sc); if (rs) scale *= rs[k0 + kk]; v = v * scale; }
            vv[4 * i] = v[0]; vv[4 * i + 1] = v[1]; vv[4 * i + 2] = v[2]; vv[4 * i + 3] = v[3];
        }
    };
    if ((int)blockIdx.x < ntiles) ldt(blockIdx.x);
    for (int tl = blockIdx.x; tl < ntiles; tl += gridDim.x) {
        const int kt = tl % nkt, ntb = tl / nkt, k0 = kt * 64, n0 = ntb * 128;
#pragma unroll
        for (int i = 0; i < 4; ++i) { const int idx = tid + i * 512, kk = idx >> 5, nn = (idx & 31) * 4;
#pragma unroll
            for (int e = 0; e < 4; ++e) tile[kk * 129 + nn + e] = vv[4 * i + e]; }
        if (tl + (int)gridDim.x < ntiles) ldt(tl + gridDim.x);
        lds_barrier();
#pragma unroll
        for (int i = 0; i < 2; ++i) {
            const int id = tid + 512 * i, k8 = id & 7, nn = id >> 3;
            u32x4 w;
#pragma unroll
            for (int d = 0; d < 4; ++d) w[d] = pk2(tile[(k8 * 8 + 2 * d) * 129 + nn], tile[(k8 * 8 + 2 * d + 1) * 129 + nn]);
            *(u32x4*)(dst + (size_t)(n0 + nn) * K + k0 + k8 * 8) = w;
        }
        lds_barrier();
    }
}

DI void phase0(const Params& p, LAS unsigned char* lds) {
    unsigned char* ws = p.ws;
    LAS float* tile = (LAS float*)lds;
    const int tid = threadIdx.x, lane = tid & 63, wave = tid >> 6;
    tconv(p.ret_w_in, 2048, 12288, (bf16_t*)(ws + OFF_W1T), 12288, p.norm_g, 1, tile);
    tconv(p.ret_w_out, 4096, 2048, (bf16_t*)(ws + OFF_W2T), 2048, nullptr, 0, tile);
    tconv(p.nsa_w_in, 2048, 7216, (bf16_t*)(ws + OFF_W3T), LD1, p.norm_g + 2048, 2, tile);
    tconv(p.nsa_w_out, 2048, 2048, (bf16_t*)(ws + OFF_W4T), 2048, nullptr, 0, tile);
    tconv(p.w1_k, 4096, 128, (bf16_t*)(ws + OFF_CW1K), 128, nullptr, 0, tile);
    tconv(p.w1_v, 4096, 128, (bf16_t*)(ws + OFF_CW1V), 128, nullptr, 0, tile);
    tconv(p.w2_k, 128, 128, (bf16_t*)(ws + OFF_CW2K), 128, nullptr, 0, tile);
    tconv(p.w2_v, 128, 128, (bf16_t*)(ws + OFF_CW2V), 128, nullptr, 0, tile);
    bf16_t* xb = (bf16_t*)(ws + OFF_XB); float* rstd0 = (float*)(ws + OFF_RSTD0); float* ss1 = (float*)(ws + OFF_SS1);
    for (int row0 = (blockIdx.x * 8 + wave) * 2; row0 < T_; row0 += gridDim.x * 16) {
        f32x4 v[2][8]; float ss[2] = {0.f, 0.f};
#pragma unroll
        for (int q = 0; q < 2; ++q) {
            const f32x4* xr = (const f32x4*)(p.x + (size_t)(row0 + q) * DM);
#pragma unroll
            for (int i = 0; i < 8; ++i) v[q][i] = xr[lane + 64 * i];
        }
#pragma unroll
        for (int q = 0; q < 2; ++q)
#pragma unroll
            for (int i = 0; i < 8; ++i) ss[q] += v[q][i][0] * v[q][i][0] + v[q][i][1] * v[q][i][1] + v[q][i][2] * v[q][i][2] + v[q][i][3] * v[q][i][3];
        ss[0] = wave_sum(ss[0]); ss[1] = wave_sum(ss[1]);
#pragma unroll
        for (int q = 0; q < 2; ++q) {
            const float rs0 = rsqrtf(ss[q] * (1.f / 2048.f) + 1e-6f);
#pragma unroll
            for (int i = 0; i < 8; ++i) { u32x2 w; w.x = pk2(v[q][i][0] * rs0, v[q][i][1] * rs0); w.y = pk2(v[q][i][2] * rs0, v[q][i][3] * rs0); *(u32x2*)(xb + (size_t)(row0 + q) * DM + (lane + 64 * i) * 4) = w; }
        }
    }
    for (int i = blockIdx.x * NTHREADS + tid; i < T_; i += gridDim.x * NTHREADS) ss1[i] = 0.f;
    {
        float* cb = (float*)(ws + OFF_CBZ);
        LAS float* red = (LAS float*)lds;
        for (int bb = blockIdx.x; bb < 128; bb += gridDim.x) {
            const int kv = bb >> 6, i0 = 64 * (bb & 63);
            const float* pos = kv ? p.pos_v : p.pos_k; const float* w1 = kv ? p.w1_v : p.w1_k;
            float a0 = 0.f, a1 = 0.f;
#pragma unroll
            for (int r = 0; r < 8; ++r) {
                const int i = i0 + 8 * wave + r;
                const float pv = pos[i];
                const float2 wv = *(const float2*)(w1 + (size_t)i * 128 + 2 * lane);
                a0 += pv * wv.x; a1 += pv * wv.y;
            }
            lds_barrier();
            red[wave * 128 + 2 * lane] = a0; red[wave * 128 + 2 * lane + 1] = a1;
            lds_barrier();
            if (tid < 128) {
                float s = 0.f;
#pragma unroll
                for (int w = 0; w < 8; ++w) s += red[w * 128 + tid];
                atomicAdd(cb + kv * 128 + tid, s);
            }
        }
    }
}

DI void ret_intra(const bf16_t* PROJ, bf16_t* OI, bf16_t* KTG, LAS unsigned char* lds) {
    const int tid = threadIdx.x, lane = tid & 63, wave = tid >> 6, r32 = lane & 31, hh = lane >> 5;
    LAS bf16_t* Qs = (LAS bf16_t*)lds;
    LAS bf16_t* Ks = (LAS bf16_t*)(lds + 67584);
    LAS bf16_t* Ss = Qs;
    LAS bf16_t* OUTs = (LAS bf16_t*)(lds + 34816);
    LAS bf16_t* VT0 = (LAS bf16_t*)(lds + 69632);
    u32x4 qk[16];
    auto loadQK = [&](int u) {
        const int b = u >> 10, h = (u >> 7) & 7, ch = u & 127;
        unsigned tq = tid; asm volatile("" : "+v"(tq));
        const bf16_t* base = PROJ + ((size_t)b * S_ + ch * 128) * LD0 + h * 256;
#pragma unroll
        for (int i = 0; i < 8; ++i) {
            const unsigned pc = tq + i * 512, off = (pc >> 5) * LD0 + (pc & 31) * 8;
            qk[2 * i] = *(const u32x4*)(base + off);
            qk[2 * i + 1] = *(const u32x4*)(base + (off + 2048));
        }
    };
    if ((int)blockIdx.x < 2048) loadQK(blockIdx.x);
    for (int u = blockIdx.x; u < 2048; u += gridDim.x) {
        const int b = u >> 10, h = (u >> 7) & 7, ch = u & 127;
        const size_t t0 = (size_t)b * S_ + ch * 128;
        const float logg = log1pf(-exp2f(-5.f - (float)h));
        {
            int tq = tid; asm volatile("" : "+v"(tq));
#pragma unroll
            for (int i = 0; i < 8; ++i) {
                const int pc = tq + i * 512, row = pc >> 5, cs = pc & 31;
                *(LAS u32x4*)(Qs + row * 264 + cs * 8) = qk[2 * i];
                *(LAS u32x4*)(Ks + row * 264 + cs * 8) = qk[2 * i + 1];
            }
        }
        const int vg = (tid & 3) + 4 * (tid >> 7), mg = (tid >> 2) & 31;
        u32x4 VA[4], VB[4];
        const bf16_t* vbase = PROJ + t0 * LD0 + 4096 + h * 512;
        auto loadV = [&](u32x4 (&R)[4], int pz) {
            unsigned mq = mg, vq = vg; asm volatile("" : "+v"(mq)); asm volatile("" : "+v"(vq));
#pragma unroll
            for (int rr = 0; rr < 4; ++rr) R[rr] = *(const u32x4*)(vbase + ((4 * mq + rr) * LD0 + pz * 128 + 8 * vq));
        };
        auto writeV = [&](const u32x4 (&R)[4], int pz) {
            LAS bf16_t* VT = VT0 + (pz & 1) * (128 * 136);
            u32x2 o[8]; tr4x8(R, o);
#pragma unroll
            for (int jj = 0; jj < 8; ++jj) *(LAS u32x2*)(VT + (8 * vg + jj) * 136 + 4 * mg) = o[jj];
        };
        loadV(VA, 0); loadV(VB, 1);
        lds_barrier();
        const int nt = wave & 3, mtb = (wave >> 2) * 2;
        f32x16 sacc[2];
#pragma unroll
        for (int mi = 0; mi < 2; ++mi) {
            const int mt = mtb + mi; sacc[mi] = zero16();
            if (mt <= nt) {
#pragma unroll
                for (int s = 0; s < 16; ++s)
                    sacc[mi] = MFMA32(ldsfrag(Ks + (mt * 32 + r32) * 264 + 16 * s + 8 * hh), ldsfrag(Qs + (nt * 32 + r32) * 264 + 16 * s + 8 * hh), sacc[mi]);
            }
        }
        {
            bf16_t* kt = KTG + (size_t)u * 32768;
#pragma unroll
            for (int i = 0; i < 2; ++i) {
                const int bi = tid + 512 * i, mgk = bi & 31, dg = bi >> 5;
                u32x4 R[4]; u32x2 o[8];
#pragma unroll
                for (int rr = 0; rr < 4; ++rr) R[rr] = *(const LAS u32x4*)(Ks + (4 * mgk + rr) * 264 + 8 * dg);
                tr4x8(R, o);
#pragma unroll
                for (int jj = 0; jj < 8; ++jj) *(u32x2*)(kt + (8 * dg + jj) * 128 + 4 * mgk) = o[jj];
            }
        }
        lds_barrier();
        const int n = nt * 32 + r32;
#pragma unroll
        for (int mi = 0; mi < 2; ++mi) {
            const int mt = mtb + mi;
#pragma unroll
            for (int G = 0; G < 4; ++G) {
                const int m0 = mt * 32 + 8 * G + 4 * hh;
                float v[4];
#pragma unroll
                for (int j = 0; j < 4; ++j) { const int df = n - (m0 + j); v[j] = df >= 0 ? sacc[mi][4 * G + j] * __expf((float)df * logg) : 0.f; }
                u32x2 w; w.x = pk2(v[0], v[1]); w.y = pk2(v[2], v[3]);
                *(LAS u32x2*)(Ss + n * 136 + m0) = w;
            }
        }
        writeV(VA, 0); loadV(VA, 2);
        if (u + (int)gridDim.x < 2048) loadQK(u + gridDim.x);
        const int vtb = (wave >> 2) * 2;
        auto piece = [&](int pz) {
            LAS bf16_t* VT = VT0 + (pz & 1) * (128 * 136);
#pragma unroll
            for (int vi = 0; vi < 2; ++vi) {
                const int vt = vtb + vi; f32x16 acc = zero16();
                for (int s = 0; s < 2 * (nt + 1); ++s)
                    acc = MFMA32(ldsfrag(VT + (vt * 32 + r32) * 136 + 16 * s + 8 * hh), ldsfrag(Ss + (nt * 32 + r32) * 136 + 16 * s + 8 * hh), acc);
#pragma unroll
                for (int G = 0; G < 4; ++G) {
                    u32x2 w; w.x = pk2(acc[4 * G], acc[4 * G + 1]); w.y = pk2(acc[4 * G + 2], acc[4 * G + 3]);
                    *(LAS u32x2*)(OUTs + n * 136 + vt * 32 + 8 * G + 4 * hh) = w;
                }
            }
        };
        auto flush = [&](int pz) {
            int tq = tid; asm volatile("" : "+v"(tq));
#pragma unroll
            for (int i = 0; i < 4; ++i) {
                const int pc = tq + 512 * i, row = pc >> 4, c16 = pc & 15;
                *(u32x4*)(OI + (t0 + row) * 4096 + h * 512 + pz * 128 + c16 * 8) = *(const LAS u32x4*)(OUTs + row * 136 + c16 * 8);
            }
        };
        lds_barrier(); writeV(VB, 1); loadV(VB, 3); piece(0); lds_barrier(); flush(0);
        lds_barrier(); writeV(VA, 2); piece(1); lds_barrier(); flush(1);
        lds_barrier(); writeV(VB, 3); piece(2); lds_barrier(); flush(2);
        lds_barrier(); piece(3); lds_barrier(); flush(3);
        lds_barrier();
    }
}

DI void ret_inter(bf16_t* PROJ, const bf16_t* OI, const bf16_t* KTG, LAS unsigned char* lds, bool dummy = false) {
    const int tid = threadIdx.x, lane = tid & 63, wave = tid >> 6, r32 = lane & 31, hh = lane >> 5;
    LAS bf16_t* KT = (LAS bf16_t*)lds;
    LAS bf16_t* VT = (LAS bf16_t*)(lds + 69632);
    LAS bf16_t* ST = (LAS bf16_t*)(lds + 69632 + 8704);
    LAS bf16_t* Qs = (LAS bf16_t*)(lds + 69632 + 8704 + 16896);
    for (int u = blockIdx.x; u < 256; u += gridDim.x) {
        const int uu = (gridDim.x == 256) ? ((((u & 7) * 2 + (u >> 7)) << 4) + ((u >> 3) & 15)) : u;
        const int b = uu >> 7, h = (uu >> 4) & 7, vs = uu & 15, v0 = vs * 32;
        const float logg = log1pf(-exp2f(-5.f - (float)h));
        const float cd = __expf(128.f * logg);
        for (int i = tid; i < 32 * 264 / 2; i += NTHREADS) ((LAS unsigned*)ST)[i] = 0u;
        const size_t tb = (size_t)b * S_;
        if (wave < 4) {
            struct QSet { u32x4 q[16]; u32x4 o[2]; };
            QSet QA, QB;
            const int n = 32 * wave + r32;
            auto loadq = [&](QSet& Q, int c) {
                unsigned tq = tid; asm volatile("" : "+v"(tq));
                const bf16_t* qb_ = PROJ + (tb + c * 128) * LD0 + h * 256;
                const bf16_t* ob_ = OI + (tb + c * 128) * 4096 + h * 512 + v0;
#pragma unroll
                for (int i = 0; i < 16; ++i) { const unsigned pc = tq + 256 * i; Q.q[i] = *(const u32x4*)(qb_ + ((pc >> 5) * LD0 + (pc & 31) * 8)); }
                const unsigned nq = 32 * (tq >> 6) + (tq & 31), hq = (tq >> 5) & 1;
#pragma unroll
                for (int e = 0; e < 2; ++e) Q.o[e] = *(const u32x4*)(ob_ + (nq * 4096 + 16 * e + 8 * hq));
            };
            const float qd = __expf((float)(n + 1) * logg);
            auto stepq = [&](int c, QSet& Q) {
                {
                    int tq = tid; asm volatile("" : "+v"(tq));
#pragma unroll
                    for (int i = 0; i < 16; ++i) { const int pc = tq + 256 * i; *(LAS u32x4*)(Qs + (pc >> 5) * 264 + (pc & 31) * 8) = Q.q[i]; }
                }
                const u32x4 o0 = Q.o[0], o1 = Q.o[1];
                if (c + 2 < 128) loadq(Q, c + 2);
                lds_barrier();
                f32x16 acc = zero16(), acc1 = zero16();
#pragma unroll
                for (int s = 0; s < 16; s += 2) {
                    acc = MFMA32(ldsfrag(ST + r32 * 264 + 16 * s + 8 * hh), ldsfrag(Qs + n * 264 + 16 * s + 8 * hh), acc);
                    acc1 = MFMA32(ldsfrag(ST + r32 * 264 + 16 * (s + 1) + 8 * hh), ldsfrag(Qs + n * 264 + 16 * (s + 1) + 8 * hh), acc1);
                }
                acc = acc + acc1;
                u32x4 w0, w1;
#pragma unroll
                for (int d = 0; d < 4; ++d) {
                    w0[d] = pk2(bflo(o0[d]) + acc[2 * d] * qd, bfhi(o0[d]) + acc[2 * d + 1] * qd);
                    w1[d] = pk2(bflo(o1[d]) + acc[8 + 2 * d] * qd, bfhi(o1[d]) + acc[8 + 2 * d + 1] * qd);
                }
                {
                    unsigned nq = n; asm volatile("" : "+v"(nq));
                    bf16_t* wb_ = PROJ + (tb + c * 128) * LD0 + 4096 + h * 512 + v0;
                    const unsigned wo = nq * LD0 + 8 * hh;
                    if (!dummy) { *(u32x4*)(wb_ + wo) = w0; *(u32x4*)(wb_ + (wo + 16)) = w1; }
                }
                lds_barrier();
            };
            loadq(QA, 0); loadq(QB, 1);
            for (int c = 0; c < 128; c += 2) { stepq(c, QA); stepq(c + 1, QB); }
        } else {
            struct KSet { u32x4 k[4][4]; u32x4 v[2]; };
            KSet KA, KB;
            const int t4 = tid - 256;
            auto loadk = [&](KSet& K, int c) {
                unsigned tq = t4; asm volatile("" : "+v"(tq));
                const bf16_t* kb_ = KTG + ((size_t)((b * 8 + h) * 128 + c)) * 32768;
                const bf16_t* vb_ = PROJ + (tb + c * 128) * LD0 + 4096 + h * 512 + v0;
#pragma unroll
                for (int i = 0; i < 16; ++i) K.k[i >> 2][i & 3] = *(const u32x4*)(kb_ + (tq + 256 * i) * 8u);
#pragma unroll
                for (int i = 0; i < 2; ++i) { const unsigned pi = tq + 256 * i; K.v[i] = *(const u32x4*)(vb_ + ((pi >> 2) * LD0 + 8 * (pi & 3))); }
            };
            f32x16 sacc[2]; sacc[0] = zero16(); sacc[1] = zero16();
            auto stepk = [&](int c, KSet& K) {
                int tw = t4; asm volatile("" : "+v"(tw));
#pragma unroll
                for (int i = 0; i < 16; ++i) { const int pc = tw + 256 * i; *(LAS u32x4*)(KT + (pc >> 4) * 136 + (pc & 15) * 8) = K.k[i >> 2][i & 3]; }
#pragma unroll
                for (int i = 0; i < 2; ++i) {
                    const int pi = tw + 256 * i, vm = pi >> 2, vgq = pi & 3;
                    const float kd = __expf((float)(127 - vm) * logg);
#pragma unroll
                    for (int d = 0; d < 4; ++d) {
                        const unsigned wv = K.v[i][d];
                        const unsigned a = pk2(bflo(wv) * kd, bfhi(wv) * kd);
                        const int vl = 8 * vgq + 2 * d, q4 = vl >> 2, pq = ((q4 & 3) == 1 || (q4 & 3) == 2) ? (q4 ^ 3) : q4, rho = (pq << 2) | (vl & 3);
                        VT[rho * 136 + vm] = (bf16_t)(a & 0xffffu);
                        VT[(rho + 1) * 136 + vm] = (bf16_t)(a >> 16);
                    }
                }
                if (c + 2 < 128) loadk(K, c + 2);
                lds_barrier();
#pragma unroll
                for (int ti = 0; ti < 2; ++ti) sacc[ti] = sacc[ti] * cd;
#pragma unroll
                for (int s = 0; s < 8; ++s)
#pragma unroll
                    for (int ti = 0; ti < 2; ++ti) {
                        const int d = (2 * (wave - 4) + ti) * 32 + r32;
                        sacc[ti] = MFMA32(ldsfrag(KT + d * 136 + 16 * s + 8 * hh), ldsfrag(VT + r32 * 136 + 16 * s + 8 * hh), sacc[ti]);
                    }
                lds_barrier();
#pragma unroll
                for (int ti = 0; ti < 2; ++ti) {
                    const int dt = 2 * (wave - 4) + ti;
#pragma unroll
                    for (int G = 0; G < 4; ++G) {
                        u32x2 w; w.x = pk2(sacc[ti][4 * G], sacc[ti][4 * G + 1]); w.y = pk2(sacc[ti][4 * G + 2], sacc[ti][4 * G + 3]);
                        *(LAS u32x2*)(ST + r32 * 264 + dt * 32 + 8 * G + 4 * hh) = w;
                    }
                }
            };
            loadk(KA, 0); loadk(KB, 1);
            for (int c = 0; c < 128; c += 2) { stepk(c, KA); stepk(c + 1, KB); }
        }
        lds_barrier();
    }
}

DI void ret_gate(bf16_t* PROJ, bf16_t* dummy = nullptr) {
    const int lane = threadIdx.x & 63, wave = threadIdx.x >> 6;
    const int nw = gridDim.x * 8, gw = blockIdx.x * 8 + wave;
    for (int task0 = gw * 8; task0 < T_ * 8; task0 += nw * 8) {
        u32x4 o8[8], g8[8];
#pragma unroll
        for (int q = 0; q < 8; ++q) {
            const int task = task0 + q; const size_t t = task >> 3; const int h = task & 7;
            o8[q] = *(const u32x4*)(PROJ + t * LD0 + 4096 + h * 512 + lane * 8);
            g8[q] = *(const u32x4*)(PROJ + t * LD0 + 8192 + h * 512 + lane * 8);
        }
#pragma unroll
        for (int q = 0; q < 8; ++q) {
            const int task = task0 + q; const size_t t = task >> 3; const int h = task & 7;
            float f[8], gt[8];
#pragma unroll
            for (int d = 0; d < 4; ++d) { f[2 * d] = bflo(o8[q][d]); f[2 * d + 1] = bfhi(o8[q][d]); gt[2 * d] = bflo(g8[q][d]); gt[2 * d + 1] = bfhi(g8[q][d]); }
            float s = 0.f;
#pragma unroll
            for (int d = 0; d < 8; ++d) s += f[d];
            const float mu = wave_sum(s) * (1.f / 512.f);
            float s2 = 0.f;
#pragma unroll
            for (int d = 0; d < 8; ++d) { f[d] -= mu; s2 += f[d] * f[d]; }
            const float rs = rsqrtf(wave_sum(s2) * (1.f / 512.f) + 1e-6f);
            u32x4 w;
#pragma unroll
            for (int d = 0; d < 4; ++d) w[d] = pk2(silu_f(gt[2 * d]) * f[2 * d] * rs, silu_f(gt[2 * d + 1]) * f[2 * d + 1] * rs);
            if (dummy) *(u32x4*)(dummy + (t & 4095) * LD0 + 8192 + h * 512 + lane * 8) = w; else *(u32x4*)(PROJ + t * LD0 + 8192 + h * 512 + lane * 8) = w;
        }
    }
}

DI void nsa_compress(const bf16_t* P1, unsigned char* ws, bf16_t* KC, bf16_t* VCT, bf16_t* VST, bf16_t* VWT, bf16_t* KS2, bf16_t* KW2, LAS unsigned char* lds) {
    const int tid = threadIdx.x, lane = tid & 63, wave = tid >> 6, r32 = lane & 31, hh = lane >> 5;
    LAS bf16_t* As = (LAS bf16_t*)lds;
    LAS bf16_t* Ws = (LAS bf16_t*)(lds + 17408);
    LAS bf16_t* Hs = (LAS bf16_t*)(lds + 17408 + 34816);
    const float* cb = (const float*)(ws + OFF_CBZ);
    for (int u = blockIdx.x; u < 256; u += gridDim.x) {
        const int kv = u >> 7, bg = (u >> 4) & 7, ct = u & 15, b = bg >> 2, g = bg & 3;
        const bf16_t* W1T = (const bf16_t*)(ws + (kv ? OFF_CW1V : OFF_CW1K));
        const bf16_t* W2T = (const bf16_t*)(ws + (kv ? OFF_CW2V : OFF_CW2K));
        const int colA = (kv ? C_VC : C_KC) + g * 128;
        const int ch = wave & 1, jt = wave >> 1;
        f32x16 acc = zero16();
        u32x4 pa[2], pw[4];
        auto ldl = [&](int l) {
            unsigned tq = tid; asm volatile("" : "+v"(tq));
#pragma unroll
            for (int i = 0; i < 2; ++i) {
                const unsigned pc = tq + 512 * i, row = pc >> 4, cs = pc & 15;
                unsigned tok = 16 * (ct * 64 + row) + l; tok = tok < (unsigned)S_ ? tok : S_ - 1;
                pa[i] = *(const u32x4*)(P1 + ((size_t)b * S_ + tok) * LD1 + colA + cs * 8);
            }
#pragma unroll
            for (int i = 0; i < 4; ++i) {
                const unsigned pc = tq + 512 * i, row = pc >> 4, cs = pc & 15;
                pw[i] = *(const u32x4*)(W1T + (row * 4096 + l * 128 + cs * 8));
            }
        };
        ldl(0);
        for (int l = 0; l < 32; ++l) {
            lds_barrier();
            {
                int tq = tid; asm volatile("" : "+v"(tq));
#pragma unroll
                for (int i = 0; i < 2; ++i) { const int pc = tq + 512 * i; *(LAS u32x4*)(As + (pc >> 4) * 136 + (pc & 15) * 8) = pa[i]; }
#pragma unroll
                for (int i = 0; i < 4; ++i) { const int pc = tq + 512 * i; *(LAS u32x4*)(Ws + (pc >> 4) * 136 + (pc & 15) * 8) = pw[i]; }
            }
            if (l + 1 < 32) ldl(l + 1);
            lds_barrier();
#pragma unroll
            for (int s = 0; s < 8; ++s)
                acc = MFMA32(ldsfrag(Ws + (jt * 32 + r32) * 136 + 16 * s + 8 * hh), ldsfrag(As + (ch * 32 + r32) * 136 + 16 * s + 8 * hh), acc);
        }
#pragma unroll
        for (int G = 0; G < 4; ++G) {
            const int j0 = jt * 32 + 8 * G + 4 * hh;
            float v[4];
#pragma unroll
            for (int j = 0; j < 4; ++j) v[j] = silu_f(acc[4 * G + j] + cb[kv * 128 + j0 + j]);
            u32x2 w; w.x = pk2(v[0], v[1]); w.y = pk2(v[2], v[3]);
            *(LAS u32x2*)(Hs + (ch * 32 + r32) * 136 + j0) = w;
        }
        lds_barrier();
#pragma unroll
        for (int i = 0; i < 4; ++i) {
            const int pc = tid + 512 * i, row = pc >> 4, cs = pc & 15;
            *(LAS u32x4*)(Ws + row * 136 + cs * 8) = *(const u32x4*)(W2T + (size_t)row * 128 + cs * 8);
        }
        lds_barrier();
        f32x16 a2 = zero16();
        if (kv == 0) {
#pragma unroll
            for (int s = 0; s < 8; ++s)
                a2 = MFMA32(ldsfrag(Ws + (jt * 32 + r32) * 136 + 16 * s + 8 * hh), ldsfrag(Hs + (ch * 32 + r32) * 136 + 16 * s + 8 * hh), a2);
            const int c = ct * 64 + ch * 32 + r32;
#pragma unroll
            for (int G = 0; G < 4; ++G) {
                u32x2 w; w.x = pk2(a2[4 * G], a2[4 * G + 1]); w.y = pk2(a2[4 * G + 2], a2[4 * G + 3]);
                *(u32x2*)(KC + ((size_t)bg * 1024 + c) * 128 + jt * 32 + 8 * G + 4 * hh) = w;
            }
            {
                float am = 0.f;
#pragma unroll
                for (int i = 0; i < 16; ++i) am = fmaxf(am, fabsf(a2[i]));
#pragma unroll
                for (int o = 32; o >= 1; o >>= 1) am = fmaxf(am, __shfl_xor(am, o));
                if (lane == 0) atomicMax((unsigned*)(ws + OFF_KINF) + bg, __float_as_uint(am * 1.01f));
            }
        } else {
#pragma unroll
            for (int s = 0; s < 8; ++s)
                a2 = MFMA32(ldsfrag(Hs + (ch * 32 + r32) * 136 + 16 * s + 8 * hh), ldsfrag(Ws + (jt * 32 + r32) * 136 + 16 * s + 8 * hh), a2);
            const int j2 = jt * 32 + r32;
#pragma unroll
            for (int G = 0; G < 4; ++G) {
                u32x2 w; w.x = pk2(a2[4 * G], a2[4 * G + 1]); w.y = pk2(a2[4 * G + 2], a2[4 * G + 3]);
                *(u32x2*)(VCT + ((size_t)(bg * 16 + ct) * 128 + j2) * 64 + ch * 32 + 8 * G + 4 * hh) = w;
            }
        }
        lds_barrier();
    }
    {
        const int half = tid >> 8, t8 = tid & 255, dgq = (t8 & 3) + 4 * (t8 >> 6), mg = (t8 >> 2) & 15;
        for (int u2 = blockIdx.x * 2 + half; u2 < 4096; u2 += gridDim.x * 2) {
            const int which = u2 >> 11, bg = (u2 >> 8) & 7, jb = u2 & 255, b = bg >> 2, g = bg & 3;
            const int col = (which ? C_VW : C_VS) + g * 128, kcol = (which ? C_KW : C_KS) + g * 128;
            bf16_t* vdst = (which ? VWT : VST) + (size_t)(bg * 256 + jb) * 8192;
            bf16_t* kdst = (which ? KW2 : KS2) + (size_t)(bg * 256 + jb) * 8192;
            const bf16_t* srow = P1 + ((size_t)b * S_ + jb * 64) * LD1;
            u32x4 R[4]; u32x2 o[8]; u32x4 kk[4];
#pragma unroll
            for (int rr = 0; rr < 4; ++rr) R[rr] = *(const u32x4*)(srow + (size_t)(4 * mg + rr) * LD1 + col + 8 * dgq);
#pragma unroll
            for (int i = 0; i < 4; ++i) { const int pc = t8 + 256 * i; kk[i] = *(const u32x4*)(srow + (size_t)(pc >> 4) * LD1 + kcol + (pc & 15) * 8); }
            tr4x8(R, o);
#pragma unroll
            for (int jj = 0; jj < 8; ++jj) *(u32x2*)(vdst + (8 * dgq + jj) * 64 + 4 * mg) = o[jj];
#pragma unroll
            for (int i = 0; i < 4; ++i) { const int pc = t8 + 256 * i; *(u32x4*)(kdst + pc * 8) = kk[i]; }
            if (which == 0) {
                float am = 0.f;
#pragma unroll
                for (int i = 0; i < 4; ++i)
#pragma unroll
                    for (int d = 0; d < 4; ++d) am = fmaxf(am, fmaxf(fabsf(bflo(kk[i][d])), fabsf(bfhi(kk[i][d]))));
#pragma unroll
                for (int o = 32; o >= 1; o >>= 1) am = fmaxf(am, __shfl_xor(am, o));
                if (lane == 0) atomicMax((unsigned*)(ws + OFF_KINF) + 8 + bg, __float_as_uint(am));
            }
        }
    }
}

DI float dpp_x1(float v) { return __int_as_float(__builtin_amdgcn_mov_dpp(__float_as_int(v), 0xB1, 0xF, 0xF, true)); }
DI float dpp_x2(float v) { return __int_as_float(__builtin_amdgcn_mov_dpp(__float_as_int(v), 0x4E, 0xF, 0xF, true)); }

DI void nsa_attn(const bf16_t* P1, const bf16_t* KC, const bf16_t* VCT, const bf16_t* VST, const bf16_t* VWT, const bf16_t* KS2, const bf16_t* KW2, const float* KINF, bf16_t* Y1, LAS unsigned char* lds) {
    const int tid = threadIdx.x, lane = tid & 63, wave = tid >> 6, r32 = lane & 31, hh = lane >> 5;
    constexpr int KB_E = 64 * 136, VP = 68, VB_E = 128 * VP;
    LAS bf16_t* Kb = (LAS bf16_t*)lds;
    LAS bf16_t* Vb = (LAS bf16_t*)(lds + 2 * KB_E * 2);
    LAS unsigned char* r1base = lds + 2 * KB_E * 2 + 2 * VB_E * 2;
    LAS float* imp = (LAS float*)r1base;
    LAS bf16_t* R1 = (LAS bf16_t*)r1base;
    LAS unsigned* selm = (LAS unsigned*)(r1base + 67584);
    LAS unsigned* uni = selm + 512;
    LAS int* jcount = (LAS int*)(uni + 8);
    LAS unsigned char* jlist = (LAS unsigned char*)(uni + 16);
    LAS int* kt0w = (LAS int*)(uni + 12);
    LAS int* jf0w = (LAS int*)(uni + 13);
    const int G_ = gridDim.x;
    for (int U = blockIdx.x; U < 2048; U += G_) {
        const int bg = U >> 8, qraw = U & 255, qidx = (gridDim.x == 256) ? ((qraw & 7) * 32 + (qraw >> 3)) : qraw, qb = (bg & 1) ? 255 - qidx : qidx, b = bg >> 2, g = bg & 3;
        const int q0 = qb * 64, tkl = r32 >> 2, r = r32 & 3, head = g * 4 + r, tl = 8 * wave + tkl, t = q0 + tl;
        const unsigned token = (unsigned)b * S_ + t;
        const float slope = 1.4426950408889634f * exp2f(-0.5f * (float)(head + 1));
        bf16x8 qf[8];
#pragma unroll
        for (int s = 0; s < 8; ++s) qf[s] = *(const bf16x8*)(P1 + token * LD1 + head * 128 + 16 * s + 8 * hh);
        float gsig[3];
#pragma unroll
        for (int br = 0; br < 3; ++br) gsig[br] = sigm_f(__uint_as_float((unsigned)P1[token * LD1 + C_G + head * 3 + br] << 16));
        if (tid < 8) uni[tid] = 0u;
        if (tid == 8) *kt0w = 1 << 20;
        if (tid == 9) *jf0w = 1 << 20;

        struct TileRegs { u32x4 k[2], v[2]; };
        TileRegs RA, RB;
        auto issue = [&](TileRegs& R, const bf16_t* ktile, const bf16_t* vtile, bool withv) {
            unsigned tq = tid; asm volatile("" : "+v"(tq));
#pragma unroll
            for (int i = 0; i < 2; ++i) R.k[i] = *(const u32x4*)(ktile + (tq + 512 * i) * 8u);
            if (withv) {
#pragma unroll
                for (int i = 0; i < 2; ++i) R.v[i] = *(const u32x4*)(vtile + (tq + 512 * i) * 8u);
            }
        };
        auto commit = [&](const TileRegs& R, int buf, bool withv) {
            int tq = tid; asm volatile("" : "+v"(tq));
#pragma unroll
            for (int i = 0; i < 2; ++i) { const int pc = tq + 512 * i; *(LAS u32x4*)(Kb + buf * KB_E + (pc >> 4) * 136 + (pc & 15) * 8) = R.k[i]; }
            if (withv) {
#pragma unroll
                for (int i = 0; i < 2; ++i) { const int pc = tq + 512 * i; LAS bf16_t* vq = Vb + buf * VB_E + (pc >> 3) * VP + (pc & 7) * 8; u32x2 lo_, hi_; lo_.x = R.v[i].x; lo_.y = R.v[i].y; hi_.x = R.v[i].z; hi_.y = R.v[i].w; *(LAS u32x2*)vq = lo_; *(LAS u32x2*)(vq + 4) = hi_; }
            }
        };
        auto compS = [&](int buf, f32x16 (&S)[2]) {
            int ro = r32 * 136 + 8 * hh; asm volatile("" : "+v"(ro));
            S[0] = zero16(); S[1] = zero16();
#pragma unroll
            for (int s = 0; s < 8; ++s) {
                S[0] = MFMA32(ldsfrag(Kb + buf * KB_E + ro + 16 * s), qf[s], S[0]);
                S[1] = MFMA32(ldsfrag(Kb + buf * KB_E + 32 * 136 + ro + 16 * s), qf[s], S[1]);
            }
        };
        auto compPV = [&](int buf, const f32x16 (&P)[2], f32x16 (&O)[4]) {
            int vo = r32 * VP + 4 * hh; asm volatile("" : "+v"(vo));
#pragma unroll
            for (int s2 = 0; s2 < 4; ++s2) {
                const int ct = s2 >> 1, sh = s2 & 1;
                u32x4 pw;
#pragma unroll
                for (int d = 0; d < 4; ++d) pw[d] = pk2(P[ct][8 * sh + 2 * d], P[ct][8 * sh + 2 * d + 1]);
                const bf16x8 pf = __builtin_bit_cast(bf16x8, pw);
#pragma unroll
                for (int dt = 0; dt < 4; ++dt) {
                    const LAS bf16_t* vp = Vb + buf * VB_E + dt * 32 * VP + vo + 16 * s2;
                    const s16x4 lo = *(const LAS s16x4*)vp, hi = *(const LAS s16x4*)(vp + 8);
                    const bf16x8 xf = __builtin_shufflevector(lo, hi, 0, 1, 2, 3, 4, 5, 6, 7);
                    O[dt] = MFMA32(xf, pf, O[dt]);
                }
            }
        };

#define KCONST(ct, i) ((float)(32 * (ct) + ((i) & 3) + 8 * ((i) >> 2)))
#define EX2(x) __builtin_amdgcn_exp2f(x)
        const int nkt = (4 * qb + 66) >> 6;
        const bf16_t* kcb = KC + (size_t)bg * 1024 * 128;
        const bf16_t* vcb = VCT + (size_t)bg * 16 * 8192;
        const float skc = 16.f * slope;
        float m1 = -1e30f, l1 = 0.f;
        int kt0;
        {
            float q1 = 0.f;
#pragma unroll
            for (int s = 0; s < 8; ++s)
#pragma unroll
                for (int e = 0; e < 8; ++e) q1 += fabsf(__uint_as_float(((unsigned)(unsigned short)qf[s][e]) << 16));
            q1 += __shfl_xor(q1, 32);
            const float reach = 15.f + (160.f + 2.f * q1 * KINF[bg]) / slope;
            const float xk = ((float)(t - 1039) - reach) * (1.f / 1024.f);
            int kf = xk > 0.f ? (int)ceilf(xk) : 0;
#pragma unroll
            for (int o = 32; o >= 1; o >>= 1) { const int ov = __shfl_xor(kf, o); kf = ov < kf ? ov : kf; }
            const float reach_s = (160.f + 2.f * q1 * KINF[8 + bg]) / slope;
            const float xj = ((float)(t - 63) - reach_s) * (1.f / 64.f);
            int jf = xj > 0.f ? (int)ceilf(xj) : 0;
#pragma unroll
            for (int o = 32; o >= 1; o >>= 1) { const int ov = __shfl_xor(jf, o); jf = ov < jf ? ov : jf; }
            lds_barrier();
            if (lane == 0) { atomicMin((int*)kt0w, kf); atomicMin((int*)jf0w, jf); }
            lds_barrier();
            kt0 = __builtin_amdgcn_readfirstlane(*kt0w);
            kt0 = kt0 < nkt - 1 ? kt0 : nkt - 1;
            for (int tk = 0; tk < 8; ++tk)
                for (int cq = lane; cq < 16 * kt0; cq += 64) imp[(wave * 8 + tk) * 257 + cq] = 0.f;
        }
        issue(RA, kcb + (size_t)kt0 * 8192, vcb, false);
        if (kt0 + 1 < nkt) issue(RB, kcb + (size_t)(kt0 + 1) * 8192, vcb, false);
        auto step1 = [&](int kt, TileRegs& R) {
            const int buf = kt & 1;
            commit(R, buf, false);
            if (kt + 2 < nkt) issue(R, kcb + (size_t)(kt + 2) * 8192, vcb, false);
            lds_barrier();
            f32x16 S[2]; compS(buf, S);
            const bool fast = (1024 * kt + 1039 <= q0);
            float rb = -slope * (float)(t - 31 - 1024 * kt) + skc * (float)(4 * hh); asm volatile("" : "+v"(rb));
            float mt = -1e30f;
#pragma unroll
            for (int ct = 0; ct < 2; ++ct)
#pragma unroll
                for (int i = 0; i < 16; ++i) S[ct][i] = fmaf(skc, KCONST(ct, i), S[ct][i]);
            if (!fast) {
                int d0 = t - 31 - 1024 * kt - 64 * hh; asm volatile("" : "+v"(d0));
#pragma unroll
                for (int ct = 0; ct < 2; ++ct)
#pragma unroll
                    for (int i = 0; i < 16; ++i) { const int dist = d0 - 16 * (32 * ct + (i & 3) + 8 * (i >> 2)); S[ct][i] = dist >= 0 ? S[ct][i] : -1e30f; }
            }
#pragma unroll
            for (int ct = 0; ct < 2; ++ct)
#pragma unroll
                for (int i = 0; i < 16; ++i) mt = fmaxf(mt, S[ct][i]);
            mt += rb;
            const float mn = fmaxf(m1, mt), off = mn - rb;
            float ls = 0.f;
            if (fast) {
#pragma unroll
                for (int ct = 0; ct < 2; ++ct)
#pragma unroll
                    for (int i = 0; i < 16; ++i) ls += EX2(S[ct][i] - off);
            } else {
#pragma unroll
                for (int ct = 0; ct < 2; ++ct)
#pragma unroll
                    for (int i = 0; i < 16; ++i) ls += S[ct][i] > -1e29f ? EX2(S[ct][i] - off) : 0.f;
            }
            l1 = l1 * EX2(m1 - mn) + ls; m1 = mn;
        };
        for (int kt = kt0; kt < nkt; kt += 2) { step1(kt, RA); if (kt + 1 < nkt) step1(kt + 1, RB); }
        float Mx, lgi;
        {
            const float mo = __shfl_xor(m1, 32), lo = __shfl_xor(l1, 32);
            Mx = fmaxf(m1, mo);
            const float L = l1 * EX2(m1 - Mx) + lo * EX2(mo - Mx);
            lgi = L > 0.f ? -__log2f(L) : -1e30f;
        }
        f32x16 O[4];
#pragma unroll
        for (int dt = 0; dt < 4; ++dt) O[dt] = zero16();
        float carry = 0.f;
        LAS float* impw = imp + (wave * 8 + tkl) * 257;
        lds_barrier();
        issue(RA, kcb + (size_t)kt0 * 8192, vcb + (size_t)kt0 * 8192, true);
        if (kt0 + 1 < nkt) issue(RB, kcb + (size_t)(kt0 + 1) * 8192, vcb + (size_t)(kt0 + 1) * 8192, true);
        auto step2 = [&](int kt, TileRegs& R) {
            const int buf = kt & 1;
            commit(R, buf, true);
            if (kt + 2 < nkt) issue(R, kcb + (size_t)(kt + 2) * 8192, vcb + (size_t)(kt + 2) * 8192, true);
            lds_barrier();
            f32x16 S[2]; compS(buf, S);
            const bool fast = (1024 * kt + 1039 <= q0);
            float rb = -slope * (float)(t - 31 - 1024 * kt) + skc * (float)(4 * hh); asm volatile("" : "+v"(rb));
            const float off = (Mx - rb) - lgi;
            if (fast) {
#pragma unroll
                for (int ct = 0; ct < 2; ++ct)
#pragma unroll
                    for (int i = 0; i < 16; ++i) S[ct][i] = EX2(fmaf(skc, KCONST(ct, i), S[ct][i]) - off);
            } else {
                int d0 = t - 31 - 1024 * kt - 64 * hh; asm volatile("" : "+v"(d0));
#pragma unroll
                for (int ct = 0; ct < 2; ++ct)
#pragma unroll
                    for (int i = 0; i < 16; ++i) {
                        const int dist = d0 - 16 * (32 * ct + (i & 3) + 8 * (i >> 2));
                        S[ct][i] = dist >= 0 ? EX2(fmaf(skc, KCONST(ct, i), S[ct][i]) - off) : 0.f;
                    }
            }
            float X[2][4];
#pragma unroll
            for (int ct = 0; ct < 2; ++ct)
#pragma unroll
                for (int G = 0; G < 4; ++G) X[ct][G] = __shfl_xor(S[ct][4 * G + 3], 32);
#pragma unroll
            for (int ct = 0; ct < 2; ++ct)
#pragma unroll
                for (int G = 0; G < 4; ++G) {
                    const float prev0 = G > 0 ? X[ct][G - 1] : (ct > 0 ? X[0][3] : carry);
                    const float prev = hh ? X[ct][G] : prev0;
                    float tot = S[ct][4 * G] + S[ct][4 * G + 1] + S[ct][4 * G + 2] + S[ct][4 * G + 3] + prev;
                    tot += dpp_x1(tot); tot += dpp_x2(tot);
                    const int cq = 16 * kt + 8 * ct + 2 * G + hh;
                    if (r == 0) impw[cq] = tot;
                }
            carry = X[1][3];
            compPV(buf, S, O);
        };
        for (int kt = kt0; kt < nkt; kt += 2) { step2(kt, RA); if (kt + 1 < nkt) step2(kt + 1, RB); }
        {
            const int cur = qb, nsel = cur + 1 < 16 ? cur + 1 : 16;
#pragma unroll 1
            for (int tk = 0; tk < 8; ++tk) {
                const LAS float* iw = imp + (wave * 8 + tk) * 257;
                unsigned key[4];
#pragma unroll
                for (int uu = 0; uu < 4; ++uu) {
                    const int j = lane + 64 * uu;
                    const bool forced = (j == 0 || j == cur || j == cur - 1);
                    const unsigned bits = forced ? 0x461C4000u   : __float_as_uint(iw[j < 256 ? j : 255]);
                    key[uu] = j <= cur ? ((bits & 0xFFFFFF00u) | (unsigned)(255 - j)) : 0u;
                }
                unsigned thr = 0u;
#pragma unroll 1
                for (int bit = 30; bit >= 0; --bit) {
                    const unsigned cand = thr | (1u << bit);
                    const int cnt = __popcll(__ballot(key[0] >= cand)) + __popcll(__ballot(key[1] >= cand)) + __popcll(__ballot(key[2] >= cand)) + __popcll(__ballot(key[3] >= cand));
                    thr = cnt >= nsel ? cand : thr;
                }
                unsigned word = 0u;
#pragma unroll
                for (int uu = 0; uu < 4; ++uu) {
                    const unsigned long long m = __ballot(key[uu] >= thr);
                    if (lane == 2 * uu) word = (unsigned)m;
                    if (lane == 2 * uu + 1) word = (unsigned)(m >> 32);
                }
                if (lane < 8) { selm[(wave * 8 + tk) * 8 + lane] = word; if (word) atomicOr((unsigned*)(uni + lane), word); }
            }
        }
        lds_barrier();
        {
            LAS bf16_t* rp = R1 + (wave * 32 + r32) * 132;
#pragma unroll
            for (int dt = 0; dt < 4; ++dt)
#pragma unroll
                for (int G = 0; G < 4; ++G) {
                    u32x2 w; w.x = pk2(O[dt][4 * G] * gsig[0], O[dt][4 * G + 1] * gsig[0]); w.y = pk2(O[dt][4 * G + 2] * gsig[0], O[dt][4 * G + 3] * gsig[0]);
                    *(LAS u32x2*)(rp + dt * 32 + 8 * G + 4 * hh) = w;
                }
            if (wave == 0) {
                const int jf0 = *jf0w;
                int n = 0;
#pragma unroll
                for (int u4 = 3; u4 >= 0; --u4) {
                    const int j = lane + 64 * u4;
                    const bool sel = ((uni[2 * u4 + (lane >> 5)] >> (lane & 31)) & 1u) && j >= jf0;
                    const unsigned long long m = __ballot(sel);
                    const unsigned long long above = lane == 63 ? 0ull : (m >> (lane + 1));
                    if (sel) jlist[n + __popcll(above)] = (unsigned char)j;
                    n += __popcll(m);
                }
                if (lane == 0) *jcount = n;
            }
        }
        lds_barrier();
        float mr, lr;
        auto flash_tile = [&](int buf, int kbase, bool rowsel, int wlim, bool fast) {
            f32x16 S[2]; compS(buf, S);
            float rb = -slope * (float)(t - kbase) + slope * (float)(4 * hh); asm volatile("" : "+v"(rb));
#pragma unroll
            for (int ct = 0; ct < 2; ++ct)
#pragma unroll
                for (int i = 0; i < 16; ++i) S[ct][i] = fmaf(slope, KCONST(ct, i), S[ct][i]);
            if (!fast) {
                int d0 = t - kbase - 4 * hh; asm volatile("" : "+v"(d0));
#pragma unroll
                for (int ct = 0; ct < 2; ++ct)
#pragma unroll
                    for (int i = 0; i < 16; ++i) {
                        const int dist = d0 - (32 * ct + (i & 3) + 8 * (i >> 2));
                        S[ct][i] = (rowsel && dist >= 0 && dist < wlim) ? S[ct][i] : -1e30f;
                    }
            }
            float mt = -1e30f;
#pragma unroll
            for (int ct = 0; ct < 2; ++ct)
#pragma unroll
                for (int i = 0; i < 16; ++i) mt = fmaxf(mt, S[ct][i]);
            mt += rb;
            mt = fmaxf(mt, __shfl_xor(mt, 32));
            const float mn = fmaxf(mr, mt);
            if (__any(mn > mr)) {
                const float alpha = EX2(mr - mn);
                lr *= alpha;
#pragma unroll
                for (int dt = 0; dt < 4; ++dt) O[dt] = O[dt] * alpha;
            }
            mr = mn;
            const float off = mn - rb;
            float ls = 0.f;
#pragma unroll
            for (int ct = 0; ct < 2; ++ct)
#pragma unroll
                for (int i = 0; i < 16; ++i) { const float pe = EX2(S[ct][i] - off); S[ct][i] = pe; ls += pe; }
            lr += ls;
            compPV(buf, S, O);
        };
        {
            const int nj = __builtin_amdgcn_readfirstlane(*jcount);
            mr = -1e30f; lr = 0.f;
#pragma unroll
            for (int dt = 0; dt < 4; ++dt) O[dt] = zero16();
            const bf16_t* ksb = KS2 + (size_t)bg * 256 * 8192;
            const bf16_t* vsb = VST + (size_t)bg * 256 * 8192;
            auto jat = [&](int i) { return __builtin_amdgcn_readfirstlane((int)jlist[i]); };
            { const int j = jat(0); issue(RA, ksb + (size_t)j * 8192, vsb + (size_t)j * 8192, true); }
            if (nj > 1) { const int j = jat(1); issue(RB, ksb + (size_t)j * 8192, vsb + (size_t)j * 8192, true); }
            auto step3 = [&](int i, TileRegs& R) {
                const int buf = i & 1, j = jat(i);
                commit(R, buf, true);
                if (i + 2 < nj) { const int jn = jat(i + 2); issue(R, ksb + (size_t)jn * 8192, vsb + (size_t)jn * 8192, true); }
                lds_barrier();
                const bool rowsel = (selm[tl * 8 + (j >> 5)] >> (j & 31)) & 1u;
                if (__any(rowsel)) flash_tile(buf, 64 * j, rowsel, 1 << 30, j < qb && __all(rowsel));
            };
            for (int i = 0; i < nj; i += 2) { step3(i, RA); if (i + 1 < nj) step3(i + 1, RB); }
            const float lt = lr + __shfl_xor(lr, 32), inv = gsig[1] / lt;
            LAS bf16_t* rp = R1 + (wave * 32 + r32) * 132;
#pragma unroll
            for (int dt = 0; dt < 4; ++dt)
#pragma unroll
                for (int G = 0; G < 4; ++G) {
                    LAS u32x2* q = (LAS u32x2*)(rp + dt * 32 + 8 * G + 4 * hh);
                    const u32x2 old = *q; u32x2 w;
                    w.x = pk2(bflo(old.x) + O[dt][4 * G] * inv, bfhi(old.x) + O[dt][4 * G + 1] * inv);
                    w.y = pk2(bflo(old.y) + O[dt][4 * G + 2] * inv, bfhi(old.y) + O[dt][4 * G + 3] * inv);
                    *q = w;
                }
        }
        {
            mr = -1e30f; lr = 0.f;
#pragma unroll
            for (int dt = 0; dt < 4; ++dt) O[dt] = zero16();
            const bf16_t* kwb = KW2 + (size_t)bg * 256 * 8192;
            const bf16_t* vwb = VWT + (size_t)bg * 256 * 8192;
            const int j0 = qb - 8 > 0 ? qb - 8 : 0, nj = qb - j0 + 1;
            lds_barrier();
            issue(RA, kwb + (size_t)qb * 8192, vwb + (size_t)qb * 8192, true);
            if (nj > 1) issue(RB, kwb + (size_t)(qb - 1) * 8192, vwb + (size_t)(qb - 1) * 8192, true);
            auto step4 = [&](int i, TileRegs& R) {
                const int buf = i & 1, j = qb - i;
                commit(R, buf, true);
                if (i + 2 < nj) issue(R, kwb + (size_t)(j - 2) * 8192, vwb + (size_t)(j - 2) * 8192, true);
                lds_barrier();
                flash_tile(buf, 64 * j, true, 512, j < qb && j > qb - 8);
            };
            for (int i = 0; i < nj; i += 2) { step4(i, RA); if (i + 1 < nj) step4(i + 1, RB); }
            const float lt = lr + __shfl_xor(lr, 32), inv = gsig[2] / lt;
            const LAS bf16_t* rp = R1 + (wave * 32 + r32) * 132;
#pragma unroll
            for (int dt = 0; dt < 4; ++dt)
#pragma unroll
                for (int G = 0; G < 4; ++G) {
                    const int d0 = dt * 32 + 8 * G + 4 * hh;
                    const u32x2 old = *(const LAS u32x2*)(rp + d0);
                    const u32x2 zz = *(const u32x2*)(P1 + token * LD1 + C_Z + head * 128 + d0);
                    u32x2 w;
                    w.x = pk2(silu_f(bflo(zz.x)) * (bflo(old.x) + O[dt][4 * G] * inv), silu_f(bfhi(zz.x)) * (bfhi(old.x) + O[dt][4 * G + 1] * inv));
                    w.y = pk2(silu_f(bflo(zz.y)) * (bflo(old.y) + O[dt][4 * G + 2] * inv), silu_f(bfhi(zz.y)) * (bfhi(old.y) + O[dt][4 * G + 3] * inv));
                    *(u32x2*)(Y1 + token * DM + head * 128 + d0) = w;
                }
        }
        lds_barrier();
    }
}

DI void final_norm(float* out, const float* fg) {
    const int lane = threadIdx.x & 63, wave = threadIdx.x >> 6;
    const int nw = gridDim.x * 8, gw = blockIdx.x * 8 + wave;
    for (int row0 = gw * 2; row0 < T_; row0 += nw * 2) {
        f32x4 v[2][8]; float ss[2] = {0.f, 0.f};
#pragma unroll
        for (int q = 0; q < 2; ++q) {
            const f32x4* xr = (const f32x4*)(out + (size_t)(row0 + q) * DM);
#pragma unroll
            for (int i = 0; i < 8; ++i) v[q][i] = xr[lane + 64 * i];
        }
#pragma unroll
        for (int q = 0; q < 2; ++q)
#pragma unroll
            for (int i = 0; i < 8; ++i) ss[q] += v[q][i][0] * v[q][i][0] + v[q][i][1] * v[q][i][1] + v[q][i][2] * v[q][i][2] + v[q][i][3] * v[q][i][3];
        ss[0] = wave_sum(ss[0]); ss[1] = wave_sum(ss[1]);
#pragma unroll
        for (int q = 0; q < 2; ++q) {
            const float rs = rsqrtf(ss[q] * (1.f / 2048.f) + 1e-6f);
            f32x4* xr = (f32x4*)(out + (size_t)(row0 + q) * DM);
#pragma unroll
            for (int i = 0; i < 8; ++i) { const f32x4 gq = ((const f32x4*)fg)[lane + 64 * i]; xr[lane + 64 * i] = v[q][i] * rs * gq; }
        }
    }
}

#define XB_TMO      128
#define XB_XCNT(j)  (256  + 64 * (j))
#define XB_XSUB(j)  (1280 + 64 * (j))
#define XB_XGEN(j)  (2304 + 64 * (j))
#define XB_TOP      3328
#define XB_TOPGEN   3392
#define XCD_BAR_WORDS 3456
#define XB_SPIN_CAP (1u << 20)
DI unsigned xb_ld(unsigned* p) { return __hip_atomic_load(p, __ATOMIC_RELAXED, __HIP_MEMORY_SCOPE_AGENT); }
DI unsigned xb_add(unsigned* p, unsigned v) { return __hip_atomic_fetch_add(p, v, __ATOMIC_RELAXED, __HIP_MEMORY_SCOPE_AGENT); }
DI unsigned xb_xcc_id() { return (unsigned)__builtin_amdgcn_s_getreg((3 << 11) | 20) & 0xFu; }
#define XB_SPIN(cond, bar) do { unsigned _sp = 0; while (cond) { __builtin_amdgcn_s_sleep(1); \
    if ((++_sp & 255u) == 0u) { if (xb_ld(&(bar)[XB_TMO])) break; if (_sp > XB_SPIN_CAP) { atomicAdd(&(bar)[XB_TMO], 1u); break; } } } } while (0)
struct XcdBarrier { unsigned* bar; unsigned x; volatile LAS unsigned* st; };
DI XcdBarrier xcd_barrier_post(unsigned* bar, volatile LAS unsigned* st) {
    XcdBarrier b; b.bar = bar; b.x = xb_xcc_id(); b.st = st;
    if (threadIdx.x == 0) (void)xb_add(&bar[XB_XCNT(b.x)], 1u);
    return b;
}
DI void xcd_barrier_complete(unsigned* bar, unsigned x, unsigned& nloc, unsigned& nx) {
    const unsigned G = gridDim.x * gridDim.y * gridDim.z;
    unsigned sum, cnt, mine, sp = 0u;
    for (;;) {
        sum = 0u; cnt = 0u; mine = 0u;
#pragma unroll
        for (unsigned j = 0; j < 16; ++j) { const unsigned c = xb_ld(&bar[XB_XCNT(j)]); sum += c; cnt += (c > 0u) ? 1u : 0u; mine = (j == x) ? c : mine; }
        if (sum == G) break;
        __builtin_amdgcn_s_sleep(1);
        if ((++sp & 255u) == 0u) { if (xb_ld(&bar[XB_TMO])) break; if (sp > XB_SPIN_CAP) { atomicAdd(&bar[XB_TMO], 1u); break; } }
    }
    nloc = mine > 0u ? mine : 1u; nx = cnt > 0u ? cnt : 1u;
}
DI void xcd_barrier(const XcdBarrier& b) {
    asm volatile("s_waitcnt vmcnt(0)" ::: "memory");
    __syncthreads();
    if (threadIdx.x == 0) {
        unsigned* bar = b.bar;
        __builtin_amdgcn_s_waitcnt(0);
        unsigned nloc = b.st[0], nx = b.st[1];
        if (nloc == 0u) { xcd_barrier_complete(bar, b.x, nloc, nx); b.st[0] = nloc; b.st[1] = nx; }
        const unsigned old = xb_add(&bar[XB_XSUB(b.x)], 1u);
        const unsigned gen = old / nloc;
        if (old + 1u == (gen + 1u) * nloc) {
            __builtin_amdgcn_fence(__ATOMIC_RELEASE, "agent");
            asm volatile("s_waitcnt vmcnt(0)" ::: "memory");
            const unsigned og = xb_add(&bar[XB_TOP], 1u);
            const unsigned tg = og / nx;
            if (og + 1u == (tg + 1u) * nx) xb_add(&bar[XB_TOPGEN], 1u);
            else XB_SPIN(xb_ld(&bar[XB_TOPGEN]) == tg, bar);
            __builtin_amdgcn_fence(__ATOMIC_ACQUIRE, "agent");
            xb_add(&bar[XB_XGEN(b.x)], 1u);
            asm volatile("s_waitcnt vmcnt(0)" ::: "memory");
        } else {
            XB_SPIN(xb_ld(&bar[XB_XGEN(b.x)]) == gen, bar);
            __builtin_amdgcn_fence(__ATOMIC_ACQUIRE, "agent");
            asm volatile("s_waitcnt vmcnt(0)" ::: "memory");
        }
    }
    __syncthreads();
}

constexpr int NPHASE = 11;
__global__ void __launch_bounds__(NTHREADS, 2) fwd_kernel(Params p) {
    extern __shared__ __attribute__((aligned(16))) unsigned char lds_raw[];
    LAS unsigned char* lds = (LAS unsigned char*)lds_raw;
    unsigned char* ws = p.ws;
    bf16_t* PROJ = (bf16_t*)(ws + OFF_PROJ);
    bf16_t* XB = (bf16_t*)(ws + OFF_XB);
    const int lo = p.ph_lo, hi = p.ph_hi;
#ifndef PHMASK
#define PHMASK 0x7ff
#endif
#define IN(k) (((PHMASK >> (k)) & 1) && lo <= (k) && (k) < hi)
    volatile LAS unsigned* xst = (volatile LAS unsigned*)(lds + LDS_BYTES - 16);
    XcdBarrier xbar; xbar.bar = (unsigned*)(ws + OFF_BAR); xbar.x = 0; xbar.st = xst;
    if (hi - lo > 1) {
        if (threadIdx.x < 2) xst[threadIdx.x] = 0u;
        __syncthreads();
        xbar = xcd_barrier_post((unsigned*)(ws + OFF_BAR), xst);
    }
#define SEAM(k) do { if ((k) + 1 < hi) { if (hi > 1000) cg::this_grid().sync();   xcd_barrier(xbar); } } while (0)
#ifndef REPMASK
#define REPMASK 0
#endif
#define REP(k) ((REPMASK >> (k)) & 1)
#define GS() cg::this_grid().sync()
    if (IN(0)) { if (REP(0)) { phase0(p, lds); GS(); } phase0(p, lds); SEAM(0); }
    if (IN(1)) {
        pg8::Gemm g{XB, (const bf16_t*)(ws + OFF_W1T), 2048, 2048, T_, 12288, 2048}; pg8::StaticOrder S; S.init(T_, 12288, gridDim.x, blockIdx.x);
        pg8::EpiScaleBf16<2> E{PROJ, LD0, nullptr};
        if (REP(1)) { pg8::gemm_phase(lds, g, S, E); GS(); }
        pg8::gemm_phase(lds, g, S, E); SEAM(1);
    }
    if (IN(2)) { if (REP(2)) { ret_intra(PROJ, (bf16_t*)p.out, XB, lds); GS(); } ret_intra(PROJ, (bf16_t*)p.out, XB, lds); SEAM(2); }
    if (IN(3)) { for (int rep = REP(3) ? 0 : 1; rep < 2; ++rep) { ret_inter(PROJ, (const bf16_t*)p.out, XB, lds, rep == 0); if (rep == 0) GS(); } SEAM(3); }
    if (IN(4)) { if (REP(4)) { ret_gate(PROJ, XB); GS(); } ret_gate(PROJ); SEAM(4); }
    if (IN(5)) {
        pg8::Gemm g{PROJ + 8192, (const bf16_t*)(ws + OFF_W2T), LD0, 4096, T_, 2048, 4096}; pg8::StaticOrder S; S.init(T_, 2048, gridDim.x, blockIdx.x);
        if (REP(5)) { pg8::EpiResid E0{p.x, p.out, XB, nullptr}; pg8::gemm_phase(lds, g, S, E0); GS(); }
        pg8::EpiResid E{p.x, p.out, XB, (float*)(ws + OFF_SS1)};
        pg8::gemm_phase(lds, g, S, E); SEAM(5);
    }
    if (IN(6)) {
        pg8::Gemm g{XB, (const bf16_t*)(ws + OFF_W3T), 2048, 2048, T_, LD1, 2048}; pg8::StaticOrder S; S.init(T_, LD1, gridDim.x, blockIdx.x);
        pg8::EpiScaleBf16<1> E{PROJ, LD1, (const float*)(ws + OFF_SS1)};
        if (REP(6)) { pg8::gemm_phase(lds, g, S, E); GS(); }
        pg8::gemm_phase(lds, g, S, E); SEAM(6);
    }
    if (IN(7)) {
        if (REP(7)) { nsa_compress(PROJ, ws, (bf16_t*)(ws + OFF_KC), (bf16_t*)(ws + OFF_VCT), (bf16_t*)(ws + OFF_VST), (bf16_t*)(ws + OFF_VWT), (bf16_t*)(ws + OFF_KS2), (bf16_t*)(ws + OFF_KW2), lds); GS(); }
        nsa_compress(PROJ, ws, (bf16_t*)(ws + OFF_KC), (bf16_t*)(ws + OFF_VCT), (bf16_t*)(ws + OFF_VST), (bf16_t*)(ws + OFF_VWT), (bf16_t*)(ws + OFF_KS2), (bf16_t*)(ws + OFF_KW2), lds); SEAM(7); }
    if (IN(8)) {
        if (REP(8)) { nsa_attn(PROJ, (const bf16_t*)(ws + OFF_KC), (const bf16_t*)(ws + OFF_VCT), (const bf16_t*)(ws + OFF_VST), (const bf16_t*)(ws + OFF_VWT), (const bf16_t*)(ws + OFF_KS2), (const bf16_t*)(ws + OFF_KW2), (const float*)(ws + OFF_KINF), XB, lds); GS(); }
        nsa_attn(PROJ, (const bf16_t*)(ws + OFF_KC), (const bf16_t*)(ws + OFF_VCT), (const bf16_t*)(ws + OFF_VST), (const bf16_t*)(ws + OFF_VWT), (const bf16_t*)(ws + OFF_KS2), (const bf16_t*)(ws + OFF_KW2), (const float*)(ws + OFF_KINF), XB, lds); SEAM(8); }
    if (IN(9)) {
        pg8::Gemm g{XB, (const bf16_t*)(ws + OFF_W4T), 2048, 2048, T_, 2048, 2048}; pg8::StaticOrder S; S.init(T_, 2048, gridDim.x, blockIdx.x);
        if (REP(9)) { pg8::EpiResid E0{p.out, (float*)PROJ, nullptr, nullptr}; pg8::gemm_phase(lds, g, S, E0); GS(); }
        pg8::EpiResid E{p.out, p.out, nullptr, nullptr};
        pg8::gemm_phase(lds, g, S, E); SEAM(9);
    }
    if (IN(10)) { final_norm(p.out, p.final_g); }
#undef IN
#undef SEAM
}

extern "C" void kernel_launch(void* const* d_in, const int* in_sizes, int n_in, void* d_out, int out_size, void* d_ws, size_t ws_size, hipStream_t stream) {
    static int grid = 0;
    if (grid == 0) {
        if (n_in != 13 || out_size != T_ * DM || ws_size < WS_END) { fprintf(stderr, "kernel_launch: unexpected shapes (n_in %d out %d ws %zu need %zu)\n", n_in, out_size, ws_size, (size_t)WS_END); grid = -1; return; }
        int dev = 0, cus = 0, per_cu = 0;
        hipGetDevice(&dev); hipDeviceGetAttribute(&cus, hipDeviceAttributeMultiprocessorCount, dev);
        if (hipFuncSetAttribute((const void*)fwd_kernel, hipFuncAttributeMaxDynamicSharedMemorySize, LDS_BYTES) != hipSuccess) { fprintf(stderr, "kernel_launch: hipFuncSetAttribute failed\n"); grid = -1; return; }
        hipOccupancyMaxActiveBlocksPerMultiprocessor(&per_cu, (const void*)fwd_kernel, NTHREADS, LDS_BYTES);
        (void)hipGetLastError();
        if (per_cu < 1) per_cu = 1;
        grid = cus * 1;
    }
    if (grid < 0) return;
    Params p{};
    p.x = (const float*)d_in[0]; p.norm_g = (const float*)d_in[1]; p.ret_w_in = (const float*)d_in[2]; p.ret_w_out = (const float*)d_in[3];
    p.nsa_w_in = (const float*)d_in[4]; p.pos_k = (const float*)d_in[5]; p.w1_k = (const float*)d_in[6]; p.w2_k = (const float*)d_in[7];
    p.pos_v = (const float*)d_in[8]; p.w1_v = (const float*)d_in[9]; p.w2_v = (const float*)d_in[10]; p.nsa_w_out = (const float*)d_in[11];
    p.final_g = (const float*)d_in[12]; p.out = (float*)d_out; p.ws = (unsigned char*)d_ws;
#if SINGLE_LAUNCH
    hipMemsetAsync((char*)d_ws + OFF_BAR, 0, 16384, stream);
    p.ph_lo = 0; p.ph_hi = NPHASE;
    void* args[] = {&p};
    hipError_t e = hipLaunchCooperativeKernel((const void*)fwd_kernel, dim3(grid), dim3(NTHREADS), args, LDS_BYTES, stream);
    if (e != hipSuccess) fprintf(stderr, "cooperative launch failed: %s (grid %d)\n", hipGetErrorString(e), grid);
#else
    for (int k = 0; k < NPHASE; ++k) {
        p.ph_lo = k; p.ph_hi = k + 1;
        hipLaunchKernelGGL(fwd_kernel, dim3(grid), dim3(NTHREADS), LDS_BYTES, stream, p);
    }
#endif
}
```
